# Optimizing an MI355X kernel written in HIP

```python
import jax
import jax.numpy as jnp
from jax import lax
import numpy as np

D_MODEL = 1024
BATCH = 8
SEQ = 4096
DEPTH = 2

GRID_W = 64
CTX_LEN = 256
EPS = 1e-6

LRU_WIDTH = 512
LRU_BLOCKS = 8
LRU_BLOCK = LRU_WIDTH // LRU_BLOCKS
CONV_W = 4
CONV_PAD_L = 2
LRU_C = 8.0

MLA_HEADS = 8
MLA_NOPE = 64
MLA_ROPE = 32
MLA_V = 64
Q_LORA = 384
KV_LORA = 256
ROPE_BASE = 10000.0
Q_BLOCK = 128

RET_HEADS = 4
RET_DK = 64
RET_DV = 128
RET_CHUNK = 128

D_FF = -(-8 * D_MODEL // (3 * 256)) * 256

KV_SIZES = (LRU_WIDTH, KV_LORA, MLA_ROPE, RET_HEADS * RET_DK, RET_HEADS * RET_DV)
Q_SIZES = (Q_LORA, RET_HEADS * RET_DK, LRU_WIDTH, RET_HEADS * RET_DV, 3 * D_MODEL)
N_KV = sum(KV_SIZES)
N_IN = N_KV + sum(Q_SIZES)

kernel_name = 'hybrid_rglru_mla_retention_dit'


def rmsnorm(x, g):
    xf = x.astype(jnp.float32)
    y = xf * lax.rsqrt(jnp.mean(xf * xf, axis=-1, keepdims=True) + EPS)
    return (y * g).astype(x.dtype)


def head_norm(o):
    of = o.astype(jnp.float32)
    mu = jnp.mean(of, axis=-1, keepdims=True)
    var = jnp.mean(jnp.square(of - mu), axis=-1, keepdims=True)
    return ((of - mu) * lax.rsqrt(var + EPS)).astype(o.dtype)


def modulate(h, shift, scale):
    return h * (1.0 + scale) + shift


def split_cols(z, sizes):
    parts, off = [], 0
    for s in sizes:
        parts.append(z[..., off:off + s])
        off += s
    return parts


def rotate(x, cos, sin):
    half = x.shape[-1] // 2
    x1, x2 = x[..., :half], x[..., half:]
    return jnp.concatenate([x1 * cos - x2 * sin, x1 * sin + x2 * cos], axis=-1)


def axial_rope_tables(n_tokens, dtype):
    rows = n_tokens // GRID_W
    row = jnp.repeat(jnp.arange(rows, dtype=jnp.float32), GRID_W)
    col = jnp.tile(jnp.arange(GRID_W, dtype=jnp.float32), rows)
    n_freq = MLA_ROPE // 4
    inv = jnp.power(ROPE_BASE, -jnp.arange(n_freq, dtype=jnp.float32) / n_freq)
    ang = jnp.concatenate([row[:, None] * inv, col[:, None] * inv], axis=-1)
    return jnp.cos(ang).astype(dtype), jnp.sin(ang).astype(dtype)


def retention_rope_tables(start, n, dtype):
    theta = 1.0 / jnp.power(10000.0, jnp.linspace(0.0, 1.0, RET_DK // 2, dtype=jnp.float32))
    pos = start + jnp.arange(n, dtype=jnp.float32)
    ang = pos[:, None] * theta
    return jnp.cos(ang)[:, None, :].astype(dtype), jnp.sin(ang)[:, None, :].astype(dtype)


def retention_log_decays():
    h = jnp.arange(RET_HEADS, dtype=jnp.float32)
    return (jnp.log1p(-jnp.exp2(-5.0 - h)), jnp.log1p(-jnp.exp2(-5.5 - h)))


def depthwise_conv(u, w, b):
    out = lax.conv_general_dilated(
        u, w[:, None, :], window_strides=(1,), padding=[(CONV_PAD_L, CONV_W - 1 - CONV_PAD_L)],
        dimension_numbers=('NWC', 'WIO', 'NWC'), feature_group_count=u.shape[-1])
    return out + b


def rglru_coefficients(u, wa, ba, wx, bx, lam):
    uf = u.astype(jnp.float32)
    ub = uf.reshape(*u.shape[:-1], LRU_BLOCKS, LRU_BLOCK)
    r = jax.nn.sigmoid(jnp.einsum('blnd,nde->blne', ub, wa).reshape(u.shape) + ba)
    i = jax.nn.sigmoid(jnp.einsum('blnd,nde->blne', ub, wx).reshape(u.shape) + bx)
    log_a = -LRU_C * r * jax.nn.softplus(-lam)
    a = jnp.exp(log_a)
    b = jnp.sqrt(-jnp.expm1(2.0 * log_a)) * (i * uf)
    return a, b


def _lin_combine(l, r):
    return (l[0] * r[0], r[0] * l[1] + r[1])


def linear_scan(a, b, h0, reverse):
    if reverse:
        a, b = a[:, ::-1], b[:, ::-1]
    b = b.at[:, 0].add(a[:, 0] * h0)
    _, h = lax.associative_scan(_lin_combine, (a, b), axis=1)
    return h[:, ::-1] if reverse else h


def attention(q, k, v):
    s = jnp.einsum('bqhd,bkhd->bhqk', q, k).astype(jnp.float32) * (q.shape[-1] ** -0.5)
    p = jax.nn.softmax(s, axis=-1).astype(v.dtype)
    return jnp.einsum('bhqk,bkhd->bqhd', p, v)


def blocked_attention(q, k, v):
    B, L, H, D = q.shape
    nb = L // Q_BLOCK
    qb = jnp.moveaxis(q.reshape(B, nb, Q_BLOCK, H, D), 1, 0)
    o = lax.map(lambda qi: attention(qi, k, v), qb)
    return jnp.moveaxis(o, 0, 1).reshape(B, L, H, v.shape[-1])


def retention_chunkwise(q, k, v, log_gamma, r0):
    B, L, H, DK = q.shape
    DV = v.shape[-1]
    n = L // RET_CHUNK
    dt = q.dtype
    pos = jnp.arange(RET_CHUNK, dtype=jnp.float32)
    diff = pos[:, None] - pos[None, :]
    inner = jnp.where(diff >= 0, jnp.exp(log_gamma[:, None, None] * jnp.maximum(diff, 0.0)), 0.0).astype(dt)
    q_decay = jnp.exp(log_gamma[:, None] * (pos + 1.0))[..., None].astype(dt)
    k_decay = jnp.exp(log_gamma[:, None] * (RET_CHUNK - 1.0 - pos))[..., None].astype(dt)
    chunk_decay = jnp.exp(log_gamma * RET_CHUNK)[:, None, None].astype(dt)

    def to_chunks(t):
        return t.reshape(B, n, RET_CHUNK, H, t.shape[-1]).transpose(1, 0, 3, 2, 4)

    def step(r, xs):
        qi, ki, vi = xs
        s = jnp.einsum('bhqd,bhkd->bhqk', qi, ki) * inner
        o = jnp.einsum('bhqk,bhkv->bhqv', s, vi) + jnp.einsum('bhqd,bhdv->bhqv', qi * q_decay, r)
        r = chunk_decay * r + jnp.einsum('bhkd,bhkv->bhdv', ki * k_decay, vi)
        return r, o

    r, o = lax.scan(step, r0.astype(dt), (to_chunks(q), to_chunks(k), to_chunks(v)))
    return o.transpose(1, 0, 3, 2, 4).reshape(B, L, H, DV), r


def retention_state(k, v, log_gamma):
    L = k.shape[1]
    w = jnp.exp((L - 1.0 - jnp.arange(L, dtype=jnp.float32))[:, None] * log_gamma[None, :]).astype(k.dtype)
    return jnp.einsum('blhd,blhv->bhdv', k * w[None, :, :, None], v)


def swiglu(h, w1, w3, w2):
    return (jax.nn.silu(h @ w1) * (h @ w3)) @ w2


def token_mixer(h, hc, w_in, conv_w, conv_b, lru_wa, lru_ba, lru_wx, lru_bx, lru_lam,
                g_q, w_uq, g_kv, w_ukv, w_oa, w_ob, w_oc, w_out,
                rope, ret_lat, ret_ctx, log_decays, need_ctx_out):
    B, L, _ = h.shape
    Lc = hc.shape[1]
    dt = h.dtype
    z = h @ w_in
    zc = hc @ (w_in if need_ctx_out else w_in[:, :N_KV])
    src = split_cols(z[..., :N_KV], KV_SIZES)
    qry = split_cols(z[..., N_KV:], Q_SIZES)
    csrc = split_cols(zc[..., :N_KV], KV_SIZES)
    cqry = split_cols(zc[..., N_KV:], Q_SIZES) if need_ctx_out else None
    ident = lambda t: t
    flip = lambda t: t[:, ::-1]

    u = depthwise_conv(src[0], conv_w, conv_b)
    uc = depthwise_conv(csrc[0], conv_w, conv_b)
    rec_lat, rec_ctx = [], []
    for d in range(2):
        rev = d == 1
        p = (lru_wa[d], lru_ba[d], lru_wx[d], lru_bx[d], lru_lam[d])
        ac, bc = rglru_coefficients(uc, *p)
        hcd = linear_scan(ac, bc, jnp.zeros_like(bc[:, 0]), rev)
        a, b = rglru_coefficients(u, *p)
        rec_lat.append(linear_scan(a, b, hcd[:, 0] if rev else hcd[:, -1], rev))
        rec_ctx.append(hcd)
    y_a = (jax.nn.gelu(qry[2]) * (rec_lat[0] + rec_lat[1])).astype(dt)

    cos, sin = rope
    rot_k = lambda t: rotate(t, cos, sin)
    rot_q = lambda t: rotate(t, cos[:, None, :], sin[:, None, :])

    def mla_keys(kvd, kr, rot):
        n = kvd.shape[1]
        kv = (rmsnorm(kvd, g_kv) @ w_ukv).reshape(B, n, MLA_HEADS, MLA_NOPE + MLA_V)
        kr = jnp.broadcast_to(rot(kr)[:, :, None, :], (B, n, MLA_HEADS, MLA_ROPE))
        return jnp.concatenate([kv[..., :MLA_NOPE], kr], axis=-1), kv[..., MLA_NOPE:]

    def mla_queries(qd, rot):
        n = qd.shape[1]
        q = (rmsnorm(qd, g_q) @ w_uq).reshape(B, n, MLA_HEADS, MLA_NOPE + MLA_ROPE)
        return jnp.concatenate([q[..., :MLA_NOPE], rot(q[..., MLA_NOPE:])], axis=-1)

    k_lat, v_lat = mla_keys(src[1], src[2], rot_k)
    k_ctx, v_ctx = mla_keys(csrc[1], csrc[2], ident)
    y_b = blocked_attention(mla_queries(qry[0], rot_q),
                            jnp.concatenate([k_ctx, k_lat], axis=1),
                            jnp.concatenate([v_ctx, v_lat], axis=1)).reshape(B, L, MLA_HEADS * MLA_V)

    rl_cos, rl_sin = ret_lat
    rc_cos, rc_sin = ret_ctx
    kscale = RET_DK ** -0.5
    heads = lambda t, dim: t.reshape(*t.shape[:2], RET_HEADS, dim)
    rq = rotate(heads(qry[1], RET_DK), rl_cos, rl_sin)
    rk = rotate(heads(src[3], RET_DK), rl_cos, rl_sin) * kscale
    rv = heads(src[4], RET_DV)
    crk = rotate(heads(csrc[3], RET_DK), rc_cos, rc_sin) * kscale
    crv = heads(csrc[4], RET_DV)
    crq = rotate(heads(cqry[1], RET_DK), rc_cos, rc_sin) if need_ctx_out else None
    ret_out, ret_out_c = [], []
    for d in range(2):
        f = flip if d == 1 else ident
        lg = log_decays[d]
        if need_ctx_out:
            r0 = jnp.zeros((B, RET_HEADS, RET_DK, RET_DV), crk.dtype)
            occ, r_ctx = retention_chunkwise(f(crq), f(crk), f(crv), lg, r0)
            ret_out_c.append(f(occ))
        else:
            r_ctx = retention_state(f(crk), f(crv), lg)
        ol, _ = retention_chunkwise(f(rq), f(rk), f(rv), lg, r_ctx)
        ret_out.append(f(ol))
    y_c = jax.nn.silu(qry[3]) * head_norm(ret_out[0] + ret_out[1]).reshape(B, L, RET_HEADS * RET_DV)

    def merge(ya, yb, yc, gm):
        ga, gb, gc = jnp.split(gm, 3, axis=-1)
        m = (jax.nn.sigmoid(ga) * (ya @ w_oa) + jax.nn.sigmoid(gb) * (yb @ w_ob)
             + jax.nn.sigmoid(gc) * (yc @ w_oc))
        return m @ w_out

    y = merge(y_a, y_b, y_c, qry[4])
    if not need_ctx_out:
        return y, None
    y_ac = (jax.nn.gelu(cqry[2]) * (rec_ctx[0] + rec_ctx[1])).astype(dt)
    y_bc = attention(mla_queries(cqry[0], ident), k_ctx, v_ctx).reshape(B, Lc, MLA_HEADS * MLA_V)
    y_cc = jax.nn.silu(cqry[3]) * head_norm(ret_out_c[0] + ret_out_c[1]).reshape(B, Lc, RET_HEADS * RET_DV)
    return y, merge(y_ac, y_bc, y_cc, cqry[4])


def setup_inputs(seed: int = 0) -> dict:
    key = jax.random.key(seed)
    ks = iter(jax.random.split(key, 32))
    f32 = jnp.float32
    D = D_MODEL

    def nrm(shape, scale):
        return jax.random.normal(next(ks), shape, f32) * scale

    u = jax.random.uniform(next(ks), (DEPTH, 2, LRU_WIDTH), f32, 0.9, 0.999)
    a = u ** (1.0 / LRU_C)
    lam = jnp.log(a) - jnp.log1p(-a)
    return {
        'x': nrm((BATCH, SEQ, D), 1.0),
        'c': nrm((BATCH, D), 1.0),
        'ctx': nrm((BATCH, CTX_LEN, D), 1.0),
        'c_ctx': nrm((D,), 1.0),
        'w_mod': nrm((DEPTH, D, 6 * D), 0.5 * D ** -0.5),
        'b_mod': nrm((DEPTH, 6 * D), 0.02),
        'g_mix': 1.0 + nrm((DEPTH, D), 0.02),
        'g_ffn': 1.0 + nrm((DEPTH, D), 0.02),
        'w_in': nrm((DEPTH, D, N_IN), D ** -0.5),
        'conv_w': nrm((DEPTH, CONV_W, LRU_WIDTH), CONV_W ** -0.5),
        'conv_b': nrm((DEPTH, LRU_WIDTH), 0.02),
        'lru_wa': nrm((DEPTH, 2, LRU_BLOCKS, LRU_BLOCK, LRU_BLOCK), LRU_BLOCK ** -0.5),
        'lru_ba': nrm((DEPTH, 2, LRU_WIDTH), 0.02),
        'lru_wx': nrm((DEPTH, 2, LRU_BLOCKS, LRU_BLOCK, LRU_BLOCK), LRU_BLOCK ** -0.5),
        'lru_bx': nrm((DEPTH, 2, LRU_WIDTH), 0.02),
        'lru_lam': lam,
        'g_q': 1.0 + nrm((DEPTH, Q_LORA), 0.02),
        'w_uq': nrm((DEPTH, Q_LORA, MLA_HEADS * (MLA_NOPE + MLA_ROPE)), Q_LORA ** -0.5),
        'g_kv': 1.0 + nrm((DEPTH, KV_LORA), 0.02),
        'w_ukv': nrm((DEPTH, KV_LORA, MLA_HEADS * (MLA_NOPE + MLA_V)), KV_LORA ** -0.5),
        'w_oa': nrm((DEPTH, LRU_WIDTH, D), LRU_WIDTH ** -0.5),
        'w_ob': nrm((DEPTH, MLA_HEADS * MLA_V, D), (MLA_HEADS * MLA_V) ** -0.5),
        'w_oc': nrm((DEPTH, RET_HEADS * RET_DV, D), (RET_HEADS * RET_DV) ** -0.5),
        'w_out': nrm((DEPTH, D, D), D ** -0.5),
        'w_ff1': nrm((DEPTH, D, D_FF), D ** -0.5),
        'w_ff3': nrm((DEPTH, D, D_FF), D ** -0.5),
        'w_ff2': nrm((DEPTH, D_FF, D), D_FF ** -0.5),
        'g_final': 1.0 + nrm((D,), 0.02),
    }


def reference(x, c, ctx, c_ctx, w_mod, b_mod, g_mix, g_ffn, w_in, conv_w, conv_b,
              lru_wa, lru_ba, lru_wx, lru_bx, lru_lam, g_q, w_uq, g_kv, w_ukv,
              w_oa, w_ob, w_oc, w_out, w_ff1, w_ff3, w_ff2, g_final):
    B, L, D = x.shape
    Lc = ctx.shape[1]
    dt = x.dtype
    rope = axial_rope_tables(L, dt)
    ret_lat = retention_rope_tables(Lc, L, dt)
    ret_ctx = retention_rope_tables(0, Lc, dt)
    log_decays = retention_log_decays()
    c_act = jax.nn.silu(c)
    cc_act = jax.nn.silu(c_ctx)
    xc = ctx
    for l in range(DEPTH):
        last = l == DEPTH - 1
        mod = c_act @ w_mod[l] + b_mod[l]
        sh_a, sc_a, ga_a, sh_f, sc_f, ga_f = [m[:, None, :] for m in jnp.split(mod, 6, axis=-1)]
        n_cm = 2 * D if last else 6 * D
        mc = jnp.split(cc_act @ w_mod[l][:, :n_cm] + b_mod[l][:n_cm], n_cm // D)
        h = modulate(rmsnorm(x, g_mix[l]), sh_a, sc_a)
        hc = modulate(rmsnorm(xc, g_mix[l]), mc[0], mc[1])
        y, yc = token_mixer(h, hc, w_in[l], conv_w[l], conv_b[l], lru_wa[l], lru_ba[l], lru_wx[l],
                            lru_bx[l], lru_lam[l], g_q[l], w_uq[l], g_kv[l], w_ukv[l],
                            w_oa[l], w_ob[l], w_oc[l], w_out[l],
                            rope, ret_lat, ret_ctx, log_decays, not last)
        x = x + ga_a * y
        x = x + ga_f * swiglu(modulate(rmsnorm(x, g_ffn[l]), sh_f, sc_f), w_ff1[l], w_ff3[l], w_ff2[l])
        if not last:
            xc = xc + mc[2] * yc
            xc = xc + mc[5] * swiglu(modulate(rmsnorm(xc, g_ffn[l]), mc[3], mc[4]),
                                     w_ff1[l], w_ff3[l], w_ff2[l])
    return rmsnorm(x, g_final)
```

```cpp
#include <hip/hip_runtime.h>
#include <hip/hip_cooperative_groups.h>
#include <cstdio>
namespace cg = cooperative_groups;

#define DI __device__ __forceinline__
typedef unsigned short bf16_t;
using bf16x8 = __attribute__((ext_vector_type(8))) short;
using s16x4 = __attribute__((ext_vector_type(4))) short;
using f32x16 = __attribute__((ext_vector_type(16))) float;
typedef __bf16 bf2_t __attribute__((ext_vector_type(2)));
typedef float f2_t __attribute__((ext_vector_type(2)));
#define MFMA(a, b, c) __builtin_amdgcn_mfma_f32_32x32x16_bf16((a), (b), (c), 0, 0, 0)

constexpr int NB = 8, SEQ = 4096, LC = 256, S = 4352, D = 1024, T = NB * S;
constexpr int ZS = 2816, DFF = 2816, NIN = 6304;
constexpr int HB = 4;
constexpr int TH = HB * S;
constexpr float EPS = 1e-6f;
constexpr int Z_LRUX = 0, Z_RETK = 512, Z_RETQ = 768, Z_KVD = 1024, Z_QD = 1280, Z_LGATE = 1664, Z_RGATE = 2176, Z_KR = 2688;
constexpr int Z_M = 0, Z_YB = 1024, Z_YA = 1664, Z_YC = 2176;
constexpr size_t W_IN = 0;
constexpr size_t W_G = W_IN + 3328ull * 1024;
constexpr size_t W_UQ = W_G + 3072ull * 1024;
constexpr size_t W_UK = W_UQ + 768ull * 384;
constexpr size_t W_UV = W_UK + 512ull * 256;
constexpr size_t W_L = W_UV + 512ull * 256;
constexpr size_t W_OA = W_L + 8ull * 256 * 64;
constexpr size_t W_OB = W_OA + 1024ull * 512;
constexpr size_t W_OC = W_OB + 1024ull * 512;
constexpr size_t W_OUT = W_OC + 1024ull * 512;
constexpr size_t W_FF13 = W_OUT + 1024ull * 1024;
constexpr size_t W_FF2 = W_FF13 + 5632ull * 1024;
constexpr size_t W_LAYER = W_FF2 + 1024ull * 2816;
constexpr size_t OFF_W = 0;
constexpr size_t OFF_MOD = OFF_W + 2 * W_LAYER * 2;
constexpr size_t OFF_AXC = OFF_MOD + 2ull * 9 * 6144 * 4;
constexpr size_t OFF_AXS = OFF_AXC + 4096ull * 16 * 4;
constexpr size_t OFF_RTC = OFF_AXS + 4096ull * 16 * 4;
constexpr size_t OFF_RTS = OFF_RTC + 4352ull * 32 * 4;
constexpr size_t OFF_XC = OFF_RTS + 4352ull * 32 * 4;
constexpr size_t OFF_H = OFF_XC + 2048ull * 1024 * 4;
constexpr size_t OFF_Z = OFF_H + (size_t)T * 1024 * 2;
constexpr size_t OFF_RVT = OFF_Z + (size_t)T * ZS * 2;
constexpr size_t OFF_Q = OFF_RVT + 8ull * 512 * S * 2;
constexpr size_t OFF_K = OFF_Q + (size_t)TH * 768 * 2;
constexpr size_t OFF_VT = OFF_K + 4ull * 8 * S * 96 * 2;
constexpr size_t OFF_CS = OFF_VT + 4ull * 8 * 64 * S * 2;
constexpr size_t OFF_AGG = OFF_CS + 4ull * 4 * 34 * 2 * 8192 * 4;
constexpr size_t OFF_H0 = OFF_AGG + 8ull * 2 * 68 * 512 * 8;
constexpr size_t OFF_CSB = OFF_H0 + 8ull * 2 * 68 * 512 * 4;
constexpr size_t OFF_BAR = OFF_CSB + 4ull * 4 * 34 * 2 * 8192 * 2;
constexpr size_t BAR_BYTES = 3456 * 4;
constexpr size_t WS_TOTAL = OFF_BAR + 16384;

constexpr int NT = 512;
constexpr int SMEM_BYTES = 135168;
constexpr int SM_AUX = 131072;

struct Params {
  const float *x, *c, *ctx, *c_ctx, *w_mod, *b_mod, *g_mix, *g_ffn, *w_in, *conv_w, *conv_b, *lru_wa, *lru_ba, *lru_wx,
      *lru_bx, *lru_lam, *g_q, *w_uq, *g_kv, *w_ukv, *w_oa, *w_ob, *w_oc, *w_out, *w_ff1, *w_ff3, *w_ff2, *g_final;
  float* out;
  char* ws;
};

DI unsigned pk2(float a, float b) { f2_t v = {a, b}; bf2_t r = __builtin_convertvector(v, bf2_t); return __builtin_bit_cast(unsigned, r); }
DI bf16_t f2bf(float a) { return (bf16_t)(pk2(a, 0.f) & 0xffffu); }
DI float bf2f(unsigned b) { return __uint_as_float(b << 16); }
DI float bflo(unsigned u) { return __uint_as_float(u << 16); }
DI float bfhi(unsigned u) { return __uint_as_float(u & 0xffff0000u); }
DI bf16x8 pack8(float a0, float a1, float a2, float a3, float a4, float a5, float a6, float a7) {
  uint4 u; u.x = pk2(a0, a1); u.y = pk2(a2, a3); u.z = pk2(a4, a5); u.w = pk2(a6, a7);
  return __builtin_bit_cast(bf16x8, u);
}
DI float sigmoidf_(float x) { return __builtin_amdgcn_rcpf(1.f + __builtin_amdgcn_exp2f(-1.4426950408889634f * x)); }
DI float siluf_(float x) { return x * sigmoidf_(x); }
DI float geluf_(float x) { return x * sigmoidf_(1.5957691216057308f * (x + 0.044715f * x * x * x)); }
DI float log1p_pos(float e) { return e < 0.05f ? e * (1.f + e * (-0.5f + e * (0.33333334f + e * (-0.25f + e * 0.2f)))) : __logf(1.f + e); }
DI float expm1_neg(float x) { return x > -0.1f ? x * (1.f + x * (0.5f + x * (0.16666667f + x * (0.041666668f + x * 0.008333334f)))) : __expf(x) - 1.f; }
DI float fexp2(float x) { return __builtin_amdgcn_exp2f(x); }
DI float wave_sum(float v) {
#pragma unroll
  for (int o = 32; o >= 1; o >>= 1) v += __shfl_xor(v, o);
  return v;
}
DI int get_tid() { int t = threadIdx.x; asm volatile("" : "+v"(t)); return t; }
#define MEMBAR() asm volatile("" ::: "memory")
DI int crow(int i, int h) { return (i & 3) + 8 * (i >> 2) + 4 * h; }
DI f32x16 zero16() { f32x16 z; for (int i = 0; i < 16; ++i) z[i] = 0.f; return z; }

DI bf16_t* wl(const Params& p, int layer) { return (bf16_t*)(p.ws + OFF_W) + (size_t)layer * W_LAYER; }
DI float* modp(const Params& p, int layer, int g, int chunk) { return (float*)(p.ws + OFF_MOD) + ((size_t)(layer * 9 + g) * 6 + chunk) * 1024; }
DI const float* xrow_in(const Params& p, int t) { int b = t / S, s = t - b * S; return s < LC ? p.ctx + ((size_t)b * LC + s) * D : p.x + ((size_t)b * SEQ + (s - LC)) * D; }
DI float* xrow_ws(const Params& p, int t) { int b = t / S, s = t - b * S; return s < LC ? (float*)(p.ws + OFF_XC) + ((size_t)b * LC + s) * D : p.out + ((size_t)b * SEQ + (s - LC)) * D; }


#define LAS3 __attribute__((address_space(3)))
#define XB_TMO      128
#define XB_XCNT(j)  (256  + 64 * (j))
#define XB_XSUB(j)  (1280 + 64 * (j))
#define XB_XGEN(j)  (2304 + 64 * (j))
#define XB_TOP      3328
#define XB_TOPGEN   3392
#define XB_SPIN_CAP (1u << 22)
DI unsigned xb_ld(unsigned* p) { return __hip_atomic_load(p, __ATOMIC_RELAXED, __HIP_MEMORY_SCOPE_AGENT); }
DI unsigned xb_add(unsigned* p, unsigned v) { return __hip_atomic_fetch_add(p, v, __ATOMIC_RELAXED, __HIP_MEMORY_SCOPE_AGENT); }
DI unsigned xb_xcc_id() { return (unsigned)__builtin_amdgcn_s_getreg((3 << 11) | 20) & 0xFu; }
#define XB_SPIN(cond, bar) do { unsigned _sp = 0; while (cond) { __builtin_amdgcn_s_sleep(1); \
    if ((++_sp & 255u) == 0u) { if (xb_ld(&(bar)[XB_TMO])) break; if (_sp > XB_SPIN_CAP) { atomicAdd(&(bar)[XB_TMO], 1u); break; } } } } while (0)
struct XcdBarrier { unsigned* bar; unsigned x; volatile LAS3 unsigned* st; };
DI XcdBarrier xcd_barrier_post(unsigned* bar, volatile LAS3 unsigned* st) {
  XcdBarrier b; b.bar = bar; b.x = xb_xcc_id(); b.st = st;
  if (threadIdx.x == 0) (void)xb_add(&bar[XB_XCNT(b.x)], 1u);
  return b;
}
DI void xcd_barrier_complete(unsigned* bar, unsigned x, unsigned& nloc, unsigned& nx) {
  const unsigned G = gridDim.x * gridDim.y * gridDim.z;
  unsigned sum, cnt, mine, sp = 0u;
  for (;;) {
    sum = 0u; cnt = 0u; mine = 0u;
#pragma unroll
    for (unsigned j = 0; j < 16; ++j) { const unsigned c = xb_ld(&bar[XB_XCNT(j)]); sum += c; cnt += (c > 0u) ? 1u : 0u; mine = (j == x) ? c : mine; }
    if (sum == G) break;
    __builtin_amdgcn_s_sleep(1);
    if ((++sp & 255u) == 0u) { if (xb_ld(&bar[XB_TMO])) break; if (sp > XB_SPIN_CAP) { atomicAdd(&bar[XB_TMO], 1u); break; } }
  }
  nloc = mine > 0u ? mine : 1u; nx = cnt > 0u ? cnt : 1u;
}
DI void xcd_barrier(const XcdBarrier& b) {
  asm volatile("s_waitcnt vmcnt(0)" ::: "memory");
  __syncthreads();
  if (threadIdx.x == 0) {
    unsigned* bar = b.bar;
    __builtin_amdgcn_s_waitcnt(0);
    unsigned nloc = b.st[0], nx = b.st[1];
    if (nloc == 0u) { xcd_barrier_complete(bar, b.x, nloc, nx); b.st[0] = nloc; b.st[1] = nx; }
    const unsigned old = xb_add(&bar[XB_XSUB(b.x)], 1u);
    const unsigned gen = old / nloc;
    if (old + 1u == (gen + 1u) * nloc) {
      __builtin_amdgcn_fence(__ATOMIC_RELEASE, "agent");
      asm volatile("s_waitcnt vmcnt(0)" ::: "memory");
      const unsigned og = xb_add(&bar[XB_TOP], 1u);
      const unsigned tg = og / nx;
      if (og + 1u == (tg + 1u) * nx) xb_add(&bar[XB_TOPGEN], 1u);
      else XB_SPIN(xb_ld(&bar[XB_TOPGEN]) == tg, bar);
      __builtin_amdgcn_fence(__ATOMIC_ACQUIRE, "agent");
      xb_add(&bar[XB_XGEN(b.x)], 1u);
      asm volatile("s_waitcnt vmcnt(0)" ::: "memory");
    } else {
      XB_SPIN(xb_ld(&bar[XB_XGEN(b.x)]) == gen, bar);
      __builtin_amdgcn_fence(__ATOMIC_ACQUIRE, "agent");
      asm volatile("s_waitcnt vmcnt(0)" ::: "memory");
    }
  }
  __syncthreads();
}
#define LAS __attribute__((address_space(3)))
using f32x4 = __attribute__((ext_vector_type(4))) float;
using u32x4 = __attribute__((ext_vector_type(4))) unsigned;
constexpr int BM = 256, BK = 64, HALF = 128, HTB = HALF * BK * 2, NXCD = 8, WGM = 8;
DI int lds_byte(int r, int c) { const int st = (r >> 4) * 2 + (c >> 5), rr = r & 15, cc = c & 31, ob = rr * 64 + cc * 2; return st * 1024 + (ob ^ (((ob >> 9) & 1) << 5)); }
DI void stage_rc(int b, int& R, int& C) { const int st = b / 1024, sb = b % 1024, swz = sb ^ (((sb >> 9) & 1) << 5); R = (st >> 1) * 16 + swz / 64; C = (st & 1) * 32 + (swz % 64) / 2; }
DI int perm32(int rho) { const int n = rho >> 4, i = rho & 15; return 8 * (i >> 2) + 4 * n + (i & 3); }
struct Unit { int pm, pn; };
struct Order {
  int nM, nN, nwg, G, c, skip;
  DI void init(int nM_, int nN_, int skip_, int c_ = -1) { nM = nM_; nN = nN_; nwg = nM * nN; G = gridDim.x; c = c_ < 0 ? (int)blockIdx.x : c_; skip = skip_; }
  DI bool next(int i, Unit& u) const {
    const long L = (long)i * G + c; if (L >= nwg) return false;
    int wgid = (int)L; { const int q = nwg / NXCD, r = nwg % NXCD, xcd = wgid % NXCD, off = wgid / NXCD; wgid = (xcd < r ? xcd * (q + 1) : r * (q + 1) + (xcd - r) * q) + off; }
    const int nig = WGM * nN, gid = wgid / nig, fm = gid * WGM, gsz = (nM - fm) < WGM ? (nM - fm) : WGM;
    int pm = fm + ((wgid % nig) % gsz); u.pn = (wgid % nig) / gsz;
    if (skip) pm = pm + pm / 16 + 1;
    u.pm = pm; return true;
  }
};
typedef f32x4 acc_t[2][2][4][2];

template <class Epi>
DI void gemm_phase(char* smem, const bf16_t* A, int lda, const bf16_t* Bt, int ldb, int K, const Order& S_, const Epi& E) {
  LAS unsigned char* lds = (LAS unsigned char*)smem;
  const int tid = get_tid(), wid = __builtin_amdgcn_readfirstlane(tid >> 6), lane = tid & 63, wr = wid >> 2, wc = wid & 3, fr = lane & 15, fq = lane >> 4;
  const int nt = K / BK;
  unsigned voffA[2], voffB[2];
#pragma unroll
  for (int i = 0; i < 2; ++i) { int R, C; stage_rc(tid * 16 + i * 8192, R, C); const int Rb = Epi::PERM ? ((R & ~31) + perm32(R & 31)) : R;
    voffA[i] = (unsigned)(R * lda + C) * 2u; voffB[i] = (unsigned)(Rb * ldb + C) * 2u; }
  const size_t kstep = (size_t)(BK * 2);
  const size_t hstepA = (size_t)HALF * lda * 2, hstepB = (size_t)HALF * ldb * 2;
  const size_t tstepA = 2 * hstepA, tstepB = 2 * hstepB;
  const unsigned ldsw = (unsigned)wid * 1024u;
  const int aoff = lds_byte(wr * 64 + fr, fq * 8), boff = lds_byte(wc * 32 + fr, fq * 8);
#define PG8_SA(b, h) (((b) * 2 + (h)) * HTB)
#define PG8_SB(b, h) ((4 + (b) * 2 + (h)) * HTB)
#define PG8_STAGE(bufoff, gbase, voff) do { _Pragma("unroll") for (int _i = 0; _i < 2; ++_i) \
    __builtin_amdgcn_global_load_lds((const unsigned*)((const char*)(gbase) + (voff)[_i]), (LAS unsigned*)(lds + (bufoff) + ldsw + _i * 8192), 16, 0, 0); } while (0)
#define PG8_LDA(dst, b, h) do { _Pragma("unroll") for (int m = 0; m < 4; ++m) _Pragma("unroll") for (int k = 0; k < 2; ++k) dst[m][k] = *(const LAS bf16x8*)(lds + PG8_SA(b, h) + aoff + m * 2048 + k * 1024); } while (0)
#define PG8_LDB(dst, b, h) do { _Pragma("unroll") for (int n = 0; n < 2; ++n) _Pragma("unroll") for (int k = 0; k < 2; ++k) dst[n][k] = *(const LAS bf16x8*)(lds + PG8_SB(b, h) + boff + n * 2048 + k * 1024); } while (0)
#define PG8_MMA(ai, bj, At, Bt_) do { __builtin_amdgcn_s_setprio(1); _Pragma("unroll") for (int m = 0; m < 4; ++m) _Pragma("unroll") for (int n = 0; n < 2; ++n) _Pragma("unroll") for (int k = 0; k < 2; ++k) \
    acc[ai][bj][m][n] = __builtin_amdgcn_mfma_f32_16x16x32_bf16(Bt_[n][k], At[m][k], acc[ai][bj][m][n], 0, 0, 0); __builtin_amdgcn_s_setprio(0); } while (0)
#define PG8_WAIT_V(n) asm volatile("s_waitcnt vmcnt(" #n ")" ::: "memory")
#define PG8_WAIT_L(n) asm volatile("s_waitcnt lgkmcnt(" #n ")" ::: "memory")
#define PG8_BAR __builtin_amdgcn_s_barrier()
#define PG8_SCHED __builtin_amdgcn_sched_barrier(0)
  Unit cur, nxt; int ui = 0;
  if (!S_.next(0, cur)) return;
  f32x4 acc[2][2][4][2];
#pragma unroll
  for (int a = 0; a < 2; ++a)
#pragma unroll
    for (int b = 0; b < 2; ++b)
#pragma unroll
      for (int m = 0; m < 4; ++m)
#pragma unroll
        for (int n = 0; n < 2; ++n) acc[a][b][m][n] = (f32x4){0.f, 0.f, 0.f, 0.f};
  bf16x8 At[4][2], B0[2][2], B1[2][2];
  const char* cA = (const char*)A + (size_t)cur.pm * tstepA; const char* cB = (const char*)Bt + (size_t)cur.pn * tstepB;
  PG8_STAGE(PG8_SB(0, 0), cB, voffB); PG8_STAGE(PG8_SA(0, 0), cA, voffA); PG8_STAGE(PG8_SB(0, 1), cB + hstepB, voffB); PG8_STAGE(PG8_SA(0, 1), cA + hstepA, voffA);
  if (wr == 1) PG8_BAR;
  PG8_WAIT_V(4); PG8_BAR;
  PG8_STAGE(PG8_SB(1, 0), cB + kstep, voffB); PG8_STAGE(PG8_SA(1, 0), cA + kstep, voffA); PG8_STAGE(PG8_SB(1, 1), cB + hstepB + kstep, voffB);
  PG8_WAIT_V(6); PG8_BAR;
  for (;;) {
    const bool has_next = S_.next(ui + 1, nxt);
    const char* nA = has_next ? (const char*)A + (size_t)nxt.pm * tstepA : cA; const char* nB = has_next ? (const char*)Bt + (size_t)nxt.pn * tstepB : cB;
    for (int t = 0; t < nt; t += 2) {
      const bool last = (t == nt - 2);
      const char* a1 = cA + (size_t)(t + 1) * kstep;
      const char* a2 = last ? nA : cA + (size_t)(t + 2) * kstep; const char* b2 = last ? nB : cB + (size_t)(t + 2) * kstep;
      const char* a3 = a2 + kstep; const char* b3 = b2 + kstep;
      PG8_LDB(B0, 0, 0); PG8_SCHED; PG8_LDA(At, 0, 0); PG8_STAGE(PG8_SA(1, 1), a1 + hstepA, voffA);
      PG8_WAIT_L(8); PG8_BAR; PG8_WAIT_L(0); PG8_MMA(0, 0, At, B0); PG8_BAR; PG8_SCHED;
      PG8_LDB(B1, 0, 1); PG8_STAGE(PG8_SB(0, 0), b2, voffB);
      PG8_BAR; PG8_WAIT_L(0); PG8_MMA(0, 1, At, B1); PG8_BAR;
      PG8_LDA(At, 0, 1); PG8_STAGE(PG8_SA(0, 0), a2, voffA);
      PG8_BAR; PG8_WAIT_L(0); PG8_MMA(1, 0, At, B0); PG8_BAR; PG8_SCHED;
      PG8_STAGE(PG8_SB(0, 1), b2 + hstepB, voffB);
      PG8_WAIT_V(6); PG8_BAR; PG8_MMA(1, 1, At, B1); PG8_BAR;
      PG8_LDB(B0, 1, 0); PG8_SCHED; PG8_LDA(At, 1, 0); PG8_STAGE(PG8_SA(0, 1), a2 + hstepA, voffA);
      PG8_WAIT_L(8); PG8_BAR; PG8_WAIT_L(0); PG8_MMA(0, 0, At, B0); PG8_BAR; PG8_SCHED;
      PG8_LDB(B1, 1, 1); PG8_STAGE(PG8_SB(1, 0), b3, voffB);
      PG8_BAR; PG8_WAIT_L(0); PG8_MMA(0, 1, At, B1); PG8_BAR;
      PG8_LDA(At, 1, 1); PG8_STAGE(PG8_SA(1, 0), a3, voffA);
      PG8_BAR; PG8_WAIT_L(0); PG8_MMA(1, 0, At, B0); PG8_BAR; PG8_SCHED;
      PG8_STAGE(PG8_SB(1, 1), b3 + hstepB, voffB);
      PG8_WAIT_V(6); PG8_BAR; PG8_MMA(1, 1, At, B1); PG8_BAR;
    }
    E(acc, cur, wr, wc, fr, fq);
    if (!has_next) break;
#pragma unroll
    for (int a = 0; a < 2; ++a)
#pragma unroll
      for (int b = 0; b < 2; ++b)
#pragma unroll
        for (int m = 0; m < 4; ++m)
#pragma unroll
          for (int n = 0; n < 2; ++n) acc[a][b][m][n] = (f32x4){0.f, 0.f, 0.f, 0.f};
    cur = nxt; cA = nA; cB = nB; ++ui;
  }
  PG8_WAIT_V(0);
  if (wr == 0) PG8_BAR;
  PG8_BAR;
#undef PG8_SA
#undef PG8_SB
#undef PG8_STAGE
#undef PG8_LDA
#undef PG8_LDB
#undef PG8_MMA
#undef PG8_WAIT_V
#undef PG8_WAIT_L
#undef PG8_BAR
#undef PG8_SCHED
}
DI u32x4 pack8v(const f32x4& a, const f32x4& b) { u32x4 w; w.x = pk2(a[0], a[1]); w.y = pk2(a[2], a[3]); w.z = pk2(b[0], b[1]); w.w = pk2(b[2], b[3]); return w; }

struct EpiStoreBf16 {
  static constexpr bool PERM = true;
  bf16_t* O; int ldc;
  DI void operator()(const acc_t& acc, const Unit& u, int wr, int wc, int fr, int fq) const {
    const int row0 = u.pm * BM + wr * 64 + fr, col0 = u.pn * BM + wc * 32 + 8 * fq;
#pragma unroll
    for (int ai = 0; ai < 2; ++ai)
#pragma unroll
      for (int m = 0; m < 4; ++m) { bf16_t* rowp = O + (size_t)(row0 + ai * HALF + m * 16) * ldc + col0;
#pragma unroll
        for (int bj = 0; bj < 2; ++bj) *(u32x4*)(rowp + bj * HALF) = pack8v(acc[ai][bj][m][0], acc[ai][bj][m][1]); }
  }
};
struct EpiTokT {
  static constexpr bool PERM = true;
  bf16_t* O; int rows_per_b;
  DI void operator()(const acc_t& acc, const Unit& u, int wr, int wc, int fr, int fq) const {
    const int row0 = u.pm * BM + wr * 64 + fr;
    const int t0 = u.pn * BM, b = t0 / S, s0 = t0 - b * S + wc * 32 + 8 * fq;
#pragma unroll
    for (int ai = 0; ai < 2; ++ai)
#pragma unroll
      for (int m = 0; m < 4; ++m) { bf16_t* rowp = O + ((size_t)b * rows_per_b + row0 + ai * HALF + m * 16) * S + s0;
#pragma unroll
        for (int bj = 0; bj < 2; ++bj) *(u32x4*)(rowp + bj * HALF) = pack8v(acc[ai][bj][m][0], acc[ai][bj][m][1]); }
  }
};
constexpr float QSCALE = 0.10206207261596577f * 1.4426950408889634f;
struct EpiK {
  static constexpr bool PERM = true;
  bf16_t* Kb;
  DI void operator()(const acc_t& acc, const Unit& u, int wr, int wc, int fr, int fq) const {
    const int row0 = u.pm * BM + wr * 64 + fr;
#pragma unroll
    for (int ai = 0; ai < 2; ++ai)
#pragma unroll
      for (int m = 0; m < 4; ++m) { const int tl = row0 + ai * HALF + m * 16, bl = tl / S, s = tl - bl * S;
#pragma unroll
        for (int bj = 0; bj < 2; ++bj) { const int c = u.pn * BM + bj * HALF + wc * 32 + 8 * fq, head = c >> 6, j = c & 63;
          *(u32x4*)(Kb + ((size_t)(bl * 8 + head) * S + s) * 96 + j) = pack8v(acc[ai][bj][m][0], acc[ai][bj][m][1]); } }
  }
};
struct EpiMergeG {
  static constexpr bool PERM = true;
  const bf16_t* P; bf16_t* M; int first;
  DI void operator()(const acc_t& acc, const Unit& u, int wr, int wc, int fr, int fq) const {
    const int row0 = u.pm * BM + wr * 64 + fr, col0 = u.pn * BM + wc * 32 + 8 * fq;
#pragma unroll
    for (int ai = 0; ai < 2; ++ai)
#pragma unroll
      for (int m = 0; m < 4; ++m) { const int row = row0 + ai * HALF + m * 16;
#pragma unroll
        for (int bj = 0; bj < 2; ++bj) {
          const u32x4 pv = *(const u32x4*)(P + (size_t)row * 1024 + col0 + bj * HALF);
          bf16_t* mp = M + (size_t)row * ZS + col0 + bj * HALF;
          f32x4 r0, r1;
          const f32x4& g0 = acc[ai][bj][m][0]; const f32x4& g1 = acc[ai][bj][m][1];
          r0[0] = sigmoidf_(g0[0]) * bflo(pv.x); r0[1] = sigmoidf_(g0[1]) * bfhi(pv.x); r0[2] = sigmoidf_(g0[2]) * bflo(pv.y); r0[3] = sigmoidf_(g0[3]) * bfhi(pv.y);
          r1[0] = sigmoidf_(g1[0]) * bflo(pv.z); r1[1] = sigmoidf_(g1[1]) * bfhi(pv.z); r1[2] = sigmoidf_(g1[2]) * bflo(pv.w); r1[3] = sigmoidf_(g1[3]) * bfhi(pv.w);
          if (!first) { const u32x4 mv = *(const u32x4*)mp;
            r0[0] += bflo(mv.x); r0[1] += bfhi(mv.x); r0[2] += bflo(mv.y); r0[3] += bfhi(mv.y); r1[0] += bflo(mv.z); r1[1] += bfhi(mv.z); r1[2] += bflo(mv.w); r1[3] += bfhi(mv.w); }
          *(u32x4*)mp = pack8v(r0, r1); } }
  }
};

struct Desc { const char* A; const char* B; int lda, ldb, nt, pm, pn, kind; };
template <class Sched, class Epi>
DI void gemm_stream(char* smem, const Sched& S_, const Epi& E) {
  LAS unsigned char* lds = (LAS unsigned char*)smem;
  const int tid = get_tid(), wid = __builtin_amdgcn_readfirstlane(tid >> 6), lane = tid & 63, wr = wid >> 2, wc = wid & 3, fr = lane & 15, fq = lane >> 4;
  int R0, C0, R1, C1;
  stage_rc(tid * 16, R0, C0); stage_rc(tid * 16 + 8192, R1, C1);
  const int Rb0 = Epi::PERM ? ((R0 & ~31) + perm32(R0 & 31)) : R0, Rb1 = Epi::PERM ? ((R1 & ~31) + perm32(R1 & 31)) : R1;
  C0 *= 2; C1 *= 2;
  const size_t kstep = (size_t)(BK * 2);
  const unsigned ldsw = (unsigned)wid * 1024u;
  const int aoff = lds_byte(wr * 64 + fr, fq * 8), boff = lds_byte(wc * 32 + fr, fq * 8);
#define PG8_SA(b, h) (((b) * 2 + (h)) * HTB)
#define PG8_SB(b, h) ((4 + (b) * 2 + (h)) * HTB)
#define PG8_STAGE3(bufoff, gbase, ld2, RA, RB) do { \
    __builtin_amdgcn_global_load_lds((const unsigned*)((const char*)(gbase) + (unsigned)((RA) * (ld2) + C0)), (LAS unsigned*)(lds + (bufoff) + ldsw), 16, 0, 0); \
    __builtin_amdgcn_global_load_lds((const unsigned*)((const char*)(gbase) + (unsigned)((RB) * (ld2) + C1)), (LAS unsigned*)(lds + (bufoff) + ldsw + 8192), 16, 0, 0); } while (0)
#define PG8_STA(bufoff, gbase, ld2) PG8_STAGE3(bufoff, gbase, ld2, R0, R1)
#define PG8_STB(bufoff, gbase, ld2) PG8_STAGE3(bufoff, gbase, ld2, Rb0, Rb1)
#define PG8_LDA(dst, b, h) do { _Pragma("unroll") for (int m = 0; m < 4; ++m) _Pragma("unroll") for (int k = 0; k < 2; ++k) dst[m][k] = *(const LAS bf16x8*)(lds + PG8_SA(b, h) + aoff + m * 2048 + k * 1024); } while (0)
#define PG8_LDB(dst, b, h) do { _Pragma("unroll") for (int n = 0; n < 2; ++n) _Pragma("unroll") for (int k = 0; k < 2; ++k) dst[n][k] = *(const LAS bf16x8*)(lds + PG8_SB(b, h) + boff + n * 2048 + k * 1024); } while (0)
#define PG8_MMA(ai, bj, At, Bt_) do { __builtin_amdgcn_s_setprio(1); _Pragma("unroll") for (int m = 0; m < 4; ++m) _Pragma("unroll") for (int n = 0; n < 2; ++n) _Pragma("unroll") for (int k = 0; k < 2; ++k) \
    acc[ai][bj][m][n] = __builtin_amdgcn_mfma_f32_16x16x32_bf16(Bt_[n][k], At[m][k], acc[ai][bj][m][n], 0, 0, 0); __builtin_amdgcn_s_setprio(0); } while (0)
#define PG8_WAIT_V(n) asm volatile("s_waitcnt vmcnt(" #n ")" ::: "memory")
#define PG8_WAIT_L(n) asm volatile("s_waitcnt lgkmcnt(" #n ")" ::: "memory")
#define PG8_BAR __builtin_amdgcn_s_barrier()
#define PG8_SCHED __builtin_amdgcn_sched_barrier(0)
  Desc cur, nxt; int ui = 0;
  if (!S_.next(0, cur)) return;
  f32x4 acc[2][2][4][2];
#pragma unroll
  for (int a = 0; a < 2; ++a)
#pragma unroll
    for (int b = 0; b < 2; ++b)
#pragma unroll
      for (int m = 0; m < 4; ++m)
#pragma unroll
        for (int n = 0; n < 2; ++n) acc[a][b][m][n] = (f32x4){0.f, 0.f, 0.f, 0.f};
  bf16x8 At[4][2], B0[2][2], B1[2][2];
  const char* cA = cur.A; const char* cB = cur.B;
  {
    const int la2 = cur.lda * 2, lb2 = cur.ldb * 2; const size_t hA = (size_t)HALF * la2, hB = (size_t)HALF * lb2;
    PG8_STB(PG8_SB(0, 0), cB, lb2); PG8_STA(PG8_SA(0, 0), cA, la2); PG8_STB(PG8_SB(0, 1), cB + hB, lb2); PG8_STA(PG8_SA(0, 1), cA + hA, la2);
    if (wr == 1) PG8_BAR;
    PG8_WAIT_V(4); PG8_BAR;
    PG8_STB(PG8_SB(1, 0), cB + kstep, lb2); PG8_STA(PG8_SA(1, 0), cA + kstep, la2); PG8_STB(PG8_SB(1, 1), cB + hB + kstep, lb2);
    PG8_WAIT_V(6); PG8_BAR;
  }
  for (;;) {
    const bool has_next = S_.next(ui + 1, nxt);
    if (!has_next) nxt = cur;
    const char* nA = nxt.A; const char* nB = nxt.B;
    const int nt = cur.nt;
    const int la2 = cur.lda * 2; const size_t hA = (size_t)HALF * la2;
    for (int t = 0; t < nt; t += 2) {
      const bool last = (t == nt - 2);
      const char* a1 = cA + (size_t)(t + 1) * kstep;
      const char* a2 = last ? nA : cA + (size_t)(t + 2) * kstep; const char* b2 = last ? nB : cB + (size_t)(t + 2) * kstep;
      const char* a3 = a2 + kstep; const char* b3 = b2 + kstep;
      const int xa2 = (last ? nxt.lda : cur.lda) * 2, xb2 = (last ? nxt.ldb : cur.ldb) * 2;
      const size_t xhA = (size_t)HALF * xa2, xhB = (size_t)HALF * xb2;
      PG8_LDB(B0, 0, 0); PG8_SCHED; PG8_LDA(At, 0, 0); PG8_STA(PG8_SA(1, 1), a1 + hA, la2);
      PG8_WAIT_L(8); PG8_BAR; PG8_WAIT_L(0); PG8_MMA(0, 0, At, B0); PG8_BAR; PG8_SCHED;
      PG8_LDB(B1, 0, 1); PG8_STB(PG8_SB(0, 0), b2, xb2);
      PG8_BAR; PG8_WAIT_L(0); PG8_MMA(0, 1, At, B1); PG8_BAR;
      PG8_LDA(At, 0, 1); PG8_STA(PG8_SA(0, 0), a2, xa2);
      PG8_BAR; PG8_WAIT_L(0); PG8_MMA(1, 0, At, B0); PG8_BAR; PG8_SCHED;
      PG8_STB(PG8_SB(0, 1), b2 + xhB, xb2);
      PG8_WAIT_V(6); PG8_BAR; PG8_MMA(1, 1, At, B1); PG8_BAR;
      PG8_LDB(B0, 1, 0); PG8_SCHED; PG8_LDA(At, 1, 0); PG8_STA(PG8_SA(0, 1), a2 + xhA, xa2);
      PG8_WAIT_L(8); PG8_BAR; PG8_WAIT_L(0); PG8_MMA(0, 0, At, B0); PG8_BAR; PG8_SCHED;
      PG8_LDB(B1, 1, 1); PG8_STB(PG8_SB(1, 0), b3, xb2);
      PG8_BAR; PG8_WAIT_L(0); PG8_MMA(0, 1, At, B1); PG8_BAR;
      PG8_LDA(At, 1, 1); PG8_STA(PG8_SA(1, 0), a3, xa2);
      PG8_BAR; PG8_WAIT_L(0); PG8_MMA(1, 0, At, B0); PG8_BAR; PG8_SCHED;
      PG8_STB(PG8_SB(1, 1), b3 + xhB, xb2);
      PG8_WAIT_V(6); PG8_BAR; PG8_MMA(1, 1, At, B1); PG8_BAR;
    }
    E(acc, cur, wr, wc, fr, fq);
    if (!has_next) break;
#pragma unroll
    for (int a = 0; a < 2; ++a)
#pragma unroll
      for (int b = 0; b < 2; ++b)
#pragma unroll
        for (int m = 0; m < 4; ++m)
#pragma unroll
          for (int n = 0; n < 2; ++n) acc[a][b][m][n] = (f32x4){0.f, 0.f, 0.f, 0.f};
    cur = nxt; cA = nA; cB = nB; ++ui;
  }
  PG8_WAIT_V(0);
  if (wr == 0) PG8_BAR;
  PG8_BAR;
#undef PG8_SA
#undef PG8_SB
#undef PG8_STAGE3
#undef PG8_STA
#undef PG8_STB
#undef PG8_LDA
#undef PG8_LDB
#undef PG8_MMA
#undef PG8_WAIT_V
#undef PG8_WAIT_L
#undef PG8_BAR
#undef PG8_SCHED
}

struct MergeSched {
  const bf16_t* H; const bf16_t* Z; const bf16_t* W; int nM, skip, G, c;
  DI bool next(int i, Desc& d) const {
    const int tseq = i / 6, step = i - tseq * 6, x = step >> 1, isg = step & 1;
    const long L = (long)tseq * G + c; const int nwg = nM * 4; if (L >= nwg) return false;
    int wgid = (int)L; { const int q = nwg / NXCD, r = nwg % NXCD, xcd = wgid % NXCD, off = wgid / NXCD; wgid = (xcd < r ? xcd * (q + 1) : r * (q + 1) + (xcd - r) * q) + off; }
    const int nig = WGM * 4, gid = wgid / nig, fm = gid * WGM, gsz = (nM - fm) < WGM ? (nM - fm) : WGM;
    int pm = fm + ((wgid % nig) % gsz); const int pn = (wgid % nig) / gsz;
    if (skip) pm = pm + pm / 16 + 1;
    d.pm = pm; d.pn = pn; d.kind = step;
    if (isg) { d.A = (const char*)(H + (size_t)pm * 256 * 1024); d.lda = 1024; d.B = (const char*)(W + W_G + (size_t)(x * 1024 + pn * 256) * 1024); d.ldb = 1024; d.nt = 16; }
    else { const int yc = x == 0 ? Z_YA : (x == 1 ? Z_YB : Z_YC);
      d.A = (const char*)(Z + (size_t)pm * 256 * ZS + yc); d.lda = ZS; d.B = (const char*)(W + W_OA + (size_t)x * 1024 * 512 + (size_t)pn * 256 * 512); d.ldb = 512; d.nt = 8; }
    return true;
  }
};
struct EpiMergeS {
  static constexpr bool PERM = true;
  u32x4* slab; bf16_t* M;
  DI void operator()(const acc_t& acc, const Desc& u, int wr, int wc, int fr, int fq) const {
    u32x4* sp = slab + get_tid(); asm volatile("" : "+v"(sp));
    if (!(u.kind & 1)) {
#pragma unroll
      for (int ai = 0; ai < 2; ++ai)
#pragma unroll
        for (int m = 0; m < 4; ++m)
#pragma unroll
          for (int bj = 0; bj < 2; ++bj) sp[((ai * 4 + m) * 2 + bj) * 512] = pack8v(acc[ai][bj][m][0], acc[ai][bj][m][1]);
    } else {
      const int first = u.kind == 1;
      const int row0 = u.pm * BM + wr * 64 + fr, col0 = u.pn * BM + wc * 32 + 8 * fq;
#pragma unroll
      for (int ai = 0; ai < 2; ++ai) {
        MEMBAR();
        u32x4 pv[4][2], mv[4][2];
#pragma unroll
        for (int m = 0; m < 4; ++m)
#pragma unroll
          for (int bj = 0; bj < 2; ++bj) {
            pv[m][bj] = sp[((ai * 4 + m) * 2 + bj) * 512];
            if (!first) mv[m][bj] = *(const u32x4*)(M + (size_t)(row0 + ai * HALF + m * 16) * ZS + col0 + bj * HALF);
          }
#pragma unroll
        for (int m = 0; m < 4; ++m)
#pragma unroll
          for (int bj = 0; bj < 2; ++bj) {
            bf16_t* mp = M + (size_t)(row0 + ai * HALF + m * 16) * ZS + col0 + bj * HALF;
            const u32x4 pq = pv[m][bj];
            f32x4 r0, r1;
            const f32x4& g0 = acc[ai][bj][m][0]; const f32x4& g1 = acc[ai][bj][m][1];
            r0[0] = sigmoidf_(g0[0]) * bflo(pq.x); r0[1] = sigmoidf_(g0[1]) * bfhi(pq.x); r0[2] = sigmoidf_(g0[2]) * bflo(pq.y); r0[3] = sigmoidf_(g0[3]) * bfhi(pq.y);
            r1[0] = sigmoidf_(g1[0]) * bflo(pq.z); r1[1] = sigmoidf_(g1[1]) * bfhi(pq.z); r1[2] = sigmoidf_(g1[2]) * bflo(pq.w); r1[3] = sigmoidf_(g1[3]) * bfhi(pq.w);
            if (!first) { const u32x4 mq = mv[m][bj];
              r0[0] += bflo(mq.x); r0[1] += bfhi(mq.x); r0[2] += bflo(mq.y); r0[3] += bfhi(mq.y); r1[0] += bflo(mq.z); r1[1] += bfhi(mq.z); r1[2] += bflo(mq.w); r1[3] += bfhi(mq.w); }
            *(u32x4*)mp = pack8v(r0, r1);
          }
      }
    }
  }
};

struct GemmASched {
  const bf16_t* H; const bf16_t* W; int G, c;
  DI bool next(int i, Desc& d) const {
    const long L = (long)i * G + c; if (L >= 1496 + 272) return false;
    d.lda = 1024; d.ldb = 1024; d.nt = 16;
    if (L < 1496) {
      const int nwg = 1496, nN = 11, nM = 136;
      int wgid = (int)L; { const int q = nwg / NXCD, r = nwg % NXCD, xcd = wgid % NXCD, off = wgid / NXCD; wgid = (xcd < r ? xcd * (q + 1) : r * (q + 1) + (xcd - r) * q) + off; }
      const int nig = WGM * nN, gid = wgid / nig, fm = gid * WGM, gsz = (nM - fm) < WGM ? (nM - fm) : WGM;
      d.pm = fm + ((wgid % nig) % gsz); d.pn = (wgid % nig) / gsz; d.kind = 0;
      d.A = (const char*)(H + (size_t)d.pm * 256 * 1024); d.B = (const char*)(W + W_IN + (size_t)d.pn * 256 * 1024);
    } else {
      const int j = (int)L - 1496; d.pm = j & 1; d.pn = j >> 1; d.kind = 1;
      d.A = (const char*)(W + W_IN + (size_t)(2816 + d.pm * 256) * 1024); d.B = (const char*)(H + (size_t)d.pn * 256 * 1024);
    }
    return true;
  }
};
struct EpiGemmA {
  static constexpr bool PERM = true;
  bf16_t* Z; bf16_t* RVT;
  DI void operator()(const acc_t& acc, const Desc& u, int wr, int wc, int fr, int fq) const {
    const int row0 = u.pm * BM + wr * 64 + fr;
    if (u.kind == 0) {
      const int col0 = u.pn * BM + wc * 32 + 8 * fq;
#pragma unroll
      for (int ai = 0; ai < 2; ++ai)
#pragma unroll
        for (int m = 0; m < 4; ++m) { bf16_t* rowp = Z + (size_t)(row0 + ai * HALF + m * 16) * ZS + col0;
#pragma unroll
          for (int bj = 0; bj < 2; ++bj) *(u32x4*)(rowp + bj * HALF) = pack8v(acc[ai][bj][m][0], acc[ai][bj][m][1]); }
    } else {
      const int t0 = u.pn * BM, b = t0 / S, s0 = t0 - b * S + wc * 32 + 8 * fq;
#pragma unroll
      for (int ai = 0; ai < 2; ++ai)
#pragma unroll
        for (int m = 0; m < 4; ++m) { bf16_t* rowp = RVT + ((size_t)b * 512 + row0 + ai * HALF + m * 16) * S + s0;
#pragma unroll
          for (int bj = 0; bj < 2; ++bj) *(u32x4*)(rowp + bj * HALF) = pack8v(acc[ai][bj][m][0], acc[ai][bj][m][1]); }
    }
  }
};
struct EpiResid {
  static constexpr bool PERM = false;
  Params p; int layer, chunk, from_input;
  DI void operator()(const acc_t& acc, const Unit& u, int wr, int wc, int fr, int fq) const {
    const int row0 = u.pm * BM + wr * 64 + fr, col0 = u.pn * BM + wc * 32 + 4 * fq;
    const int b = u.pm / 17, g = (u.pm - b * 17) == 0 ? 8 : b;
    const float* gate = modp(p, layer, g, chunk);
    f32x4 gv[2][2];
#pragma unroll
    for (int bj = 0; bj < 2; ++bj)
#pragma unroll
      for (int n = 0; n < 2; ++n) gv[bj][n] = *(const f32x4*)(gate + col0 + bj * HALF + n * 16);
#pragma unroll
    for (int q = 0; q < 4; ++q) {
      const int ai = q >> 1, mh = q & 1;
      MEMBAR();
      f32x4 xv[2][2][2];
#pragma unroll
      for (int mm = 0; mm < 2; ++mm) { const int t = row0 + ai * HALF + (2 * mh + mm) * 16;
        const float* xi = from_input ? xrow_in(p, t) : xrow_ws(p, t);
#pragma unroll
        for (int bj = 0; bj < 2; ++bj)
#pragma unroll
          for (int n = 0; n < 2; ++n) xv[mm][bj][n] = *(const f32x4*)(xi + col0 + bj * HALF + n * 16); }
      MEMBAR();
#pragma unroll
      for (int mm = 0; mm < 2; ++mm) { const int t = row0 + ai * HALF + (2 * mh + mm) * 16;
        float* xo = xrow_ws(p, t);
#pragma unroll
        for (int bj = 0; bj < 2; ++bj)
#pragma unroll
          for (int n = 0; n < 2; ++n) *(f32x4*)(xo + col0 + bj * HALF + n * 16) = xv[mm][bj][n] + gv[bj][n] * acc[ai][bj][2 * mh + mm][n]; }
    }
  }
};
struct EpiFFN1 {
  static constexpr bool PERM = true;
  bf16_t* G;
  DI void operator()(const acc_t& acc, const Unit& u, int wr, int wc, int fr, int fq) const {
    const int row0 = u.pm * BM + wr * 64 + fr, col0 = u.pn * HALF + wc * 32 + 8 * fq;
#pragma unroll
    for (int ai = 0; ai < 2; ++ai)
#pragma unroll
      for (int m = 0; m < 4; ++m) {
        f32x4 r0, r1;
#pragma unroll
        for (int e = 0; e < 4; ++e) { r0[e] = siluf_(acc[ai][0][m][0][e]) * acc[ai][1][m][0][e]; r1[e] = siluf_(acc[ai][0][m][1][e]) * acc[ai][1][m][1][e]; }
        *(u32x4*)(G + (size_t)(row0 + ai * HALF + m * 16) * DFF + col0) = pack8v(r0, r1); }
  }
};
DI void conv_job(const float* src0, const float* src1, int ld, int K, int N, bf16_t* dst, int kind, const float* kscale, char* smem, int& rot) {
  float* tile = (float*)smem;
  const int ktn = K >> 6, ntn = N >> 6, kq = (ktn + 3) >> 2, nit = kq * ntn;
  const int G = gridDim.x;
  int start = blockIdx.x + rot; if (start >= G) start -= G;
  for (int it = start; it < nit; it += G) {
    const int tid = get_tid(), tx = tid & 15, ty = tid >> 4;
    const int nt = it / kq, kt0 = (it - nt * kq) * 4, nkt = (ktn - kt0) < 4 ? (ktn - kt0) : 4;
    const int n = nt * 64 + tx * 4;
    const float* src = src0; int col = n;
    if (kind == 1) {
      if (n < 512) col = n;
      else if (n < 768) col = 800 + (n - 512);
      else if (n < 1024) col = 1952 + (n - 768);
      else if (n < 1280) col = 512 + (n - 1024);
      else if (n < 1664) col = 1568 + (n - 1280);
      else if (n < 2176) col = 2208 + (n - 1664);
      else if (n < 2688) col = 2720 + (n - 2176);
      else if (n < 2720) col = 768 + (n - 2688);
      else if (n < 2816) col = -1;
      else col = 1056 + (n - 2816);
    } else if (kind == 2) { col = 3232 + n;
    } else if (kind == 4) { col = (n >> 6) * 128 + (n & 63);
    } else if (kind == 5) { col = (n >> 6) * 128 + 64 + (n & 63);
    } else if (kind == 6) { const int tl = n >> 8, c = n & 255; col = tl * 128 + (c & 127); src = (c >> 7) ? src1 : src0; }
    float4 v[4][2];
#pragma unroll
    for (int q = 0; q < 4; ++q)
#pragma unroll
      for (int ps = 0; ps < 2; ++ps) {
        v[q][ps] = make_float4(0.f, 0.f, 0.f, 0.f);
        if (q < nkt && col >= 0) { const int k = (kt0 + q) * 64 + ty + 32 * ps; v[q][ps] = *(const float4*)(src + (size_t)k * ld + col); }
      }
    __syncthreads();
#pragma unroll
    for (int q = 0; q < 4; ++q)
#pragma unroll
      for (int ps = 0; ps < 2; ++ps) {
        if (q < nkt) {
          const int kl = ty + 32 * ps; float4 w = v[q][ps];
          if (kscale) { const float sc = kscale[(kt0 + q) * 64 + kl]; w.x *= sc; w.y *= sc; w.z *= sc; w.w *= sc; }
          float* tp = tile + (q * 64 + kl) * 65 + tx * 4;
          tp[0] = w.x; tp[1] = w.y; tp[2] = w.z; tp[3] = w.w;
        }
      }
    __syncthreads();
    {
      const int kc = tid & 7, nl = tid >> 3;
#pragma unroll
      for (int q = 0; q < 4; ++q) {
        if (q < nkt) {
          const float* tp = tile + (q * 64 + kc * 8) * 65 + nl;
          u32x4 o; o.x = pk2(tp[0], tp[65]); o.y = pk2(tp[130], tp[195]); o.z = pk2(tp[260], tp[325]); o.w = pk2(tp[390], tp[455]);
          *(u32x4*)(dst + (size_t)(nt * 64 + nl) * K + (kt0 + q) * 64 + kc * 8) = o;
        }
      }
    }
  }
  rot = (rot + G - (nit % G)) % G;
}

DI void phase_convert(const Params& p, int l, int rot, char* smem) {
  {
    bf16_t* W = wl(p, l);
    conv_job(p.w_in + (size_t)l * D * NIN, nullptr, NIN, 1024, 3328, W + W_IN, 1, nullptr, smem, rot);
    conv_job(p.w_in + (size_t)l * D * NIN, nullptr, NIN, 1024, 3072, W + W_G, 2, nullptr, smem, rot);
    conv_job(p.w_uq + (size_t)l * 384 * 768, nullptr, 768, 384, 768, W + W_UQ, 0, p.g_q + l * 384, smem, rot);
    conv_job(p.w_ukv + (size_t)l * 256 * 1024, nullptr, 1024, 256, 512, W + W_UK, 4, p.g_kv + l * 256, smem, rot);
    conv_job(p.w_ukv + (size_t)l * 256 * 1024, nullptr, 1024, 256, 512, W + W_UV, 5, p.g_kv + l * 256, smem, rot);
    for (int nbk = 0; nbk < 8; ++nbk)
      for (int jj = 0; jj < 4; ++jj) {
        const float* s = ((jj & 1) ? p.lru_wx : p.lru_wa) + ((size_t)((l * 2 + (jj >> 1)) * 8 + nbk)) * 4096;
        conv_job(s, nullptr, 64, 64, 64, W + W_L + (size_t)(nbk * 256 + jj * 64) * 64, 0, nullptr, smem, rot);
      }
    conv_job(p.w_oa + (size_t)l * 512 * 1024, nullptr, 1024, 512, 1024, W + W_OA, 0, nullptr, smem, rot);
    conv_job(p.w_ob + (size_t)l * 512 * 1024, nullptr, 1024, 512, 1024, W + W_OB, 0, nullptr, smem, rot);
    conv_job(p.w_oc + (size_t)l * 512 * 1024, nullptr, 1024, 512, 1024, W + W_OC, 0, nullptr, smem, rot);
    conv_job(p.w_out + (size_t)l * 1024 * 1024, nullptr, 1024, 1024, 1024, W + W_OUT, 0, nullptr, smem, rot);
    conv_job(p.w_ff1 + (size_t)l * 1024 * DFF, p.w_ff3 + (size_t)l * 1024 * DFF, DFF, 1024, 5632, W + W_FF13, 6, nullptr, smem, rot);
    conv_job(p.w_ff2 + (size_t)l * DFF * 1024, nullptr, 1024, DFF, 1024, W + W_FF2, 0, nullptr, smem, rot);
  }
}
DI void phase_setup(const Params& p, char* smem) {
  int rot = 0;
  {
    float* act = (float*)smem;
    float* red = act + 9 * 1024;
    bool have = false;
    int mstart = blockIdx.x + rot; if (mstart >= (int)gridDim.x) mstart -= gridDim.x;
    for (int it = mstart; it < 2 * 96; it += gridDim.x) {
      const int tid = get_tid(), tx = tid & 63, ty = tid >> 6;
      __syncthreads();
      if (!have) {
        for (int i = tid; i < 9 * 1024; i += NT) { int g = i >> 10, k = i & 1023; float v = g < 8 ? p.c[g * 1024 + k] : p.c_ctx[k]; act[i] = siluf_(v); }
        have = true;
        __syncthreads();
      }
      const int l = it / 96, j = (it - l * 96) * 64 + tx;
      float a[9];
#pragma unroll
      for (int g = 0; g < 9; ++g) a[g] = 0.f;
      const float* wm = p.w_mod + (size_t)l * 1024 * 6144 + j;
#pragma unroll 8
      for (int k = ty * 128; k < ty * 128 + 128; ++k) {
        const float wv = wm[(size_t)k * 6144];
#pragma unroll
        for (int g = 0; g < 9; ++g) a[g] += act[g * 1024 + k] * wv;
      }
#pragma unroll
      for (int g = 0; g < 9; ++g) red[(ty * 9 + g) * 64 + tx] = a[g];
      __syncthreads();
      for (int i = tid; i < 9 * 64; i += NT) {
        int g = i >> 6, c = i & 63;
        float v = 0.f;
#pragma unroll
        for (int q = 0; q < 8; ++q) v += red[(q * 9 + g) * 64 + c];
        int jj = (it - l * 96) * 64 + c;
        ((float*)(p.ws + OFF_MOD))[(size_t)(l * 9 + g) * 6144 + jj] = v + p.b_mod[l * 6144 + jj];
      }
    }
  }
  {
    float* axc = (float*)(p.ws + OFF_AXC); float* axs = (float*)(p.ws + OFF_AXS);
    float* rtc = (float*)(p.ws + OFF_RTC); float* rts = (float*)(p.ws + OFF_RTS);
    const int gt = blockIdx.x * NT + get_tid(), gs = gridDim.x * NT;
    for (int i = gt; i < 4096 * 16; i += gs) {
      int n = i >> 4, j = i & 15; int row = n >> 6, col = n & 63;
      float inv = exp2f(-(float)(j & 7) * (13.287712379549449f / 8.f));
      float ang = (float)(j < 8 ? row : col) * inv;
      float sn, cs; sincosf(ang, &sn, &cs);
      axc[i] = cs; axs[i] = sn;
    }
    for (int i = gt; i < S * 32; i += gs) {
      int s = i >> 5, j = i & 31;
      float th = exp2f(-(float)j * (13.287712379549449f / 31.f));
      float ang = (float)s * th;
      float sn, cs; sincosf(ang, &sn, &cs);
      rtc[i] = cs; rts[i] = sn;
    }
  }
}

DI void phase_norm(const Params& p, int layer, int which, bool from_input, bool skipctx) {
  bf16_t* H = (bf16_t*)(p.ws + OFF_H);
  const float* gam = (which ? p.g_ffn : p.g_mix) + layer * 1024;
  const int tid_ = get_tid(); const int lane = tid_ & 63, w = tid_ >> 6;
  float4 gg[4], s4[4], c4[4];
#pragma unroll
  for (int i = 0; i < 4; ++i) { gg[i] = *(const float4*)(gam + (i * 64 + lane) * 4); s4[i] = make_float4(0.f, 0.f, 0.f, 0.f); c4[i] = s4[i]; }
  int gc = -1;
  for (int t0 = (blockIdx.x * 8 + w) * 2; t0 < T; t0 += gridDim.x * 16) {
    const int b = t0 / S, s = t0 - b * S, g = s < LC ? 8 : b;
    if (skipctx && s < LC) continue;
    if (g != gc) {
      const float* sh = modp(p, layer, g, which ? 3 : 0);
      const float* sc = modp(p, layer, g, which ? 4 : 1);
#pragma unroll
      for (int i = 0; i < 4; ++i) { s4[i] = *(const float4*)(sh + (i * 64 + lane) * 4); c4[i] = *(const float4*)(sc + (i * 64 + lane) * 4); }
      gc = g;
    }
    float4 v[2][4]; float ss[2] = {0.f, 0.f};
#pragma unroll
    for (int u = 0; u < 2; ++u) {
      const float* xr = from_input ? xrow_in(p, t0 + u) : xrow_ws(p, t0 + u);
#pragma unroll
      for (int i = 0; i < 4; ++i) { v[u][i] = *(const float4*)(xr + (i * 64 + lane) * 4); }
    }
#pragma unroll
    for (int u = 0; u < 2; ++u) {
#pragma unroll
      for (int i = 0; i < 4; ++i) ss[u] += v[u][i].x * v[u][i].x + v[u][i].y * v[u][i].y + v[u][i].z * v[u][i].z + v[u][i].w * v[u][i].w;
      ss[u] = wave_sum(ss[u]);
    }
#pragma unroll
    for (int i = 0; i < 4; ++i) {
      const int k = (i * 64 + lane) * 4;
#pragma unroll
      for (int u = 0; u < 2; ++u) {
        const float rstd = rsqrtf(ss[u] * (1.f / 1024.f) + EPS);
        float o0 = v[u][i].x * rstd * gg[i].x * (1.f + c4[i].x) + s4[i].x, o1 = v[u][i].y * rstd * gg[i].y * (1.f + c4[i].y) + s4[i].y;
        float o2 = v[u][i].z * rstd * gg[i].z * (1.f + c4[i].z) + s4[i].z, o3 = v[u][i].w * rstd * gg[i].w * (1.f + c4[i].w) + s4[i].w;
        uint2 o; o.x = pk2(o0, o1); o.y = pk2(o2, o3);
        *(uint2*)(H + (size_t)(t0 + u) * 1024 + k) = o;
      }
    }
  }
}
DI void phase_final_norm(const Params& p) {
  const int tid_ = get_tid(); const int lane = tid_ & 63, w = tid_ >> 6;
  float4 gg[4];
#pragma unroll
  for (int i = 0; i < 4; ++i) gg[i] = *(const float4*)(p.g_final + (i * 64 + lane) * 4);
  for (int t = blockIdx.x * 8 + w; t < NB * SEQ; t += gridDim.x * 8) {
    float* xr = p.out + (size_t)t * D;
    float4 v[4]; float ss = 0.f;
#pragma unroll
    for (int i = 0; i < 4; ++i) { v[i] = *(const float4*)(xr + (i * 64 + lane) * 4); ss += v[i].x * v[i].x + v[i].y * v[i].y + v[i].z * v[i].z + v[i].w * v[i].w; }
    ss = wave_sum(ss);
    const float rstd = rsqrtf(ss * (1.f / 1024.f) + EPS);
#pragma unroll
    for (int i = 0; i < 4; ++i) {
      const int k = (i * 64 + lane) * 4;
      float4 o; o.x = v[i].x * rstd * gg[i].x; o.y = v[i].y * rstd * gg[i].y; o.z = v[i].z * rstd * gg[i].z; o.w = v[i].w * rstd * gg[i].w;
      *(float4*)(xr + k) = o;
    }
  }
}
DI void phase_lownorm(const Params& p) {
  bf16_t* Z = (bf16_t*)(p.ws + OFF_Z);
  const int tid_ = get_tid(); const int lane = tid_ & 63, w = tid_ >> 6;
  for (int t0 = (blockIdx.x * 8 + w) * 2; t0 < T; t0 += gridDim.x * 16) {
    uint4 q[2], k[2];
#pragma unroll
    for (int u = 0; u < 2; ++u) {
      bf16_t* zr = Z + (size_t)(t0 + u) * ZS;
      q[u] = make_uint4(0, 0, 0, 0); k[u] = make_uint4(0, 0, 0, 0);
      if (lane < 48) q[u] = *(const uint4*)(zr + Z_QD + lane * 8);
      if (lane < 32) k[u] = *(const uint4*)(zr + Z_KVD + lane * 8);
    }
#pragma unroll
    for (int u = 0; u < 2; ++u) {
      bf16_t* zr = Z + (size_t)(t0 + u) * ZS;
      float sq = 0.f, sk = 0.f, a;
      a = bflo(q[u].x); sq += a * a; a = bfhi(q[u].x); sq += a * a; a = bflo(q[u].y); sq += a * a; a = bfhi(q[u].y); sq += a * a;
      a = bflo(q[u].z); sq += a * a; a = bfhi(q[u].z); sq += a * a; a = bflo(q[u].w); sq += a * a; a = bfhi(q[u].w); sq += a * a;
      a = bflo(k[u].x); sk += a * a; a = bfhi(k[u].x); sk += a * a; a = bflo(k[u].y); sk += a * a; a = bfhi(k[u].y); sk += a * a;
      a = bflo(k[u].z); sk += a * a; a = bfhi(k[u].z); sk += a * a; a = bflo(k[u].w); sk += a * a; a = bfhi(k[u].w); sk += a * a;
      sq = wave_sum(sq); sk = wave_sum(sk);
      const float rq = rsqrtf(sq * (1.f / 384.f) + EPS), rk = rsqrtf(sk * (1.f / 256.f) + EPS);
      if (lane < 48) { uint4 o; o.x = pk2(bflo(q[u].x) * rq, bfhi(q[u].x) * rq); o.y = pk2(bflo(q[u].y) * rq, bfhi(q[u].y) * rq); o.z = pk2(bflo(q[u].z) * rq, bfhi(q[u].z) * rq); o.w = pk2(bflo(q[u].w) * rq, bfhi(q[u].w) * rq); *(uint4*)(zr + Z_QD + lane * 8) = o; }
      if (lane < 32) { uint4 o; o.x = pk2(bflo(k[u].x) * rk, bfhi(k[u].x) * rk); o.y = pk2(bflo(k[u].y) * rk, bfhi(k[u].y) * rk); o.z = pk2(bflo(k[u].z) * rk, bfhi(k[u].z) * rk); o.w = pk2(bflo(k[u].w) * rk, bfhi(k[u].w) * rk); *(uint4*)(zr + Z_KVD + lane * 8) = o; }
    }
  }
}

DI void phase_gemm_a(const Params& p, int layer, char* smem) {
  GemmASched s{(const bf16_t*)(p.ws + OFF_H), wl(p, layer), (int)gridDim.x, (int)blockIdx.x};
  EpiGemmA e{(bf16_t*)(p.ws + OFF_Z), (bf16_t*)(p.ws + OFF_RVT)};
  gemm_stream(smem, s, e);
}
DI int vblock(int rot) { const int G = gridDim.x; int v = (int)blockIdx.x - rot; if (v < 0) v += G; return v; }
DI void phase_qkv(const Params& p, int layer, int hf, char* smem, int& rot) {
  const int G_ = gridDim.x;
  const bf16_t* W = wl(p, layer);
  const bf16_t* Z = (const bf16_t*)(p.ws + OFF_Z) + (size_t)hf * TH * ZS;
  bf16_t* Kb = (bf16_t*)(p.ws + OFF_K);
  const float* axc = (const float*)(p.ws + OFF_AXC); const float* axs = (const float*)(p.ws + OFF_AXS);
  { Order o; o.init(68, 3, 0, vblock(rot)); EpiStoreBf16 e{(bf16_t*)(p.ws + OFF_Q), 768}; gemm_phase(smem, Z + Z_QD, ZS, W + W_UQ, 384, 384, o, e); rot = (rot + 204) % G_; }
  { Order o; o.init(68, 2, 0, vblock(rot)); EpiK e{Kb}; gemm_phase(smem, Z + Z_KVD, ZS, W + W_UK, 256, 256, o, e); rot = (rot + 136) % G_; }
  { Order o; o.init(2, 68, 0, vblock(rot)); EpiTokT e{(bf16_t*)(p.ws + OFF_VT), 512}; gemm_phase(smem, W + W_UV, 256, Z + Z_KVD, ZS, 256, o, e); rot = (rot + 136) % G_; }
  {
    const int gt = blockIdx.x * NT + get_tid(), gs = gridDim.x * NT;
    for (int tl = gt; tl < TH; tl += gs) {
      const int bl = tl / S, s = tl - bl * S;
      const uint4* kr = (const uint4*)(Z + (size_t)tl * ZS + Z_KR);
      const uint4 a0 = kr[0], a1 = kr[1], b0 = kr[2], b1 = kr[3];
      const unsigned xa[8] = {a0.x, a0.y, a0.z, a0.w, a1.x, a1.y, a1.z, a1.w}, xb[8] = {b0.x, b0.y, b0.z, b0.w, b1.x, b1.y, b1.z, b1.w};
      unsigned o1[8], o2[8];
#pragma unroll
      for (int q = 0; q < 8; ++q) {
        float x1l = bflo(xa[q]), x1h = bfhi(xa[q]), x2l = bflo(xb[q]), x2h = bfhi(xb[q]);
        float c0 = 1.f, s0 = 0.f, c1 = 1.f, s1 = 0.f;
        if (s >= LC) { c0 = axc[(s - LC) * 16 + 2 * q]; s0 = axs[(s - LC) * 16 + 2 * q]; c1 = axc[(s - LC) * 16 + 2 * q + 1]; s1 = axs[(s - LC) * 16 + 2 * q + 1]; }
        o1[q] = pk2(x1l * c0 - x2l * s0, x1h * c1 - x2h * s1);
        o2[q] = pk2(x1l * s0 + x2l * c0, x1h * s1 + x2h * c1);
      }
#pragma unroll
      for (int hd = 0; hd < 8; ++hd) {
        uint4* kd = (uint4*)(Kb + ((size_t)(bl * 8 + hd) * S + s) * 96 + 64);
        kd[0] = make_uint4(o1[0], o1[1], o1[2], o1[3]); kd[1] = make_uint4(o1[4], o1[5], o1[6], o1[7]);
        kd[2] = make_uint4(o2[0], o2[1], o2[2], o2[3]); kd[3] = make_uint4(o2[4], o2[5], o2[6], o2[7]);
      }
    }
  }
}
DI void phase_merge(const Params& p, int layer, bool skipctx, char* smem) {
  MergeSched s{(const bf16_t*)(p.ws + OFF_H), (const bf16_t*)(p.ws + OFF_Z), wl(p, layer), skipctx ? 128 : 136, skipctx ? 1 : 0, (int)gridDim.x, (int)blockIdx.x};
  EpiMergeS e{(u32x4*)(p.ws + OFF_Q) + (size_t)blockIdx.x * 16 * 512, (bf16_t*)(p.ws + OFF_Z) + Z_M};
  gemm_stream(smem, s, e);
}
DI void phase_resid_gemm(const Params& p, int layer, const bf16_t* A, int lda, const bf16_t* BT, int K, int chunk, bool from_input, bool skipctx, char* smem) {
  Order o; o.init(skipctx ? 128 : 136, 4, skipctx);
  EpiResid e{p, layer, chunk, from_input};
  gemm_phase(smem, A, lda, BT, K, K, o, e);
}
DI void phase_ffn1(const Params& p, int layer, bool skipctx, char* smem) {
  Order o; o.init(skipctx ? 128 : 136, 22, skipctx);
  EpiFFN1 e{(bf16_t*)(p.ws + OFF_Z)};
  gemm_phase(smem, (const bf16_t*)(p.ws + OFF_H), 1024, wl(p, layer) + W_FF13, 1024, 1024, o, e);
}
DI void phase_attn(const Params& p, int hf, bool skipctx, char* smem, int& rot) {
  const bf16_t* Qb = (const bf16_t*)(p.ws + OFF_Q);
  const bf16_t* Kb = (const bf16_t*)(p.ws + OFF_K);
  const bf16_t* VTb = (const bf16_t*)(p.ws + OFF_VT);
  bf16_t* Z = (bf16_t*)(p.ws + OFF_Z) + (size_t)hf * TH * ZS;
  constexpr int KROW = 208, VROW = 264, KB_ = 128 * KROW, STG = KB_ + 64 * VROW;
  const int nitem = HB * 8 * 16 + (skipctx ? 0 : HB * 8);
  const int vb_ = vblock(rot); rot = (rot + nitem) % (int)gridDim.x;
  for (int it = vb_; it < nitem; it += gridDim.x) {
    const int tid = get_tid(), lane = tid & 63, w = tid >> 6, r = lane & 31, h = lane >> 5;
    int bh, s0, nkt;
    if (it < HB * 8 * 16) {
      int li = it;
      if (gridDim.x == 256) { const int c_ = it & 255, rr_ = it >> 8, idx_ = (c_ >> 3) + 32 * rr_; li = ((c_ & 7) * 4 + (idx_ >> 4)) * 16 + (idx_ & 15); }
      bh = li >> 4; s0 = LC + (li & 15) * 256; nkt = S / 128;
    } else { bh = it - HB * 8 * 16; s0 = 0; nkt = LC / 128; }
    const int head = bh & 7, bl = bh >> 3;
    const size_t tq = (size_t)bl * S + s0 + w * 32 + r;
    bf16x8 qf[6];
    {
      const float* axc = (const float*)(p.ws + OFF_AXC); const float* axs = (const float*)(p.ws + OFF_AXS);
      uint4 qu[6];
#pragma unroll
      for (int ks = 0; ks < 6; ++ks) qu[ks] = *(const uint4*)(Qb + tq * 768 + head * 96 + ks * 16 + h * 8);
#pragma unroll
      for (int ks = 0; ks < 4; ++ks) {
        const uint4 u = qu[ks];
        qf[ks] = pack8(bflo(u.x) * QSCALE, bfhi(u.x) * QSCALE, bflo(u.y) * QSCALE, bfhi(u.y) * QSCALE, bflo(u.z) * QSCALE, bfhi(u.z) * QSCALE, bflo(u.w) * QSCALE, bfhi(u.w) * QSCALE);
      }
      const unsigned a1[4] = {qu[4].x, qu[4].y, qu[4].z, qu[4].w}, a2[4] = {qu[5].x, qu[5].y, qu[5].z, qu[5].w};
      float o1[8], o2[8];
      const int sq_ = s0 + w * 32 + r;
#pragma unroll
      for (int e = 0; e < 8; ++e) {
        const float x1 = ((e & 1) ? bfhi(a1[e >> 1]) : bflo(a1[e >> 1])) * QSCALE;
        const float x2 = ((e & 1) ? bfhi(a2[e >> 1]) : bflo(a2[e >> 1])) * QSCALE;
        float cs = 1.f, sn = 0.f;
        if (sq_ >= LC) { cs = axc[(sq_ - LC) * 16 + 8 * h + e]; sn = axs[(sq_ - LC) * 16 + 8 * h + e]; }
        o1[e] = x1 * cs - x2 * sn; o2[e] = x1 * sn + x2 * cs;
      }
      qf[4] = pack8(o1[0], o1[1], o1[2], o1[3], o1[4], o1[5], o1[6], o1[7]);
      qf[5] = pack8(o2[0], o2[1], o2[2], o2[3], o2[4], o2[5], o2[6], o2[7]);
    }
    const bf16_t* Kg = Kb + (size_t)(bl * 8 + head) * S * 96;
    const bf16_t* Vg = VTb + (size_t)(bl * 8 + head) * 64 * S;
    f32x16 o[2]; o[0] = zero16(); o[1] = zero16();
    float m_run = -1e30f, l_run = 0.f;
    uint4 ak0, ak1, ak2, av0, av1, bk0, bk1, bk2, bv0, bv1;
    const int kr0 = tid / 12, kc0 = tid - kr0 * 12, kr1 = (tid + 512) / 12, kc1 = (tid + 512) - kr1 * 12, kr2 = (tid + 1024) / 12, kc2 = (tid + 1024) - kr2 * 12;
    const int vr0 = tid >> 4, vr1 = (tid + 512) >> 4, vc = tid & 15;
#define ATT_LOAD(K0, K1, K2, V0, V1, t_) do { \
      K0 = *(const uint4*)(Kg + (size_t)((t_) * 128 + kr0) * 96 + kc0 * 8); K1 = *(const uint4*)(Kg + (size_t)((t_) * 128 + kr1) * 96 + kc1 * 8); K2 = *(const uint4*)(Kg + (size_t)((t_) * 128 + kr2) * 96 + kc2 * 8); \
      V0 = *(const uint4*)(Vg + (size_t)vr0 * S + (t_) * 128 + vc * 8); V1 = *(const uint4*)(Vg + (size_t)vr1 * S + (t_) * 128 + vc * 8); } while (0)
#define ATT_WRITE(K0, K1, K2, V0, V1, buf) do { char* sk_ = smem + (buf) * STG; char* sv_ = sk_ + KB_; \
      *(uint4*)(sk_ + kr0 * KROW + kc0 * 16) = K0; *(uint4*)(sk_ + kr1 * KROW + kc1 * 16) = K1; *(uint4*)(sk_ + kr2 * KROW + kc2 * 16) = K2; \
      *(uint2*)(sv_ + vr0 * VROW + vc * 16) = make_uint2(V0.x, V0.y); *(uint2*)(sv_ + vr0 * VROW + vc * 16 + 8) = make_uint2(V0.z, V0.w); \
      *(uint2*)(sv_ + vr1 * VROW + vc * 16) = make_uint2(V1.x, V1.y); *(uint2*)(sv_ + vr1 * VROW + vc * 16 + 8) = make_uint2(V1.z, V1.w); } while (0)
    auto scores = [&](int buf, int half, f32x16 (&st)[2]) {
      const char* sk = smem + buf * STG + half * 64 * KROW;
#pragma unroll
      for (int kb = 0; kb < 2; ++kb) {
        bf16x8 kf[6];
#pragma unroll
        for (int ks = 0; ks < 6; ++ks) kf[ks] = *(const bf16x8*)(sk + (kb * 32 + r) * KROW + (ks * 16 + h * 8) * 2);
        __builtin_amdgcn_sched_barrier(0);
        st[kb] = zero16();
#pragma unroll
        for (int ks = 0; ks < 6; ++ks) st[kb] = MFMA(kf[ks], qf[ks], st[kb]);
        __builtin_amdgcn_sched_barrier(0);
      }
    };
    auto softpv = [&](int buf, int half, f32x16 (&st)[2]) {
      const char* sv = smem + buf * STG + KB_ + half * 128;
      bf16x8 vf[2][2][2];
#pragma unroll
      for (int kb = 0; kb < 2; ++kb)
#pragma unroll
        for (int s2 = 0; s2 < 2; ++s2)
#pragma unroll
          for (int dvb = 0; dvb < 2; ++dvb) {
            const char* vp = sv + (dvb * 32 + r) * VROW + (kb * 32 + 16 * s2 + 4 * h) * 2;
            const s16x4 lo = *(const s16x4*)vp, hi = *(const s16x4*)(vp + 16);
            vf[kb][s2][dvb] = __builtin_shufflevector(lo, hi, 0, 1, 2, 3, 4, 5, 6, 7);
          }
      float mx = st[0][0];
#pragma unroll
      for (int i = 0; i < 16; ++i) { mx = fmaxf(mx, st[0][i]); mx = fmaxf(mx, st[1][i]); }
      if (__any(mx > m_run + 8.f)) {
        mx = fmaxf(mx, __shfl_xor(mx, 32));
        const float m_new = fmaxf(m_run, mx);
        const float alpha = fexp2(m_run - m_new);
        m_run = m_new;
        l_run *= alpha;
#pragma unroll
        for (int i = 0; i < 16; ++i) { o[0][i] *= alpha; o[1][i] *= alpha; }
      }
      float ps = 0.f;
#pragma unroll
      for (int kb = 0; kb < 2; ++kb)
#pragma unroll
        for (int i = 0; i < 16; ++i) { const float e = fexp2(st[kb][i] - m_run); st[kb][i] = e; ps += e; }
      l_run += ps;
#pragma unroll
      for (int kb = 0; kb < 2; ++kb)
#pragma unroll
        for (int s2 = 0; s2 < 2; ++s2) {
          const bf16x8 pb = pack8(st[kb][8 * s2 + 0], st[kb][8 * s2 + 1], st[kb][8 * s2 + 2], st[kb][8 * s2 + 3], st[kb][8 * s2 + 4], st[kb][8 * s2 + 5], st[kb][8 * s2 + 6], st[kb][8 * s2 + 7]);
#pragma unroll
          for (int dvb = 0; dvb < 2; ++dvb) o[dvb] = MFMA(vf[kb][s2][dvb], pb, o[dvb]);
        }
    };
    const bool lag = w >= 4;
    auto tile = [&](int buf) {
      f32x16 sa[2], sb[2];
      if (!lag) { scores(buf, 0, sa); softpv(buf, 0, sa); scores(buf, 1, sa); softpv(buf, 1, sa); }
      else { scores(buf, 0, sa); scores(buf, 1, sb); softpv(buf, 0, sa); softpv(buf, 1, sb); }
    };
    __syncthreads();
    ATT_LOAD(ak0, ak1, ak2, av0, av1, 0);
    ATT_LOAD(bk0, bk1, bk2, bv0, bv1, 1);
    ATT_WRITE(ak0, ak1, ak2, av0, av1, 0);
    __syncthreads();
    for (int kt = 0; kt < nkt; kt += 2) {
      if (kt + 2 < nkt) ATT_LOAD(ak0, ak1, ak2, av0, av1, kt + 2);
      tile(0);
      ATT_WRITE(bk0, bk1, bk2, bv0, bv1, 1);
      __syncthreads();
      if (kt + 3 < nkt) ATT_LOAD(bk0, bk1, bk2, bv0, bv1, kt + 3);
      tile(1);
      if (kt + 2 < nkt) ATT_WRITE(ak0, ak1, ak2, av0, av1, 0);
      __syncthreads();
    }
#undef ATT_LOAD
#undef ATT_WRITE
    const float lt = l_run + __shfl_xor(l_run, 32);
    const float inv = 1.f / lt;
    bf16_t* ot = (bf16_t*)smem;
#pragma unroll
    for (int dvb = 0; dvb < 2; ++dvb)
#pragma unroll
      for (int i = 0; i < 16; ++i) ot[(w * 32 + r) * 72 + dvb * 32 + crow(i, h)] = f2bf(o[dvb][i] * inv);
    __syncthreads();
#pragma unroll
    for (int i = 0; i < 4; ++i) {
      const int c = tid + 512 * i, row = c >> 3, kc = c & 7;
      const uint4 v = *(const uint4*)((const char*)ot + row * 144 + kc * 16);
      *(uint4*)(Z + ((size_t)bl * S + s0 + row) * ZS + Z_YB + head * 64 + kc * 8) = v;
    }
  }
}

DI void phase_lru(const Params& p, int layer, int b0, int nb, int mode, bool skipctx, char* smem) {
  bf16_t* Z = (bf16_t*)(p.ws + OFF_Z);
  const bf16_t* WL = wl(p, layer) + W_L;
  float2* AGG = (float2*)(p.ws + OFF_AGG);
  const float* H0 = (const float*)(p.ws + OFF_H0);
  bf16_t* xs0 = (bf16_t*)smem;
  bf16_t* uA = (bf16_t*)(smem + 17408);
  float* uF = (float*)(smem + 26624);
  float* sA = (float*)(smem + 43008);
  float* sB = (float*)(smem + 76288);
  float* h0s = (float*)(smem + 109568);
  constexpr int SD = 64 * 65;
  const float* cw = p.conv_w + layer * 4 * 512; const float* cb = p.conv_b + layer * 512;
  int G = gridDim.x; asm volatile("" : "+s"(G));
  const int nbn = nb * 8, bpg = G / nbn;
  const int bn = blockIdx.x / bpg, sub = blockIdx.x - bn * bpg;
  if (bn >= nbn) return;
  const int nblk = bn & 7, b = b0 + (bn >> 3);
  const int jlo = (mode == 1 && skipctx) ? 4 : 0;
  const int tid0 = get_tid(), lane0 = tid0 & 63, w0_ = tid0 >> 6, r0 = lane0 & 31, h0_ = lane0 >> 5;
  const int chh0 = (w0_ >> 1) & 1, dw0 = w0_ >> 2;
  bf16x8 bq[4][2];
#pragma unroll
  for (int ks = 0; ks < 4; ++ks)
#pragma unroll
    for (int q = 0; q < 2; ++q) bq[ks][q] = *(const bf16x8*)(WL + (size_t)(nblk * 256 + (2 * dw0 + q) * 64 + chh0 * 32 + r0) * 64 + ks * 16 + 8 * h0_);
  const int chgl = nblk * 64 + chh0 * 32 + r0;
  const float sp = log1p_pos(__expf(-p.lru_lam[(layer * 2 + dw0) * 512 + chgl]));
  const float ba = p.lru_ba[(layer * 2 + dw0) * 512 + chgl], bx = p.lru_bx[(layer * 2 + dw0) * 512 + chgl];
  const int chg = nblk * 64 + (tid0 & 63);
  const float w0 = cw[chg], w1 = cw[512 + chg], w2 = cw[1024 + chg], w3 = cw[1536 + chg], bb = cb[chg];
  uint4 pre0 = make_uint4(0, 0, 0, 0), pre1 = make_uint4(0, 0, 0, 0);
  float preh = 0.f;
  int tid = tid0;
  auto issue = [&](int j) {
    if (mode == 1 && tid < 128) preh = H0[((size_t)(b * 2 + (tid >> 6)) * 68 + j) * 512 + nblk * 64 + (tid & 63)];
    const int s0 = j * 64, slo = j < 4 ? 0 : LC, shi = j < 4 ? LC : S;
    { const int row = tid >> 3, kc = tid & 7, s = s0 - 2 + row;
      pre0 = make_uint4(0, 0, 0, 0);
      if (s >= slo && s < shi) pre0 = *(const uint4*)(Z + ((size_t)b * S + s) * ZS + Z_LRUX + nblk * 64 + kc * 8); }
    { const int c = tid + 512, row = c >> 3, kc = c & 7, s = s0 - 2 + row;
      pre1 = make_uint4(0, 0, 0, 0);
      if (c < 67 * 8 && s >= slo && s < shi) pre1 = *(const uint4*)(Z + ((size_t)b * S + s) * ZS + Z_LRUX + nblk * 64 + kc * 8); }
  };
  auto stash = [&](int buf) {
    char* xb_ = (char*)xs0 + buf * 8704;
    *(uint4*)(xb_ + (tid >> 3) * 128 + (tid & 7) * 16) = pre0;
    if (tid + 512 < 67 * 8) *(uint4*)(xb_ + ((tid + 512) >> 3) * 128 + (tid & 7) * 16) = pre1;
    if (mode == 1 && tid < 128) h0s[tid] = preh;
  };
  __syncthreads();
  issue(jlo + sub);
  stash(0);
  int cur = 0;
  for (int j = jlo + sub; j < 68; j += bpg, cur ^= 1) {
    const int s0 = j * 64;
    const bf16_t* xs = xs0 + cur * (8704 / 2);
    tid = get_tid();
    const int lane = tid & 63, w = tid >> 6, r = lane & 31, h = lane >> 5, th = w & 1, chh = (w >> 1) & 1, dw = w >> 2, chl = chh * 32 + r, ch = tid & 63;
    const int sd = w >> 2, sc16 = lane & 15, sseg = lane >> 4, sch = (w & 3) * 16 + sc16;
    __syncthreads();
#pragma unroll
    for (int i = 0; i < 8; ++i) {
      const int tok = (tid >> 6) + 8 * i;
      const float u = bb + w0 * bf2f(xs[tok * 64 + ch]) + w1 * bf2f(xs[(tok + 1) * 64 + ch]) + w2 * bf2f(xs[(tok + 2) * 64 + ch]) + w3 * bf2f(xs[(tok + 3) * 64 + ch]);
      uF[tok * 64 + ch] = u; uA[tok * 72 + ch] = f2bf(u);
    }
    const float h0v = (mode == 1) ? h0s[sd * 64 + sch] : 0.f;
    if (j + bpg < 68) issue(j + bpg);
    __syncthreads();
    {
      f32x16 acc[2]; acc[0] = zero16(); acc[1] = zero16();
#pragma unroll
      for (int ks = 0; ks < 4; ++ks) {
        const bf16x8 a = *(const bf16x8*)((const char*)uA + (th * 32 + r) * 144 + (ks * 16 + 8 * h) * 2);
#pragma unroll
        for (int q = 0; q < 2; ++q) acc[q] = MFMA(a, bq[ks][q], acc[q]);
      }
#pragma unroll
      for (int i = 0; i < 16; ++i) {
        const int tok = th * 32 + crow(i, h);
        const float rr = sigmoidf_(acc[0][i] + ba), ii = sigmoidf_(acc[1][i] + bx);
        const float la = -8.f * rr * sp;
        sA[dw * SD + tok * 65 + chl] = __expf(la);
        sB[dw * SD + tok * 65 + chl] = __builtin_amdgcn_sqrtf(-expm1_neg(2.f * la)) * ii * uF[tok * 64 + chl];
      }
    }
    unsigned short gate[8];
    if (mode == 1) {
      const bf16_t* gp = Z + ((size_t)b * S + s0 + (tid >> 6)) * ZS + Z_LGATE + nblk * 64 + ch;
#pragma unroll
      for (int i = 0; i < 8; ++i) gate[i] = gp[(size_t)(8 * i) * ZS];
    }
    __syncthreads();
    {
      float av[16], bv[16];
#pragma unroll
      for (int q = 0; q < 16; ++q) {
        const int pi = sseg * 16 + q, tok = sd ? 63 - pi : pi;
        av[q] = sA[sd * SD + tok * 65 + sch]; bv[q] = sB[sd * SD + tok * 65 + sch];
      }
      float P = 1.f, E = 0.f;
#pragma unroll
      for (int q = 0; q < 16; ++q) { E = av[q] * E + bv[q]; P *= av[q]; }
      float hh = h0v, PP = 1.f, EE = 0.f;
#pragma unroll
      for (int sg = 0; sg < 4; ++sg) {
        const float Pg = __shfl(P, sc16 + 16 * sg), Eg = __shfl(E, sc16 + 16 * sg);
        if (sg < sseg) hh = Pg * hh + Eg;
        EE = Pg * EE + Eg; PP *= Pg;
      }
      if (mode == 0) {
        if (sseg == 0) AGG[((size_t)(b * 2 + sd) * 68 + j) * 512 + nblk * 64 + sch] = make_float2(PP, EE);
      } else {
#pragma unroll
        for (int q = 0; q < 16; ++q) {
          const int pi = sseg * 16 + q, tok = sd ? 63 - pi : pi;
          hh = av[q] * hh + bv[q];
          sB[sd * SD + tok * 65 + sch] = hh;
        }
      }
    }
    if (mode == 1) {
      __syncthreads();
#pragma unroll
      for (int i = 0; i < 8; ++i) {
        const int tok = (tid >> 6) + 8 * i;
        const float g = bf2f(gate[i]);
        Z[((size_t)b * S + s0 + tok) * ZS + Z_LGATE + nblk * 64 + ch] = f2bf(geluf_(g) * (sB[tok * 65 + ch] + sB[SD + tok * 65 + ch]));
      }
    }
    stash(cur ^ 1);
  }
}

template <int DIR>
DI void lru_prefix_one(const float2* ag, float* h0) {
  float hh = 0.f;
#pragma unroll 1
  for (int g = 0; g < 4; ++g) {
    float2 v[17];
#pragma unroll
    for (int i = 0; i < 17; ++i) { const int q = g * 17 + i; const int t = DIR ? (q < 4 ? 3 - q : 71 - q) : q; v[i] = ag[(size_t)t * 512]; }
#pragma unroll
    for (int i = 0; i < 17; ++i) { const int q = g * 17 + i; const int t = DIR ? (q < 4 ? 3 - q : 71 - q) : q; h0[(size_t)t * 512] = hh; hh = v[i].x * hh + v[i].y; }
  }
}
DI void phase_lru_prefix(const Params& p) {
  const float2* AGG = (const float2*)(p.ws + OFF_AGG);
  float* H0 = (float*)(p.ws + OFF_H0);
  for (int it = blockIdx.x; it < NB * 2; it += gridDim.x) {
    const int tid = get_tid(), d = it & 1;
    const float2* ag = AGG + (size_t)it * 68 * 512 + tid;
    float* h0 = H0 + (size_t)it * 68 * 512 + tid;
    if (d) lru_prefix_one<1>(ag, h0); else lru_prefix_one<0>(ag, h0);
  }
}

DI float ret_lg2(int head, int d) { return log2f(1.f - exp2f(-(d ? 5.5f : 5.0f) - (float)head)); }

DI void phase_ret_states(const Params& p, int hf, char* smem, int& rot) {
  const bf16_t* Z = (const bf16_t*)(p.ws + OFF_Z) + (size_t)hf * TH * ZS;
  const bf16_t* RVT = (const bf16_t*)(p.ws + OFF_RVT) + (size_t)hf * HB * 512 * S;
  float* CS = (float*)(p.ws + OFF_CS);
  const float* rtc = (const float*)(p.ws + OFF_RTC); const float* rts = (const float*)(p.ws + OFF_RTS);
  bf16_t* KT0 = (bf16_t*)smem;
  bf16_t* KT1 = (bf16_t*)(smem + 17408);
  char* VT = smem + 34816;
  const int nitem = HB * 4 * 34;
  const int vb_ = vblock(rot); rot = (rot + nitem) % (int)gridDim.x;
  for (int it = vb_; it < nitem; it += gridDim.x) {
    const int tid = get_tid(), lane = tid & 63, w = tid >> 6, r = lane & 31, h = lane >> 5;
    const int c = it % 34, bh = it / 34, head = bh & 3, bl = bh >> 2;
    const float lgf = ret_lg2(head, 0), lgb = ret_lg2(head, 1);
    __syncthreads();
    {
      const int tok = tid >> 2, cp = tid & 3, s = c * 128 + tok;
      const bf16_t* kp = Z + ((size_t)bl * S + s) * ZS + Z_RETK + head * 64 + cp * 8;
      const uint4 u1 = *(const uint4*)kp, u2 = *(const uint4*)(kp + 32);
      const unsigned a1[4] = {u1.x, u1.y, u1.z, u1.w}, a2[4] = {u2.x, u2.y, u2.z, u2.w};
      const float wf = fexp2((float)(127 - tok) * lgf) * 0.125f, wb = fexp2((float)tok * lgb) * 0.125f;
#pragma unroll
      for (int e = 0; e < 8; ++e) {
        const int jd = cp * 8 + e;
        const float x1 = (e & 1) ? bfhi(a1[e >> 1]) : bflo(a1[e >> 1]);
        const float x2 = (e & 1) ? bfhi(a2[e >> 1]) : bflo(a2[e >> 1]);
        const float cs = rtc[s * 32 + jd], sn = rts[s * 32 + jd];
        const float k1 = x1 * cs - x2 * sn, k2 = x1 * sn + x2 * cs;
        KT0[jd * 136 + tok] = f2bf(k1 * wf); KT0[(jd + 32) * 136 + tok] = f2bf(k2 * wf);
        KT1[jd * 136 + tok] = f2bf(k1 * wb); KT1[(jd + 32) * 136 + tok] = f2bf(k2 * wb);
      }
    }
    {
      uint4 vq[4];
#pragma unroll
      for (int u = 0; u < 4; ++u) { const int ch = tid + 512 * u, row = ch >> 4, kc = ch & 15; vq[u] = *(const uint4*)(RVT + ((size_t)(bl * 4 + head) * 128 + row) * S + c * 128 + kc * 8); }
#pragma unroll
      for (int u = 0; u < 4; ++u) { const int ch = tid + 512 * u, row = ch >> 4, kc = ch & 15; *(uint4*)(VT + row * 272 + kc * 16) = vq[u]; }
    }
    __syncthreads();
    const int dvb = w & 3, d = w >> 2;
    const char* KTd = (const char*)(d ? KT1 : KT0);
    f32x16 acc[2]; acc[0] = zero16(); acc[1] = zero16();
#pragma unroll
    for (int ks = 0; ks < 8; ++ks) {
      const bf16x8 a = *(const bf16x8*)(VT + (dvb * 32 + r) * 272 + (ks * 16 + 8 * h) * 2);
#pragma unroll
      for (int nb2 = 0; nb2 < 2; ++nb2) {
        const bf16x8 b0 = *(const bf16x8*)(KTd + (nb2 * 32 + r) * 272 + (ks * 16 + 8 * h) * 2);
        acc[nb2] = MFMA(a, b0, acc[nb2]);
      }
    }
#pragma unroll
    for (int nb2 = 0; nb2 < 2; ++nb2)
#pragma unroll
      for (int i = 0; i < 16; ++i)
        CS[((size_t)((bl * 4 + head) * 34 + c) * 2 + d) * 8192 + (dvb * 32 + crow(i, h)) * 64 + nb2 * 32 + r] = acc[nb2][i];
  }
}
template <int DIR>
DI void ret_prefix_one(const float* base, bf16_t* ob, float g128) {
  float v[34];
#pragma unroll
  for (int i = 0; i < 34; ++i) { const int c = DIR ? (i < 2 ? 1 - i : 35 - i) : i; v[i] = base[(size_t)c * 2 * 8192]; }
  float run = 0.f;
#pragma unroll
  for (int i = 0; i < 34; ++i) { const int c = DIR ? (i < 2 ? 1 - i : 35 - i) : i; ob[(size_t)c * 2 * 8192] = f2bf(run); run = g128 * run + v[i]; }
}
DI void phase_ret_prefix(const Params& p) {
  const float* CS = (const float*)(p.ws + OFF_CS);
  bf16_t* CSB = (bf16_t*)(p.ws + OFF_CSB);
  const int nitem = HB * 4 * 2 * 16;
  for (int it = blockIdx.x; it < nitem; it += gridDim.x) {
    const int eb = it & 15, d = (it >> 4) & 1, bh = it >> 5, head = bh & 3;
    const float g128 = exp2f(128.f * ret_lg2(head, d));
    const size_t off = ((size_t)(bh * 34) * 2 + d) * 8192 + eb * 512 + get_tid();
    if (d) ret_prefix_one<1>(CS + off, CSB + off, g128); else ret_prefix_one<0>(CS + off, CSB + off, g128);
  }
}
DI void phase_ret_out(const Params& p, int hf, bool skipctx, char* smem0, int& rot) {
  bf16_t* Z = (bf16_t*)(p.ws + OFF_Z) + (size_t)hf * TH * ZS;
  const bf16_t* RVT = (const bf16_t*)(p.ws + OFF_RVT) + (size_t)hf * HB * 512 * S;
  const bf16_t* CS = (const bf16_t*)(p.ws + OFF_CSB);
  const float* rtc = (const float*)(p.ws + OFF_RTC); const float* rts = (const float*)(p.ws + OFF_RTS);
  const int cpb = skipctx ? 32 : 34;
  const int npair = HB * 4 * cpb / 2;
  const int vb_ = vblock(rot); rot = (rot + npair) % (int)gridDim.x;
  for (int itp = vb_; itp < npair; itp += gridDim.x) {
    const int tid5 = get_tid(), grp = tid5 >> 8, tid = tid5 & 255, lane = tid & 63, w = tid >> 6, r = lane & 31, h = lane >> 5;
    char* smem = smem0 + grp * 53248;
    char* KR = smem;
    char* VT = smem + 18432;
    bf16_t* ot = (bf16_t*)(smem + 18432);
    const int it = itp * 2 + grp;
    int c, bh;
    if (skipctx) { c = (it & 31) + 2; bh = it >> 5; } else { c = it % 34; bh = it / 34; }
    const int head = bh & 3, bl = bh >> 2;
    const float lgf = ret_lg2(head, 0), lgb = ret_lg2(head, 1);
    __syncthreads();
#pragma unroll 1
    for (int u = 0; u < 2; ++u) {
      const int q = tid + 256 * u, tok = q >> 2, cp = q & 3, s = c * 128 + tok;
      const bf16_t* kp = Z + ((size_t)bl * S + s) * ZS + Z_RETK + head * 64 + cp * 8;
      const uint4 u1 = *(const uint4*)kp, u2 = *(const uint4*)(kp + 32);
      const unsigned a1[4] = {u1.x, u1.y, u1.z, u1.w}, a2[4] = {u2.x, u2.y, u2.z, u2.w};
      float k1[8], k2[8];
#pragma unroll
      for (int e = 0; e < 8; ++e) {
        const int jd = cp * 8 + e;
        const float x1 = (e & 1) ? bfhi(a1[e >> 1]) : bflo(a1[e >> 1]);
        const float x2 = (e & 1) ? bfhi(a2[e >> 1]) : bflo(a2[e >> 1]);
        const float cs = rtc[s * 32 + jd], sn = rts[s * 32 + jd];
        k1[e] = (x1 * cs - x2 * sn) * 0.125f; k2[e] = (x1 * sn + x2 * cs) * 0.125f;
      }
      *(bf16x8*)(KR + tok * 144 + cp * 16) = pack8(k1[0], k1[1], k1[2], k1[3], k1[4], k1[5], k1[6], k1[7]);
      *(bf16x8*)(KR + tok * 144 + 64 + cp * 16) = pack8(k2[0], k2[1], k2[2], k2[3], k2[4], k2[5], k2[6], k2[7]);
    }
    {
      uint4 vq[8];
#pragma unroll
      for (int u = 0; u < 8; ++u) { const int ch = tid + 256 * u, row = ch >> 4, kc = ch & 15; vq[u] = *(const uint4*)(RVT + ((size_t)(bl * 4 + head) * 128 + row) * S + c * 128 + kc * 8); }
#pragma unroll
      for (int u = 0; u < 8; ++u) { const int ch = tid + 256 * u, row = ch >> 4, kc = ch & 15; *(uint4*)(VT + row * 272 + kc * 16) = vq[u]; }
    }
    const int iq = w * 32 + r, sq = c * 128 + iq;
    bf16x8 qf[4];
    {
      const bf16_t* qp = Z + ((size_t)bl * S + sq) * ZS + Z_RETQ + head * 64;
#pragma unroll
      for (int ks = 0; ks < 2; ++ks) {
        MEMBAR();
        const uint4 u1 = *(const uint4*)(qp + ks * 16 + 8 * h), u2 = *(const uint4*)(qp + 32 + ks * 16 + 8 * h);
        const unsigned a1[4] = {u1.x, u1.y, u1.z, u1.w}, a2[4] = {u2.x, u2.y, u2.z, u2.w};
        float q1[8], q2[8];
#pragma unroll
        for (int e = 0; e < 8; ++e) {
          const int jd = ks * 16 + 8 * h + e;
          const float x1 = (e & 1) ? bfhi(a1[e >> 1]) : bflo(a1[e >> 1]);
          const float x2 = (e & 1) ? bfhi(a2[e >> 1]) : bflo(a2[e >> 1]);
          const float cs = rtc[sq * 32 + jd], sn = rts[sq * 32 + jd];
          q1[e] = x1 * cs - x2 * sn; q2[e] = x1 * sn + x2 * cs;
        }
        qf[ks] = pack8(q1[0], q1[1], q1[2], q1[3], q1[4], q1[5], q1[6], q1[7]);
        qf[ks + 2] = pack8(q2[0], q2[1], q2[2], q2[3], q2[4], q2[5], q2[6], q2[7]);
      }
    }
    __syncthreads();
    f32x16 o[4];
#pragma unroll
    for (int dvb = 0; dvb < 4; ++dvb) o[dvb] = zero16();
#pragma unroll
    for (int kb = 0; kb < 4; ++kb) {
      MEMBAR();
      f32x16 st = zero16();
#pragma unroll
      for (int ks = 0; ks < 4; ++ks) {
        const bf16x8 a = *(const bf16x8*)(KR + (kb * 32 + r) * 144 + (ks * 16 + 8 * h) * 2);
        st = MFMA(a, qf[ks], st);
      }
#pragma unroll
      for (int i = 0; i < 16; ++i) {
        const int dl = iq - (kb * 32 + crow(i, h));
        const float dlf = (float)dl;
        const float e = fexp2(dl > 0 ? dlf * lgf : -dlf * lgb);
        st[i] *= (dl == 0 ? 2.f : e);
      }
#pragma unroll
      for (int s2 = 0; s2 < 2; ++s2) {
        const bf16x8 pb = pack8(st[8 * s2 + 0], st[8 * s2 + 1], st[8 * s2 + 2], st[8 * s2 + 3], st[8 * s2 + 4], st[8 * s2 + 5], st[8 * s2 + 6], st[8 * s2 + 7]);
#pragma unroll
        for (int dvb = 0; dvb < 4; ++dvb) {
          const char* vp = VT + (dvb * 32 + r) * 272 + (kb * 32 + 16 * s2 + 4 * h) * 2;
          const s16x4 lo = *(const s16x4*)vp, hi = *(const s16x4*)(vp + 16);
          const bf16x8 va = __builtin_shufflevector(lo, hi, 0, 1, 2, 3, 4, 5, 6, 7);
          o[dvb] = MFMA(va, pb, o[dvb]);
        }
      }
    }
#pragma unroll 1
    for (int d = 0; d < 2; ++d) {
      const float qdec = d ? fexp2((float)(128 - iq) * lgb) : fexp2((float)(iq + 1) * lgf);
      const bf16_t* Rg = CS + ((size_t)((bl * 4 + head) * 34 + c) * 2 + d) * 8192;
      bf16x8 rf[4][4];
#pragma unroll
      for (int dvb = 0; dvb < 4; ++dvb)
#pragma unroll
        for (int ks = 0; ks < 4; ++ks) rf[dvb][ks] = *(const bf16x8*)(Rg + (dvb * 32 + r) * 64 + ks * 16 + 8 * h);
#pragma unroll
      for (int dvb = 0; dvb < 4; ++dvb) {
        f32x16 t = zero16();
#pragma unroll
        for (int ks = 0; ks < 4; ++ks) t = MFMA(rf[dvb][ks], qf[ks], t);
#pragma unroll
        for (int i = 0; i < 16; ++i) o[dvb][i] += qdec * t[i];
      }
    }
    float sm = 0.f;
#pragma unroll
    for (int dvb = 0; dvb < 4; ++dvb)
#pragma unroll
      for (int i = 0; i < 16; ++i) sm += o[dvb][i];
    sm += __shfl_xor(sm, 32);
    const float mu = sm * (1.f / 128.f);
    float vs = 0.f;
#pragma unroll
    for (int dvb = 0; dvb < 4; ++dvb)
#pragma unroll
      for (int i = 0; i < 16; ++i) { const float dd = o[dvb][i] - mu; vs += dd * dd; }
    vs += __shfl_xor(vs, 32);
    const float rs = rsqrtf(vs * (1.f / 128.f) + EPS);
    __syncthreads();
#pragma unroll
    for (int dvb = 0; dvb < 4; ++dvb)
#pragma unroll
      for (int i = 0; i < 16; ++i) ot[iq * 136 + dvb * 32 + crow(i, h)] = f2bf((o[dvb][i] - mu) * rs);
    __syncthreads();
#pragma unroll 1
    for (int u = 0; u < 8; ++u) {
      const int ch = tid + 256 * u, row = ch >> 4, kc = ch & 15;
      bf16_t* gp = Z + ((size_t)bl * S + c * 128 + row) * ZS + Z_RGATE + head * 128 + kc * 8;
      const uint4 g4 = *(const uint4*)gp;
      const uint4 v4 = *(const uint4*)((const char*)ot + row * 272 + kc * 16);
      uint4 o4;
      o4.x = pk2(siluf_(bflo(g4.x)) * bflo(v4.x), siluf_(bfhi(g4.x)) * bfhi(v4.x));
      o4.y = pk2(siluf_(bflo(g4.y)) * bflo(v4.y), siluf_(bfhi(g4.y)) * bfhi(v4.y));
      o4.z = pk2(siluf_(bflo(g4.z)) * bflo(v4.z), siluf_(bfhi(g4.z)) * bfhi(v4.z));
      o4.w = pk2(siluf_(bflo(g4.w)) * bflo(v4.w), siluf_(bfhi(g4.w)) * bfhi(v4.w));
      *(uint4*)gp = o4;
    }
  }
}


__global__ void __launch_bounds__(NT, 2) fwd_megakernel(Params p) {
  extern __shared__ __attribute__((aligned(16))) char smem[];
  cg::grid_group grid = cg::this_grid();
  volatile LAS3 unsigned* xst = (volatile LAS3 unsigned*)(LAS3 unsigned*)(smem + SMEM_BYTES - 16);
  if (threadIdx.x == 0) { xst[0] = 0u; xst[1] = 0u; xst[2] = 0u; xst[3] = 0u; }
  __syncthreads();
  if (blockIdx.x == 0) { unsigned* bw = (unsigned*)(p.ws + OFF_BAR); for (int i = threadIdx.x; i < (int)(BAR_BYTES / 4); i += NT) bw[i] = 0u; }
  phase_setup(p, smem);
  grid.sync();
  const XcdBarrier xb = xcd_barrier_post((unsigned*)(p.ws + OFF_BAR), xst);
#define GSYNC() xcd_barrier(xb)
  for (int layer = 0; layer < 2; ++layer) {
    const bool first = layer == 0, last = layer == 1;
    phase_norm(p, layer, 0, first, false);
    if (first) phase_convert(p, 0, 0, smem);
    GSYNC();
    phase_gemm_a(p, layer, smem);
    GSYNC();
    phase_lownorm(p);
    phase_lru(p, layer, 0, NB, 0, false, smem);
    GSYNC();
    int rot = 16;
    phase_lru_prefix(p);
    phase_qkv(p, layer, 0, smem, rot);
    phase_ret_states(p, 0, smem, rot);
    GSYNC();
    phase_ret_prefix(p);
    rot = 0;
    phase_attn(p, 0, last, smem, rot);
    phase_lru(p, layer, 0, HB, 1, last, smem);
    GSYNC();
    rot = 0;
    phase_ret_out(p, 0, last, smem, rot);
    phase_qkv(p, layer, 1, smem, rot);
    phase_ret_states(p, 1, smem, rot);
    GSYNC();
    phase_ret_prefix(p);
    rot = 0;
    phase_attn(p, 1, last, smem, rot);
    phase_lru(p, layer, HB, HB, 1, last, smem);
    GSYNC();
    rot = 0;
    phase_ret_out(p, 1, last, smem, rot);
    GSYNC();
    phase_merge(p, layer, last, smem);
    if (first) phase_convert(p, 1, (int)gridDim.x - 32, smem);
    GSYNC();
    phase_resid_gemm(p, layer, (const bf16_t*)(p.ws + OFF_Z) + Z_M, ZS, wl(p, layer) + W_OUT, 1024, 2, first, last, smem);
    GSYNC();
    phase_norm(p, layer, 1, false, last);
    GSYNC();
    phase_ffn1(p, layer, last, smem);
    GSYNC();
    phase_resid_gemm(p, layer, (const bf16_t*)(p.ws + OFF_Z), DFF, wl(p, layer) + W_FF2, DFF, 5, false, last, smem);
    GSYNC();
  }
  phase_final_norm(p);
}

extern "C" void kernel_launch(void* const* d_in, const int* in_sizes, int n_in, void* d_out, int out_size, void* d_ws, size_t ws_size, hipStream_t stream) {
  static int grid_blocks = 0;
  if (!grid_blocks) {
    int dev = 0, cus = 0, per_cu = 0;
    (void)hipGetDevice(&dev);
    (void)hipDeviceGetAttribute(&cus, hipDeviceAttributeMultiprocessorCount, dev);
    if (hipFuncSetAttribute((const void*)fwd_megakernel, hipFuncAttributeMaxDynamicSharedMemorySize, SMEM_BYTES) != hipSuccess) fprintf(stderr, "hipFuncSetAttribute failed\n");
    (void)hipOccupancyMaxActiveBlocksPerMultiprocessor(&per_cu, fwd_megakernel, NT, SMEM_BYTES);
    if (per_cu < 1) per_cu = 1;
    grid_blocks = cus * per_cu;
  }
  if (ws_size < WS_TOTAL) { fprintf(stderr, "workspace too small: %zu < %zu\n", ws_size, (size_t)WS_TOTAL); return; }
  Params p{};
  const float** pp = (const float**)&p;
  for (int i = 0; i < 28; ++i) pp[i] = (const float*)d_in[i];
  p.out = (float*)d_out;
  p.ws = (char*)d_ws;
  void* args[] = {&p};
  hipError_t e = hipLaunchCooperativeKernel((void*)fwd_megakernel, dim3(grid_blocks), dim3(NT), args, SMEM_BYTES, stream);
  if (e != hipSuccess) fprintf(stderr, "cooperative launch failed: %s (grid %d)\n", hipGetErrorString(e), grid_blocks);
}
```

```cpp
#include <hip/hip_runtime.h>
#include <hip/hip_cooperative_groups.h>
#include <cstdio>
namespace cg = cooperative_groups;

#define DI __device__ __forceinline__
typedef unsigned short bf16_t;
using bf16x8 = __attribute__((ext_vector_type(8))) short;
using s16x4 = __attribute__((ext_vector_type(4))) short;
using f32x16 = __attribute__((ext_vector_type(16))) float;
typedef __bf16 bf2_t __attribute__((ext_vector_type(2)));
typedef float f2_t __attribute__((ext_vector_type(2)));
#define MFMA(a, b, c) __builtin_amdgcn_mfma_f32_32x32x16_bf16((a), (b), (c), 0, 0, 0)

constexpr int NB = 8, SEQ = 4096, LC = 256, S = 4352, D = 1024, T = NB * S;
constexpr int ZS = 2816, DFF = 2816, NIN = 6304;
constexpr int HB = 4;
constexpr int TH = HB * S;
constexpr float EPS = 1e-6f;
constexpr int Z_LRUX = 0, Z_RETK = 512, Z_RETQ = 768, Z_KVD = 1024, Z_QD = 1280, Z_LGATE = 1664, Z_RGATE = 2176, Z_KR = 2688;
constexpr int Z_M = 0, Z_YB = 1024, Z_YA = 1664, Z_YC = 2176;
constexpr size_t W_IN = 0;
constexpr size_t W_G = W_IN + 3328ull * 1024;
constexpr size_t W_UQ = W_G + 3072ull * 1024;
constexpr size_t W_UK = W_UQ + 768ull * 384;
constexpr size_t W_UV = W_UK + 512ull * 256;
constexpr size_t W_L = W_UV + 512ull * 256;
constexpr size_t W_OA = W_L + 8ull * 256 * 64;
constexpr size_t W_OB = W_OA + 1024ull * 512;
constexpr size_t W_OC = W_OB + 1024ull * 512;
constexpr size_t W_OUT = W_OC + 1024ull * 512;
constexpr size_t W_FF13 = W_OUT + 1024ull * 1024;
constexpr size_t W_FF2 = W_FF13 + 5632ull * 1024;
constexpr size_t W_LAYER = W_FF2 + 1024ull * 2816;
constexpr size_t OFF_W = 0;
constexpr size_t OFF_MOD = OFF_W + 2 * W_LAYER * 2;
constexpr size_t OFF_AXC = OFF_MOD + 2ull * 9 * 6144 * 4;
constexpr size_t OFF_AXS = OFF_AXC + 4096ull * 16 * 4;
constexpr size_t OFF_RTC = OFF_AXS + 4096ull * 16 * 4;
constexpr size_t OFF_RTS = OFF_RTC + 4352ull * 32 * 4;
constexpr size_t OFF_XC = OFF_RTS + 4352ull * 32 * 4;
constexpr size_t OFF_H = OFF_XC + 2048ull * 1024 * 4;
constexpr size_t OFF_Z = OFF_H + (size_t)T * 1024 * 2;
constexpr size_t OFF_RVT = OFF_Z + (size_t)T * ZS * 2;
constexpr size_t OFF_Q = OFF_RVT + 8ull * 512 * S * 2;
constexpr size_t OFF_K = OFF_Q + (size_t)TH * 768 * 2;
constexpr size_t OFF_VT = OFF_K + 4ull * 8 * S * 96 * 2;
constexpr size_t OFF_CS = OFF_VT + 4ull * 8 * 64 * S * 2;
constexpr size_t OFF_AGG = OFF_CS + 4ull * 4 * 34 * 2 * 8192 * 4;
constexpr size_t OFF_H0 = OFF_AGG + 8ull * 2 * 68 * 512 * 8;
constexpr size_t OFF_CSB = OFF_H0 + 8ull * 2 * 68 * 512 * 4;
constexpr size_t OFF_BAR = OFF_CSB + 4ull * 4 * 34 * 2 * 8192 * 2;
constexpr size_t BAR_BYTES = 3456 * 4;
constexpr size_t WS_TOTAL = OFF_BAR + 16384;

constexpr int NT = 512;
constexpr int SMEM_BYTES = 135168;
constexpr int SM_AUX = 131072;

struct Params {
  const float *x, *c, *ctx, *c_ctx, *w_mod, *b_mod, *g_mix, *g_ffn, *w_in, *conv_w, *conv_b, *lru_wa, *lru_ba, *lru_wx,
      *lru_bx, *lru_lam, *g_q, *w_uq, *g_kv, *w_ukv, *w_oa, *w_ob, *w_oc, *w_out, *w_ff1, *w_ff3, *w_ff2, *g_final;
  float* out;
  char* ws;
};

DI unsigned pk2(float a, float b) { f2_t v = {a, b}; bf2_t r = __builtin_convertvector(v, bf2_t); return __builtin_bit_cast(unsigned, r); }
DI bf16_t f2bf(float a) { return (bf16_t)(pk2(a, 0.f) & 0xffffu); }
DI float bf2f(unsigned b) { return __uint_as_float(b << 16); }
DI float bflo(unsigned u) { return __uint_as_float(u << 16); }
DI float bfhi(unsigned u) { return __uint_as_float(u & 0xffff0000u); }
DI bf16x8 pack8(float a0, float a1, float a2, float a3, float a4, float a5, float a6, float a7) {
  uint4 u; u.x = pk2(a0, a1); u.y = pk2(a2, a3); u.z = pk2(a4, a5); u.w = pk2(a6, a7);
  return __builtin_bit_cast(bf16x8, u);
}
DI float sigmoidf_(float x) { return __builtin_amdgcn_rcpf(1.f + __builtin_amdgcn_exp2f(-1.4426950408889634f * x)); }
DI float siluf_(float x) { return x * sigmoidf_(x); }
DI float geluf_(float x) { return x * sigmoidf_(1.5957691216057308f * (x + 0.044715f * x * x * x)); }
DI float log1p_pos(float e) { return e < 0.05f ? e * (1.f + e * (-0.5f + e * (0.33333334f + e * (-0.25f + e * 0.2f)))) : __logf(1.f + e); }
DI float expm1_neg(float x) { return x > -0.1f ? x * (1.f + x * (0.5f + x * (0.16666667f + x * (0.041666668f + x * 0.008333334f)))) : __expf(x) - 1.f; }
DI float fexp2(float x) { return __builtin_amdgcn_exp2f(x); }
DI float wave_sum(float v) {
#pragma unroll
  for (int o = 32; o >= 1; o >>= 1) v += __shfl_xor(v, o);
  return v;
}
DI int get_tid() { int t = threadIdx.x; asm volatile("" : "+v"(t)); return t; }
#define MEMBAR() asm volatile("" ::: "memory")
DI int crow(int i, int h) { return (i & 3) + 8 * (i >> 2) + 4 * h; }
DI f32x16 zero16() { f32x16 z; for (int i = 0; i < 16; ++i) z[i] = 0.f; return z; }

DI bf16_t* wl(const Params& p, int layer) { return (bf16_t*)(p.ws + OFF_W) + (size_t)layer * W_LAYER; }
DI float* modp(const Params& p, int layer, int g, int chunk) { return (float*)(p.ws + OFF_MOD) + ((size_t)(layer * 9 + g) * 6 + chunk) * 1024; }
DI const float* xrow_in(const Params& p, int t) { int b = t / S, s = t - b * S; return s < LC ? p.ctx + ((size_t)b * LC + s) * D : p.x + ((size_t)b * SEQ + (s - LC)) * D; }
DI float* xrow_ws(const Params& p, int t) { int b = t / S, s = t - b * S; return s < LC ? (float*)(p.ws + OFF_XC) + ((size_t)b * LC + s) * D : p.out + ((size_t)b * SEQ + (s - LC)) * D; }


#define LAS3 __attribute__((address_space(3)))
#define XB_TMO      128
#define XB_XCNT(j)  (256  + 64 * (j))
#define XB_XSUB(j)  (1280 + 64 * (j))
#define XB_XGEN(j)  (2304 + 64 * (j))
#define XB_TOP      3328
#define XB_TOPGEN   3392
#define XB_SPIN_CAP (1u << 22)
DI unsigned xb_ld(unsigned* p) { return __hip_atomic_load(p, __ATOMIC_RELAXED, __HIP_MEMORY_SCOPE_AGENT); }
DI unsigned xb_add(unsigned* p, unsigned v) { return __hip_atomic_fetch_add(p, v, __ATOMIC_RELAXED, __HIP_MEMORY_SCOPE_AGENT); }
DI unsigned xb_xcc_id() { return (unsigned)__builtin_amdgcn_s_getreg((3 << 11) | 20) & 0xFu; }
#define XB_SPIN(cond, bar) do { unsigned _sp = 0; while (cond) { __builtin_amdgcn_s_sleep(1); \
    if ((++_sp & 255u) == 0u) { if (xb_ld(&(bar)[XB_TMO])) break; if (_sp > XB_SPIN_CAP) { atomicAdd(&(bar)[XB_TMO], 1u); break; } } } } while (0)
struct XcdBarrier { unsigned* bar; unsigned x; volatile LAS3 unsigned* st; };
DI XcdBarrier xcd_barrier_post(unsigned* bar, volatile LAS3 unsigned* st) {
  XcdBarrier b; b.bar = bar; b.x = xb_xcc_id(); b.st = st;
  if (threadIdx.x == 0) (void)xb_add(&bar[XB_XCNT(b.x)], 1u);
  return b;
}
DI void xcd_barrier_complete(unsigned* bar, unsigned x, unsigned& nloc, unsigned& nx) {
  const unsigned G = gridDim.x * gridDim.y * gridDim.z;
  unsigned sum, cnt, mine, sp = 0u;
  for (;;) {
    sum = 0u; cnt = 0u; mine = 0u;
#pragma unroll
    for (unsigned j = 0; j < 16; ++j) { const unsigned c = xb_ld(&bar[XB_XCNT(j)]); sum += c; cnt += (c > 0u) ? 1u : 0u; mine = (j == x) ? c : mine; }
    if (sum == G) break;
    __builtin_amdgcn_s_sleep(1);
    if ((++sp & 255u) == 0u) { if (xb_ld(&bar[XB_TMO])) break; if (sp > XB_SPIN_CAP) { atomicAdd(&bar[XB_TMO], 1u); break; } }
  }
  nloc = mine > 0u ? mine : 1u; nx = cnt > 0u ? cnt : 1u;
}
DI void xcd_barrier(const XcdBarrier& b) {
  asm volatile("s_waitcnt vmcnt(0)" ::: "memory");
  __syncthreads();
  if (threadIdx.x == 0) {
    unsigned* bar = b.bar;
    __builtin_amdgcn_s_waitcnt(0);
    unsigned nloc = b.st[0], nx = b.st[1];
    if (nloc == 0u) { xcd_barrier_complete(bar, b.x, nloc, nx); b.st[0] = nloc; b.st[1] = nx; }
    const unsigned old = xb_add(&bar[XB_XSUB(b.x)], 1u);
    const unsigned gen = old / nloc;
    if (old + 1u == (gen + 1u) * nloc) {
      __builtin_amdgcn_fence(__ATOMIC_RELEASE, "agent");
      asm volatile("s_waitcnt vmcnt(0)" ::: "memory");
      const unsigned og = xb_add(&bar[XB_TOP], 1u);
      const unsigned tg = og / nx;
      if (og + 1u == (tg + 1u) * nx) xb_add(&bar[XB_TOPGEN], 1u);
      else XB_SPIN(xb_ld(&bar[XB_TOPGEN]) == tg, bar);
      __builtin_amdgcn_fence(__ATOMIC_ACQUIRE, "agent");
      xb_add(&bar[XB_XGEN(b.x)], 1u);
      asm volatile("s_waitcnt vmcnt(0)" ::: "memory");
    } else {
      XB_SPIN(xb_ld(&bar[XB_XGEN(b.x)]) == gen, bar);
      __builtin_amdgcn_fence(__ATOMIC_ACQUIRE, "agent");
      asm volatile("s_waitcnt vmcnt(0)" ::: "memory");
    }
  }
  __syncthreads();
}
#define LAS __attribute__((address_space(3)))
using f32x4 = __attribute__((ext_vector_type(4))) float;
using u32x4 = __attribute__((ext_vector_type(4))) unsigned;
constexpr int BM = 256, BK = 64, HALF = 128, HTB = HALF * BK * 2, NXCD = 8, WGM = 8;
DI int lds_byte(int r, int c) { const int st = (r >> 4) * 2 + (c >> 5), rr = r & 15, cc = c & 31, ob = rr * 64 + cc * 2; return st * 1024 + (ob ^ (((ob >> 9) & 1) << 5)); }
DI void stage_rc(int b, int& R, int& C) { const int st = b / 1024, sb = b % 1024, swz = sb ^ (((sb >> 9) & 1) << 5); R = (st >> 1) * 16 + swz / 64; C = (st & 1) * 32 + (swz % 64) / 2; }
DI int perm32(int rho) { const int n = rho >> 4, i = rho & 15; return 8 * (i >> 2) + 4 * n + (i & 3); }
struct Unit { int pm, pn; };
struct Order {
  int nM, nN, nwg, G, c, skip;
  DI void init(int nM_, int nN_, int skip_, int c_ = -1) { nM = nM_; nN = nN_; nwg = nM * nN; G = gridDim.x; c = c_ < 0 ? (int)blockIdx.x : c_; skip = skip_; }
  DI bool next(int i, Unit& u) const {
    const long L = (long)i * G + c; if (L >= nwg) return false;
    int wgid = (int)L; { const int q = nwg / NXCD, r = nwg % NXCD, xcd = wgid % NXCD, off = wgid / NXCD; wgid = (xcd < r ? xcd * (q + 1) : r * (q + 1) + (xcd - r) * q) + off; }
    const int nig = WGM * nN, gid = wgid / nig, fm = gid * WGM, gsz = (nM - fm) < WGM ? (nM - fm) : WGM;
    int pm = fm + ((wgid % nig) % gsz); u.pn = (wgid % nig) / gsz;
    if (skip) pm = pm + pm / 16 + 1;
    u.pm = pm; return true;
  }
};
typedef f32x4 acc_t[2][2][4][2];

template <class Epi>
DI void gemm_phase(char* smem, const bf16_t* A, int lda, const bf16_t* Bt, int ldb, int K, const Order& S_, const Epi& E) {
  LAS unsigned char* lds = (LAS unsigned char*)smem;
  const int tid = get_tid(), wid = __builtin_amdgcn_readfirstlane(tid >> 6), lane = tid & 63, wr = wid >> 2, wc = wid & 3, fr = lane & 15, fq = lane >> 4;
  const int nt = K / BK;
  unsigned voffA[2], voffB[2];
#pragma unroll
  for (int i = 0; i < 2; ++i) { int R, C; stage_rc(tid * 16 + i * 8192, R, C); const int Rb = Epi::PERM ? ((R & ~31) + perm32(R & 31)) : R;
    voffA[i] = (unsigned)(R * lda + C) * 2u; voffB[i] = (unsigned)(Rb * ldb + C) * 2u; }
  const size_t kstep = (size_t)(BK * 2);
  const size_t hstepA = (size_t)HALF * lda * 2, hstepB = (size_t)HALF * ldb * 2;
  const size_t tstepA = 2 * hstepA, tstepB = 2 * hstepB;
  const unsigned ldsw = (unsigned)wid * 1024u;
  const int aoff = lds_byte(wr * 64 + fr, fq * 8), boff = lds_byte(wc * 32 + fr, fq * 8);
#define PG8_SA(b, h) (((b) * 2 + (h)) * HTB)
#define PG8_SB(b, h) ((4 + (b) * 2 + (h)) * HTB)
#define PG8_STAGE(bufoff, gbase, voff) do { _Pragma("unroll") for (int _i = 0; _i < 2; ++_i) \
    __builtin_amdgcn_global_load_lds((const unsigned*)((const char*)(gbase) + (voff)[_i]), (LAS unsigned*)(lds + (bufoff) + ldsw + _i * 8192), 16, 0, 0); } while (0)
#define PG8_LDA(dst, b, h) do { _Pragma("unroll") for (int m = 0; m < 4; ++m) _Pragma("unroll") for (int k = 0; k < 2; ++k) dst[m][k] = *(const LAS bf16x8*)(lds + PG8_SA(b, h) + aoff + m * 2048 + k * 1024); } while (0)
#define PG8_LDB(dst, b, h) do { _Pragma("unroll") for (int n = 0; n < 2; ++n) _Pragma("unroll") for (int k = 0; k < 2; ++k) dst[n][k] = *(const LAS bf16x8*)(lds + PG8_SB(b, h) + boff + n * 2048 + k * 1024); } while (0)
#define PG8_MMA(ai, bj, At, Bt_) do { __builtin_amdgcn_s_setprio(1); _Pragma("unroll") for (int m = 0; m < 4; ++m) _Pragma("unroll") for (int n = 0; n < 2; ++n) _Pragma("unroll") for (int k = 0; k < 2; ++k) \
    acc[ai][bj][m][n] = __builtin_amdgcn_mfma_f32_16x16x32_bf16(Bt_[n][k], At[m][k], acc[ai][bj][m][n], 0, 0, 0); __builtin_amdgcn_s_setprio(0); } while (0)
#define PG8_WAIT_V(n) asm volatile("s_waitcnt vmcnt(" #n ")" ::: "memory")
#define PG8_WAIT_L(n) asm volatile("s_waitcnt lgkmcnt(" #n ")" ::: "memory")
#define PG8_BAR __builtin_amdgcn_s_barrier()
#define PG8_SCHED __builtin_amdgcn_sched_barrier(0)
  Unit cur, nxt; int ui = 0;
  if (!S_.next(0, cur)) return;
  f32x4 acc[2][2][4][2];
#pragma unroll
  for (int a = 0; a < 2; ++a)
#pragma unroll
    for (int b = 0; b < 2; ++b)
#pragma unroll
      for (int m = 0; m < 4; ++m)
#pragma unroll
        for (int n = 0; n < 2; ++n) acc[a][b][m][n] = (f32x4){0.f, 0.f, 0.f, 0.f};
  bf16x8 At[4][2], B0[2][2], B1[2][2];
  const char* cA = (const char*)A + (size_t)cur.pm * tstepA; const char* cB = (const char*)Bt + (size_t)cur.pn * tstepB;
  PG8_STAGE(PG8_SB(0, 0), cB, voffB); PG8_STAGE(PG8_SA(0, 0), cA, voffA); PG8_STAGE(PG8_SB(0, 1), cB + hstepB, voffB); PG8_STAGE(PG8_SA(0, 1), cA + hstepA, voffA);
  if (wr == 1) PG8_BAR;
  PG8_WAIT_V(4); PG8_BAR;
  PG8_STAGE(PG8_SB(1, 0), cB + kstep, voffB); PG8_STAGE(PG8_SA(1, 0), cA + kstep, voffA); PG8_STAGE(PG8_SB(1, 1), cB + hstepB + kstep, voffB);
  PG8_WAIT_V(6); PG8_BAR;
  for (;;) {
    const bool has_next = S_.next(ui + 1, nxt);
    const char* nA = has_next ? (const char*)A + (size_t)nxt.pm * tstepA : cA; const char* nB = has_next ? (const char*)Bt + (size_t)nxt.pn * tstepB : cB;
    for (int t = 0; t < nt; t += 2) {
      const bool last = (t == nt - 2);
      const char* a1 = cA + (size_t)(t + 1) * kstep;
      const char* a2 = last ? nA : cA + (size_t)(t + 2) * kstep; const char* b2 = last ? nB : cB + (size_t)(t + 2) * kstep;
      const char* a3 = a2 + kstep; const char* b3 = b2 + kstep;
      PG8_LDB(B0, 0, 0); PG8_SCHED; PG8_LDA(At, 0, 0); PG8_STAGE(PG8_SA(1, 1), a1 + hstepA, voffA);
      PG8_WAIT_L(8); PG8_BAR; PG8_WAIT_L(0); PG8_MMA(0, 0, At, B0); PG8_BAR; PG8_SCHED;
      PG8_LDB(B1, 0, 1); PG8_STAGE(PG8_SB(0, 0), b2, voffB);
      PG8_BAR; PG8_WAIT_L(0); PG8_MMA(0, 1, At, B1); PG8_BAR;
      PG8_LDA(At, 0, 1); PG8_STAGE(PG8_SA(0, 0), a2, voffA);
      PG8_BAR; PG8_WAIT_L(0); PG8_MMA(1, 0, At, B0); PG8_BAR; PG8_SCHED;
      PG8_STAGE(PG8_SB(0, 1), b2 + hstepB, voffB);
      PG8_WAIT_V(6); PG8_BAR; PG8_MMA(1, 1, At, B1); PG8_BAR;
      PG8_LDB(B0, 1, 0); PG8_SCHED; PG8_LDA(At, 1, 0); PG8_STAGE(PG8_SA(0, 1), a2 + hstepA, voffA);
      PG8_WAIT_L(8); PG8_BAR; PG8_WAIT_L(0); PG8_MMA(0, 0, At, B0); PG8_BAR; PG8_SCHED;
      PG8_LDB(B1, 1, 1); PG8_STAGE(PG8_SB(1, 0), b3, voffB);
      PG8_BAR; PG8_WAIT_L(0); PG8_MMA(0, 1, At, B1); PG8_BAR;
      PG8_LDA(At, 1, 1); PG8_STAGE(PG8_SA(1, 0), a3, voffA);
      PG8_BAR; PG8_WAIT_L(0); PG8_MMA(1, 0, At, B0); PG8_BAR; PG8_SCHED;
      PG8_STAGE(PG8_SB(1, 1), b3 + hstepB, voffB);
      PG8_WAIT_V(6); PG8_BAR; PG8_MMA(1, 1, At, B1); PG8_BAR;
    }
    E(acc, cur, wr, wc, fr, fq);
    if (!has_next) break;
#pragma unroll
    for (int a = 0; a < 2; ++a)
#pragma unroll
      for (int b = 0; b < 2; ++b)
#pragma unroll
        for (int m = 0; m < 4; ++m)
#pragma unroll
          for (int n = 0; n < 2; ++n) acc[a][b][m][n] = (f32x4){0.f, 0.f, 0.f, 0.f};
    cur = nxt; cA = nA; cB = nB; ++ui;
  }
  PG8_WAIT_V(0);
  if (wr == 0) PG8_BAR;
  PG8_BAR;
#undef PG8_SA
#undef PG8_SB
#undef PG8_STAGE
#undef PG8_LDA
#undef PG8_LDB
#undef PG8_MMA
#undef PG8_WAIT_V
#undef PG8_WAIT_L
#undef PG8_BAR
#undef PG8_SCHED
}
DI u32x4 pack8v(const f32x4& a, const f32x4& b) { u32x4 w; w.x = pk2(a[0], a[1]); w.y = pk2(a[2], a[3]); w.z = pk2(b[0], b[1]); w.w = pk2(b[2], b[3]); return w; }

struct EpiStoreBf16 {
  static constexpr bool PERM = true;
  bf16_t* O; int ldc;
  DI void operator()(const acc_t& acc, const Unit& u, int wr, int wc, int fr, int fq) const {
    const int row0 = u.pm * BM + wr * 64 + fr, col0 = u.pn * BM + wc * 32 + 8 * fq;
#pragma unroll
    for (int ai = 0; ai < 2; ++ai)
#pragma unroll
      for (int m = 0; m < 4; ++m) { bf16_t* rowp = O + (size_t)(row0 + ai * HALF + m * 16) * ldc + col0;
#pragma unroll
        for (int bj = 0; bj < 2; ++bj) *(u32x4*)(rowp + bj * HALF) = pack8v(acc[ai][bj][m][0], acc[ai][bj][m][1]); }
  }
};
struct EpiTokT {
  static constexpr bool PERM = true;
  bf16_t* O; int rows_per_b;
  DI void operator()(const acc_t& acc, const Unit& u, int wr, int wc, int fr, int fq) const {
    const int row0 = u.pm * BM + wr * 64 + fr;
    const int t0 = u.pn * BM, b = t0 / S, s0 = t0 - b * S + wc * 32 + 8 * fq;
#pragma unroll
    for (int ai = 0; ai < 2; ++ai)
#pragma unroll
      for (int m = 0; m < 4; ++m) { bf16_t* rowp = O + ((size_t)b * rows_per_b + row0 + ai * HALF + m * 16) * S + s0;
#pragma unroll
        for (int bj = 0; bj < 2; ++bj) *(u32x4*)(rowp + bj * HALF) = pack8v(acc[ai][bj][m][0], acc[ai][bj][m][1]); }
  }
};
constexpr float QSCALE = 0.10206207261596577f * 1.4426950408889634f;
struct EpiK {
  static constexpr bool PERM = true;
  bf16_t* Kb;
  DI void operator()(const acc_t& acc, const Unit& u, int wr, int wc, int fr, int fq) const {
    const int row0 = u.pm * BM + wr * 64 + fr;
#pragma unroll
    for (int ai = 0; ai < 2; ++ai)
#pragma unroll
      for (int m = 0; m < 4; ++m) { const int tl = row0 + ai * HALF + m * 16, bl = tl / S, s = tl - bl * S;
#pragma unroll
        for (int bj = 0; bj < 2; ++bj) { const int c = u.pn * BM + bj * HALF + wc * 32 + 8 * fq, head = c >> 6, j = c & 63;
          *(u32x4*)(Kb + ((size_t)(bl * 8 + head) * S + s) * 96 + j) = pack8v(acc[ai][bj][m][0], acc[ai][bj][m][1]); } }
  }
};
struct EpiMergeG {
  static constexpr bool PERM = true;
  const bf16_t* P; bf16_t* M; int first;
  DI void operator()(const acc_t& acc, const Unit& u, int wr, int wc, int fr, int fq) const {
    const int row0 = u.pm * BM + wr * 64 + fr, col0 = u.pn * BM + wc * 32 + 8 * fq;
#pragma unroll
    for (int ai = 0; ai < 2; ++ai)
#pragma unroll
      for (int m = 0; m < 4; ++m) { const int row = row0 + ai * HALF + m * 16;
#pragma unroll
        for (int bj = 0; bj < 2; ++bj) {
          const u32x4 pv = *(const u32x4*)(P + (size_t)row * 1024 + col0 + bj * HALF);
          bf16_t* mp = M + (size_t)row * ZS + col0 + bj * HALF;
          f32x4 r0, r1;
          const f32x4& g0 = acc[ai][bj][m][0]; const f32x4& g1 = acc[ai][bj][m][1];
          r0[0] = sigmoidf_(g0[0]) * bflo(pv.x); r0[1] = sigmoidf_(g0[1]) * bfhi(pv.x); r0[2] = sigmoidf_(g0[2]) * bflo(pv.y); r0[3] = sigmoidf_(g0[3]) * bfhi(pv.y);
          r1[0] = sigmoidf_(g1[0]) * bflo(pv.z); r1[1] = sigmoidf_(g1[1]) * bfhi(pv.z); r1[2] = sigmoidf_(g1[2]) * bflo(pv.w); r1[3] = sigmoidf_(g1[3]) * bfhi(pv.w);
          if (!first) { const u32x4 mv = *(const u32x4*)mp;
            r0[0] += bflo(mv.x); r0[1] += bfhi(mv.x); r0[2] += bflo(mv.y); r0[3] += bfhi(mv.y); r1[0] += bflo(mv.z); r1[1] += bfhi(mv.z); r1[2] += bflo(mv.w); r1[3] += bfhi(mv.w); }
          *(u32x4*)mp = pack8v(r0, r1); } }
  }
};

struct Desc { const char* A; const char* B; int lda, ldb, nt, pm, pn, kind; };
template <class Sched, class Epi>
DI void gemm_stream(char* smem, const Sched& S_, const Epi& E) {
  LAS unsigned char* lds = (LAS unsigned char*)smem;
  const int tid = get_tid(), wid = __builtin_amdgcn_readfirstlane(tid >> 6), lane = tid & 63, wr = wid >> 2, wc = wid & 3, fr = lane & 15, fq = lane >> 4;
  int R0, C0, R1, C1;
  stage_rc(tid * 16, R0, C0); stage_rc(tid * 16 + 8192, R1, C1);
  const int Rb0 = Epi::PERM ? ((R0 & ~31) + perm32(R0 & 31)) : R0, Rb1 = Epi::PERM ? ((R1 & ~31) + perm32(R1 & 31)) : R1;
  C0 *= 2; C1 *= 2;
  const size_t kstep = (size_t)(BK * 2);
  const unsigned ldsw = (unsigned)wid * 1024u;
  const int aoff = lds_byte(wr * 64 + fr, fq * 8), boff = lds_byte(wc * 32 + fr, fq * 8);
#define PG8_SA(b, h) (((b) * 2 + (h)) * HTB)
#define PG8_SB(b, h) ((4 + (b) * 2 + (h)) * HTB)
#define PG8_STAGE3(bufoff, gbase, ld2, RA, RB) do { \
    __builtin_amdgcn_global_load_lds((const unsigned*)((const char*)(gbase) + (unsigned)((RA) * (ld2) + C0)), (LAS unsigned*)(lds + (bufoff) + ldsw), 16, 0, 0); \
    __builtin_amdgcn_global_load_lds((const unsigned*)((const char*)(gbase) + (unsigned)((RB) * (ld2) + C1)), (LAS unsigned*)(lds + (bufoff) + ldsw + 8192), 16, 0, 0); } while (0)
#define PG8_STA(bufoff, gbase, ld2) PG8_STAGE3(bufoff, gbase, ld2, R0, R1)
#define PG8_STB(bufoff, gbase, ld2) PG8_STAGE3(bufoff, gbase, ld2, Rb0, Rb1)
#define PG8_LDA(dst, b, h) do { _Pragma("unroll") for (int m = 0; m < 4; ++m) _Pragma("unroll") for (int k = 0; k < 2; ++k) dst[m][k] = *(const LAS bf16x8*)(lds + PG8_SA(b, h) + aoff + m * 2048 + k * 1024); } while (0)
#define PG8_LDB(dst, b, h) do { _Pragma("unroll") for (int n = 0; n < 2; ++n) _Pragma("unroll") for (int k = 0; k < 2; ++k) dst[n][k] = *(const LAS bf16x8*)(lds + PG8_SB(b, h) + boff + n * 2048 + k * 1024); } while (0)
#define PG8_MMA(ai, bj, At, Bt_) do { __builtin_amdgcn_s_setprio(1); _Pragma("unroll") for (int m = 0; m < 4; ++m) _Pragma("unroll") for (int n = 0; n < 2; ++n) _Pragma("unroll") for (int k = 0; k < 2; ++k) \
    acc[ai][bj][m][n] = __builtin_amdgcn_mfma_f32_16x16x32_bf16(Bt_[n][k], At[m][k], acc[ai][bj][m][n], 0, 0, 0); __builtin_amdgcn_s_setprio(0); } while (0)
#define PG8_WAIT_V(n) asm volatile("s_waitcnt vmcnt(" #n ")" ::: "memory")
#define PG8_WAIT_L(n) asm volatile("s_waitcnt lgkmcnt(" #n ")" ::: "memory")
#define PG8_BAR __builtin_amdgcn_s_barrier()
#define PG8_SCHED __builtin_amdgcn_sched_barrier(0)
  Desc cur, nxt; int ui = 0;
  if (!S_.next(0, cur)) return;
  f32x4 acc[2][2][4][2];
#pragma unroll
  for (int a = 0; a < 2; ++a)
#pragma unroll
    for (int b = 0; b < 2; ++b)
#pragma unroll
      for (int m = 0; m < 4; ++m)
#pragma unroll
        for (int n = 0; n < 2; ++n) acc[a][b][m][n] = (f32x4){0.f, 0.f, 0.f, 0.f};
  bf16x8 At[4][2], B0[2][2], B1[2][2];
  const char* cA = cur.A; const char* cB = cur.B;
  {
    const int la2 = cur.lda * 2, lb2 = cur.ldb * 2; const size_t hA = (size_t)HALF * la2, hB = (size_t)HALF * lb2;
    PG8_STB(PG8_SB(0, 0), cB, lb2); PG8_STA(PG8_SA(0, 0), cA, la2); PG8_STB(PG8_SB(0, 1), cB + hB, lb2); PG8_STA(PG8_SA(0, 1), cA + hA, la2);
    if (wr == 1) PG8_BAR;
    PG8_WAIT_V(4); PG8_BAR;
    PG8_STB(PG8_SB(1, 0), cB + kstep, lb2); PG8_STA(PG8_SA(1, 0), cA + kstep, la2); PG8_STB(PG8_SB(1, 1), cB + hB + kstep, lb2);
    PG8_WAIT_V(6); PG8_BAR;
  }
  for (;;) {
    const bool has_next = S_.next(ui + 1, nxt);
    if (!has_next) nxt = cur;
    const char* nA = nxt.A; const char* nB = nxt.B;
    const int nt = cur.nt;
    const int la2 = cur.lda * 2; const size_t hA = (size_t)HALF * la2;
    for (int t = 0; t < nt; t += 2) {
      const bool last = (t == nt - 2);
      const char* a1 = cA + (size_t)(t + 1) * kstep;
      const char* a2 = last ? nA : cA + (size_t)(t + 2) * kstep; const char* b2 = last ? nB : cB + (size_t)(t + 2) * kstep;
      const char* a3 = a2 + kstep; const char* b3 = b2 + kstep;
      const int xa2 = (last ? nxt.lda : cur.lda) * 2, xb2 = (last ? nxt.ldb : cur.ldb) * 2;
      const size_t xhA = (size_t)HALF * xa2, xhB = (size_t)HALF * xb2;
      PG8_LDB(B0, 0, 0); PG8_SCHED; PG8_LDA(At, 0, 0); PG8_STA(PG8_SA(1, 1), a1 + hA, la2);
      PG8_WAIT_L(8); PG8_BAR; PG8_WAIT_L(0); PG8_MMA(0, 0, At, B0); PG8_BAR; PG8_SCHED;
      PG8_LDB(B1, 0, 1); PG8_STB(PG8_SB(0, 0), b2, xb2);
      PG8_BAR; PG8_WAIT_L(0); PG8_MMA(0, 1, At, B1); PG8_BAR;
      PG8_LDA(At, 0, 1); PG8_STA(PG8_SA(0, 0), a2, xa2);
      PG8_BAR; PG8_WAIT_L(0); PG8_MMA(1, 0, At, B0); PG8_BAR; PG8_SCHED;
      PG8_STB(PG8_SB(0, 1), b2 + xhB, xb2);
      PG8_WAIT_V(6); PG8_BAR; PG8_MMA(1, 1, At, B1); PG8_BAR;
      PG8_LDB(B0, 1, 0); PG8_SCHED; PG8_LDA(At, 1, 0); PG8_STA(PG8_SA(0, 1), a2 + xhA, xa2);
      PG8_WAIT_L(8); PG8_BAR; PG8_WAIT_L(0); PG8_MMA(0, 0, At, B0); PG8_BAR; PG8_SCHED;
      PG8_LDB(B1, 1, 1); PG8_STB(PG8_SB(1, 0), b3, xb2);
      PG8_BAR; PG8_WAIT_L(0); PG8_MMA(0, 1, At, B1); PG8_BAR;
      PG8_LDA(At, 1, 1); PG8_STA(PG8_SA(1, 0), a3, xa2);
      PG8_BAR; PG8_WAIT_L(0); PG8_MMA(1, 0, At, B0); PG8_BAR; PG8_SCHED;
      PG8_STB(PG8_SB(1, 1), b3 + xhB, xb2);
      PG8_WAIT_V(6); PG8_BAR; PG8_MMA(1, 1, At, B1); PG8_BAR;
    }
    E(acc, cur, wr, wc, fr, fq);
    if (!has_next) break;
#pragma unroll
    for (int a = 0; a < 2; ++a)
#pragma unroll
      for (int b = 0; b < 2; ++b)
#pragma unroll
        for (int m = 0; m < 4; ++m)
#pragma unroll
          for (int n = 0; n < 2; ++n) acc[a][b][m][n] = (f32x4){0.f, 0.f, 0.f, 0.f};
    cur = nxt; cA = nA; cB = nB; ++ui;
  }
  PG8_WAIT_V(0);
  if (wr == 0) PG8_BAR;
  PG8_BAR;
#undef PG8_SA
#undef PG8_SB
#undef PG8_STAGE3
#undef PG8_STA
#undef PG8_STB
#undef PG8_LDA
#undef PG8_LDB
#undef PG8_MMA
#undef PG8_WAIT_V
#undef PG8_WAIT_L
#undef PG8_BAR
#undef PG8_SCHED
}

struct MergeSched {
  const bf16_t* H; const bf16_t* Z; const bf16_t* W; int nM, skip, G, c;
  DI bool next(int i, Desc& d) const {
    const int tseq = i / 6, step = i - tseq * 6, x = step >> 1, isg = step & 1;
    const long L = (long)tseq * G + c; const int nwg = nM * 4; if (L >= nwg) return false;
    int wgid = (int)L; { const int q = nwg / NXCD, r = nwg % NXCD, xcd = wgid % NXCD, off = wgid / NXCD; wgid = (xcd < r ? xcd * (q + 1) : r * (q + 1) + (xcd - r) * q) + off; }
    const int nig = WGM * 4, gid = wgid / nig, fm = gid * WGM, gsz = (nM - fm) < WGM ? (nM - fm) : WGM;
    int pm = fm + ((wgid % nig) % gsz); const int pn = (wgid % nig) / gsz;
    if (skip) pm = pm + pm / 16 + 1;
    d.pm = pm; d.pn = pn; d.kind = step;
    if (isg) { d.A = (const char*)(H + (size_t)pm * 256 * 1024); d.lda = 1024; d.B = (const char*)(W + W_G + (size_t)(x * 1024 + pn * 256) * 1024); d.ldb = 1024; d.nt = 16; }
    else { const int yc = x == 0 ? Z_YA : (x == 1 ? Z_YB : Z_YC);
      d.A = (const char*)(Z + (size_t)pm * 256 * ZS + yc); d.lda = ZS; d.B = (const char*)(W + W_OA + (size_t)x * 1024 * 512 + (size_t)pn * 256 * 512); d.ldb = 512; d.nt = 8; }
    return true;
  }
};
struct EpiMergeS {
  static constexpr bool PERM = true;
  u32x4* slab; bf16_t* M;
  DI void operator()(const acc_t& acc, const Desc& u, int wr, int wc, int fr, int fq) const {
    u32x4* sp = slab + get_tid(); asm volatile("" : "+v"(sp));
    if (!(u.kind & 1)) {
#pragma unroll
      for (int ai = 0; ai < 2; ++ai)
#pragma unroll
        for (int m = 0; m < 4; ++m)
#pragma unroll
          for (int bj = 0; bj < 2; ++bj) sp[((ai * 4 + m) * 2 + bj) * 512] = pack8v(acc[ai][bj][m][0], acc[ai][bj][m][1]);
    } else {
      const int first = u.kind == 1;
      const int row0 = u.pm * BM + wr * 64 + fr, col0 = u.pn * BM + wc * 32 + 8 * fq;
#pragma unroll
      for (int ai = 0; ai < 2; ++ai) {
        MEMBAR();
        u32x4 pv[4][2], mv[4][2];
#pragma unroll
        for (int m = 0; m < 4; ++m)
#pragma unroll
          for (int bj = 0; bj < 2; ++bj) {
            pv[m][bj] = sp[((ai * 4 + m) * 2 + bj) * 512];
            if (!first) mv[m][bj] = *(const u32x4*)(M + (size_t)(row0 + ai * HALF + m * 16) * ZS + col0 + bj * HALF);
          }
#pragma unroll
        for (int m = 0; m < 4; ++m)
#pragma unroll
          for (int bj = 0; bj < 2; ++bj) {
            bf16_t* mp = M + (size_t)(row0 + ai * HALF + m * 16) * ZS + col0 + bj * HALF;
            const u32x4 pq = pv[m][bj];
            f32x4 r0, r1;
            const f32x4& g0 = acc[ai][bj][m][0]; const f32x4& g1 = acc[ai][bj][m][1];
            r0[0] = sigmoidf_(g0[0]) * bflo(pq.x); r0[1] = sigmoidf_(g0[1]) * bfhi(pq.x); r0[2] = sigmoidf_(g0[2]) * bflo(pq.y); r0[3] = sigmoidf_(g0[3]) * bfhi(pq.y);
            r1[0] = sigmoidf_(g1[0]) * bflo(pq.z); r1[1] = sigmoidf_(g1[1]) * bfhi(pq.z); r1[2] = sigmoidf_(g1[2]) * bflo(pq.w); r1[3] = sigmoidf_(g1[3]) * bfhi(pq.w);
            if (!first) { const u32x4 mq = mv[m][bj];
              r0[0] += bflo(mq.x); r0[1] += bfhi(mq.x); r0[2] += bflo(mq.y); r0[3] += bfhi(mq.y); r1[0] += bflo(mq.z); r1[1] += bfhi(mq.z); r1[2] += bflo(mq.w); r1[3] += bfhi(mq.w); }
            *(u32x4*)mp = pack8v(r0, r1);
          }
      }
    }
  }
};

struct GemmASched {
  const bf16_t* H; const bf16_t* W; int G, c;
  DI bool next(int i, Desc& d) const {
    const long L = (long)i * G + c; if (L >= 1496 + 272) return false;
    d.lda = 1024; d.ldb = 1024; d.nt = 16;
    if (L < 1496) {
      const int nwg = 1496, nN = 11, nM = 136;
      int wgid = (int)L; { const int q = nwg / NXCD, r = nwg % NXCD, xcd = wgid % NXCD, off = wgid / NXCD; wgid = (xcd < r ? xcd * (q + 1) : r * (q + 1) + (xcd - r) * q) + off; }
      const int nig = WGM * nN, gid = wgid / nig, fm = gid * WGM, gsz = (nM - fm) < WGM ? (nM - fm) : WGM;
      d.pm = fm + ((wgid % nig) % gsz); d.pn = (wgid % nig) / gsz; d.kind = 0;
      d.A = (const char*)(H + (size_t)d.pm * 256 * 1024); d.B = (const char*)(W + W_IN + (size_t)d.pn * 256 * 1024);
    } else {
      const int j = (int)L - 1496; d.pm = j & 1; d.pn = j >> 1; d.kind = 1;
      d.A = (const char*)(W + W_IN + (size_t)(2816 + d.pm * 256) * 1024); d.B = (const char*)(H + (size_t)d.pn * 256 * 1024);
    }
    return true;
  }
};
struct EpiGemmA {
  static constexpr bool PERM = true;
  bf16_t* Z; bf16_t* RVT;
  DI void operator()(const acc_t& acc, const Desc& u, int wr, int wc, int fr, int fq) const {
    const int row0 = u.pm * BM + wr * 64 + fr;
    if (u.kind == 0) {
      const int col0 = u.pn * BM + wc * 32 + 8 * fq;
#pragma unroll
      for (int ai = 0; ai < 2; ++ai)
#pragma unroll
        for (int m = 0; m < 4; ++m) { bf16_t* rowp = Z + (size_t)(row0 + ai * HALF + m * 16) * ZS + col0;
#pragma unroll
          for (int bj = 0; bj < 2; ++bj) *(u32x4*)(rowp + bj * HALF) = pack8v(acc[ai][bj][m][0], acc[ai][bj][m][1]); }
    } else {
      const int t0 = u.pn * BM, b = t0 / S, s0 = t0 - b * S + wc * 32 + 8 * fq;
#pragma unroll
      for (int ai = 0; ai < 2; ++ai)
#pragma unroll
        for (int m = 0; m < 4; ++m) { bf16_t* rowp = RVT + ((size_t)b * 512 + row0 + ai * HALF + m * 16) * S + s0;
#pragma unroll
          for (int bj = 0; bj < 2; ++bj) *(u32x4*)(rowp + bj * HALF) = pack8v(acc[ai][bj][m][0], acc[ai][bj][m][1]); }
    }
  }
};
struct EpiResid {
  static constexpr bool PERM = false;
  Params p; int layer, chunk, from_input;
  DI void operator()(const acc_t& acc, const Unit& u, int wr, int wc, int fr, int fq) const {
    const int row0 = u.pm * BM + wr * 64 + fr, col0 = u.pn * BM + wc * 32 + 4 * fq;
    const int b = u.pm / 17, g = (u.pm - b * 17) == 0 ? 8 : b;
    const float* gate = modp(p, layer, g, chunk);
    f32x4 gv[2][2];
#pragma unroll
    for (int bj = 0; bj < 2; ++bj)
#pragma unroll
      for (int n = 0; n < 2; ++n) gv[bj][n] = *(const f32x4*)(gate + col0 + bj * HALF + n * 16);
#pragma unroll
    for (int q = 0; q < 4; ++q) {
      const int ai = q >> 1, mh = q & 1;
      MEMBAR();
      f32x4 xv[2][2][2];
#pragma unroll
      for (int mm = 0; mm < 2; ++mm) { const int t = row0 + ai * HALF + (2 * mh + mm) * 16;
        const float* xi = from_input ? xrow_in(p, t) : xrow_ws(p, t);
#pragma unroll
        for (int bj = 0; bj < 2; ++bj)
#pragma unroll
          for (int n = 0; n < 2; ++n) xv[mm][bj][n] = *(const f32x4*)(xi + col0 + bj * HALF + n * 16); }
      MEMBAR();
#pragma unroll
      for (int mm = 0; mm < 2; ++mm) { const int t = row0 + ai * HALF + (2 * mh + mm) * 16;
        float* xo = xrow_ws(p, t);
#pragma unroll
        for (int bj = 0; bj < 2; ++bj)
#pragma unroll
          for (int n = 0; n < 2; ++n) *(f32x4*)(xo + col0 + bj * HALF + n * 16) = xv[mm][bj][n] + gv[bj][n] * acc[ai][bj][2 * mh + mm][n]; }
    }
  }
};
struct EpiFFN1 {
  static constexpr bool PERM = true;
  bf16_t* G;
  DI void operator()(const acc_t& acc, const Unit& u, int wr, int wc, int fr, int fq) const {
    const int row0 = u.pm * BM + wr * 64 + fr, col0 = u.pn * HALF + wc * 32 + 8 * fq;
#pragma unroll
    for (int ai = 0; ai < 2; ++ai)
#pragma unroll
      for (int m = 0; m < 4; ++m) {
        f32x4 r0, r1;
#pragma unroll
        for (int e = 0; e < 4; ++e) { r0[e] = siluf_(acc[ai][0][m][0][e]) * acc[ai][1][m][0][e]; r1[e] = siluf_(acc[ai][0][m][1][e]) * acc[ai][1][m][1][e]; }
        *(u32x4*)(G + (size_t)(row0 + ai * HALF + m * 16) * DFF + col0) = pack8v(r0, r1); }
  }
};
DI void conv_job(const float* src0, const float* src1, int ld, int K, int N, bf16_t* dst, int kind, const float* kscale, char* smem, int& rot) {
  float* tile = (float*)smem;
  const int ktn = K >> 6, ntn = N >> 6, kq = (ktn + 3) >> 2, nit = kq * ntn;
  const int G = gridDim.x;
  int start = blockIdx.x + rot; if (start >= G) start -= G;
  for (int it = start; it < nit; it += G) {
    const int tid = get_tid(), tx = tid & 15, ty = tid >> 4;
    const int nt = it / kq, kt0 = (it - nt * kq) * 4, nkt = (ktn - kt0) < 4 ? (ktn - kt0) : 4;
    const int n = nt * 64 + tx * 4;
    const float* src = src0; int col = n;
    if (kind == 1) {
      if (n < 512) col = n;
      else if (n < 768) col = 800 + (n - 512);
      else if (n < 1024) col = 1952 + (n - 768);
      else if (n < 1280) col = 512 + (n - 1024);
      else if (n < 1664) col = 1568 + (n - 1280);
      else if (n < 2176) col = 2208 + (n - 1664);
      else if (n < 2688) col = 2720 + (n - 2176);
      else if (n < 2720) col = 768 + (n - 2688);
      else if (n < 2816) col = -1;
      else col = 1056 + (n - 2816);
    } else if (kind == 2) { col = 3232 + n;
    } else if (kind == 4) { col = (n >> 6) * 128 + (n & 63);
    } else if (kind == 5) { col = (n >> 6) * 128 + 64 + (n & 63);
    } else if (kind == 6) { const int tl = n >> 8, c = n & 255; col = tl * 128 + (c & 127); src = (c >> 7) ? src1 : src0; }
    float4 v[4][2];
#pragma unroll
    for (int q = 0; q < 4; ++q)
#pragma unroll
      for (int ps = 0; ps < 2; ++ps) {
        v[q][ps] = make_float4(0.f, 0.f, 0.f, 0.f);
        if (q < nkt && col >= 0) { const int k = (kt0 + q) * 64 + ty + 32 * ps; v[q][ps] = *(const float4*)(src + (size_t)k * ld + col); }
      }
    __syncthreads();
#pragma unroll
    for (int q = 0; q < 4; ++q)
#pragma unroll
      for (int ps = 0; ps < 2; ++ps) {
        if (q < nkt) {
          const int kl = ty + 32 * ps; float4 w = v[q][ps];
          if (kscale) { const float sc = kscale[(kt0 + q) * 64 + kl]; w.x *= sc; w.y *= sc; w.z *= sc; w.w *= sc; }
          float* tp = tile + (q * 64 + kl) * 65 + tx * 4;
          tp[0] = w.x; tp[1] = w.y; tp[2] = w.z; tp[3] = w.w;
        }
      }
    __syncthreads();
    {
      const int kc = tid & 7, nl = tid >> 3;
#pragma unroll
      for (int q = 0; q < 4; ++q) {
        if (q < nkt) {
          const float* tp = tile + (q * 64 + kc * 8) * 65 + nl;
          u32x4 o; o.x = pk2(tp[0], tp[65]); o.y = pk2(tp[130], tp[195]); o.z = pk2(tp[260], tp[325]); o.w = pk2(tp[390], tp[455]);
          *(u32x4*)(dst + (size_t)(nt * 64 + nl) * K + (kt0 + q) * 64 + kc * 8) = o;
        }
      }
    }
  }
  rot = (rot + G - (nit % G)) % G;
}

DI void phase_convert(const Params& p, int l, int rot, char* smem) {
  {
    bf16_t* W = wl(p, l);
    conv_job(p.w_in + (size_t)l * D * NIN, nullptr, NIN, 1024, 3328, W + W_IN, 1, nullptr, smem, rot);
    conv_job(p.w_in + (size_t)l * D * NIN, nullptr, NIN, 1024, 3072, W + W_G, 2, nullptr, smem, rot);
    conv_job(p.w_uq + (size_t)l * 384 * 768, nullptr, 768, 384, 768, W + W_UQ, 0, p.g_q + l * 384, smem, rot);
    conv_job(p.w_ukv + (size_t)l * 256 * 1024, nullptr, 1024, 256, 512, W + W_UK, 4, p.g_kv + l * 256, smem, rot);
    conv_job(p.w_ukv + (size_t)l * 256 * 1024, nullptr, 1024, 256, 512, W + W_UV, 5, p.g_kv + l * 256, smem, rot);
    for (int nbk = 0; nbk < 8; ++nbk)
      for (int jj = 0; jj < 4; ++jj) {
        const float* s = ((jj & 1) ? p.lru_wx : p.lru_wa) + ((size_t)((l * 2 + (jj >> 1)) * 8 + nbk)) * 4096;
        conv_job(s, nullptr, 64, 64, 64, W + W_L + (size_t)(nbk * 256 + jj * 64) * 64, 0, nullptr, smem, rot);
      }
    conv_job(p.w_oa + (size_t)l * 512 * 1024, nullptr, 1024, 512, 1024, W + W_OA, 0, nullptr, smem, rot);
    conv_job(p.w_ob + (size_t)l * 512 * 1024, nullptr, 1024, 512, 1024, W + W_OB, 0, nullptr, smem, rot);
    conv_job(p.w_oc + (size_t)l * 512 * 1024, nullptr, 1024, 512, 1024, W + W_OC, 0, nullptr, smem, rot);
    conv_job(p.w_out + (size_t)l * 1024 * 1024, nullptr, 1024, 1024, 1024, W + W_OUT, 0, nullptr, smem, rot);
    conv_job(p.w_ff1 + (size_t)l * 1024 * DFF, p.w_ff3 + (size_t)l * 1024 * DFF, DFF, 1024, 5632, W + W_FF13, 6, nullptr, smem, rot);
    conv_job(p.w_ff2 + (size_t)l * DFF * 1024, nullptr, 1024, DFF, 1024, W + W_FF2, 0, nullptr, smem, rot);
  }
}
DI void phase_setup(const Params& p, char* smem) {
  int rot = 0;
  {
    float* act = (float*)smem;
    float* red = act + 9 * 1024;
    bool have = false;
    int mstart = blockIdx.x + rot; if (mstart >= (int)gridDim.x) mstart -= gridDim.x;
    for (int it = mstart; it < 2 * 96; it += gridDim.x) {
      const int tid = get_tid(), tx = tid & 63, ty = tid >> 6;
      __syncthreads();
      if (!have) {
        for (int i = tid; i < 9 * 1024; i += NT) { int g = i >> 10, k = i & 1023; float v = g < 8 ? p.c[g * 1024 + k] : p.c_ctx[k]; act[i] = siluf_(v); }
        have = true;
        __syncthreads();
      }
      const int l = it / 96, j = (it - l * 96) * 64 + tx;
      float a[9];
#pragma unroll
      for (int g = 0; g < 9; ++g) a[g] = 0.f;
      const float* wm = p.w_mod + (size_t)l * 1024 * 6144 + j;
#pragma unroll 8
      for (int k = ty * 128; k < ty * 128 + 128; ++k) {
        const float wv = wm[(size_t)k * 6144];
#pragma unroll
        for (int g = 0; g < 9; ++g) a[g] += act[g * 1024 + k] * wv;
      }
#pragma unroll
      for (int g = 0; g < 9; ++g) red[(ty * 9 + g) * 64 + tx] = a[g];
      __syncthreads();
      for (int i = tid; i < 9 * 64; i += NT) {
        int g = i >> 6, c = i & 63;
        float v = 0.f;
#pragma unroll
        for (int q = 0; q < 8; ++q) v += red[(q * 9 + g) * 64 + c];
        int jj = (it - l * 96) * 64 + c;
        ((float*)(p.ws + OFF_MOD))[(size_t)(l * 9 + g) * 6144 + jj] = v + p.b_mod[l * 6144 + jj];
      }
    }
  }
  {
    float* axc = (float*)(p.ws + OFF_AXC); float* axs = (float*)(p.ws + OFF_AXS);
    float* rtc = (float*)(p.ws + OFF_RTC); float* rts = (float*)(p.ws + OFF_RTS);
    const int gt = blockIdx.x * NT + get_tid(), gs = gridDim.x * NT;
    for (int i = gt; i < 4096 * 16; i += gs) {
      int n = i >> 4, j = i & 15; int row = n >> 6, col = n & 63;
      float inv = exp2f(-(float)(j & 7) * (13.287712379549449f / 8.f));
      float ang = (float)(j < 8 ? row : col) * inv;
      float sn, cs; sincosf(ang, &sn, &cs);
      axc[i] = cs; axs[i] = sn;
    }
    for (int i = gt; i < S * 32; i += gs) {
      int s = i >> 5, j = i & 31;
      float th = exp2f(-(float)j * (13.287712379549449f / 31.f));
      float ang = (float)s * th;
      float sn, cs; sincosf(ang, &sn, &cs);
      rtc[i] = cs; rts[i] = sn;
    }
  }
}

DI void phase_norm(const Params& p, int layer, int which, bool from_input, bool skipctx) {
  bf16_t* H = (bf16_t*)(p.ws + OFF_H);
  const float* gam = (which ? p.g_ffn : p.g_mix) + layer * 1024;
  const int tid_ = get_tid(); const int lane = tid_ & 63, w = tid_ >> 6;
  float4 gg[4], s4[4], c4[4];
#pragma unroll
  for (int i = 0; i < 4; ++i) { gg[i] = *(const float4*)(gam + (i * 64 + lane) * 4); s4[i] = make_float4(0.f, 0.f, 0.f, 0.f); c4[i] = s4[i]; }
  int gc = -1;
  for (int t0 = (blockIdx.x * 8 + w) * 2; t0 < T; t0 += gridDim.x * 16) {
    const int b = t0 / S, s = t0 - b * S, g = s < LC ? 8 : b;
    if (skipctx && s < LC) continue;
    if (g != gc) {
      const float* sh = modp(p, layer, g, which ? 3 : 0);
      const float* sc = modp(p, layer, g, which ? 4 : 1);
#pragma unroll
      for (int i = 0; i < 4; ++i) { s4[i] = *(const float4*)(sh + (i * 64 + lane) * 4); c4[i] = *(const float4*)(sc + (i * 64 + lane) * 4); }
      gc = g;
    }
    float4 v[2][4]; float ss[2] = {0.f, 0.f};
#pragma unroll
    for (int u = 0; u < 2; ++u) {
      const float* xr = from_input ? xrow_in(p, t0 + u) : xrow_ws(p, t0 + u);
#pragma unroll
      for (int i = 0; i < 4; ++i) { v[u][i] = *(const float4*)(xr + (i * 64 + lane) * 4); }
    }
#pragma unroll
    for (int u = 0; u < 2; ++u) {
#pragma unroll
      for (int i = 0; i < 4; ++i) ss[u] += v[u][i].x * v[u][i].x + v[u][i].y * v[u][i].y + v[u][i].z * v[u][i].z + v[u][i].w * v[u][i].w;
      ss[u] = wave_sum(ss[u]);
    }
#pragma unroll
    for (int i = 0; i < 4; ++i) {
      const int k = (i * 64 + lane) * 4;
#pragma unroll
      for (int u = 0; u < 2; ++u) {
        const float rstd = rsqrtf(ss[u] * (1.f / 1024.f) + EPS);
        float o0 = v[u][i].x * rstd * gg[i].x * (1.f + c4[i].x) + s4[i].x, o1 = v[u][i].y * rstd * gg[i].y * (1.f + c4[i].y) + s4[i].y;
        float o2 = v[u][i].z * rstd * gg[i].z * (1.f + c4[i].z) + s4[i].z, o3 = v[u][i].w * rstd * gg[i].w * (1.f + c4[i].w) + s4[i].w;
        uint2 o; o.x = pk2(o0, o1); o.y = pk2(o2, o3);
        *(uint2*)(H + (size_t)(t0 + u) * 1024 + k) = o;
      }
    }
  }
}
DI void phase_final_norm(const Params& p) {
  const int tid_ = get_tid(); const int lane = tid_ & 63, w = tid_ >> 6;
  float4 gg[4];
#pragma unroll
  for (int i = 0; i < 4; ++i) gg[i] = *(const float4*)(p.g_final + (i * 64 + lane) * 4);
  for (int t = blockIdx.x * 8 + w; t < NB * SEQ; t += gridDim.x * 8) {
    float* xr = p.out + (size_t)t * D;
    float4 v[4]; float ss = 0.f;
#pragma unroll
    for (int i = 0; i < 4; ++i) { v[i] = *(const float4*)(xr + (i * 64 + lane) * 4); ss += v[i].x * v[i].x + v[i].y * v[i].y + v[i].z * v[i].z + v[i].w * v[i].w; }
    ss = wave_sum(ss);
    const float rstd = rsqrtf(ss * (1.f / 1024.f) + EPS);
#pragma unroll
    for (int i = 0; i < 4; ++i) {
      const int k = (i * 64 + lane) * 4;
      float4 o; o.x = v[i].x * rstd * gg[i].x; o.y = v[i].y * rstd * gg[i].y; o.z = v[i].z * rstd * gg[i].z; o.w = v[i].w * rstd * gg[i].w;
      *(float4*)(xr + k) = o;
    }
  }
}
DI void phase_lownorm(const Params& p) {
  bf16_t* Z = (bf16_t*)(p.ws + OFF_Z);
  const int tid_ = get_tid(); const int lane = tid_ & 63, w = tid_ >> 6;
  for (int t0 = (blockIdx.x * 8 + w) * 2; t0 < T; t0 += gridDim.x * 16) {
    uint4 q[2], k[2];
#pragma unroll
    for (int u = 0; u < 2; ++u) {
      bf16_t* zr = Z + (size_t)(t0 + u) * ZS;
      q[u] = make_uint4(0, 0, 0, 0); k[u] = make_uint4(0, 0, 0, 0);
      if (lane < 48) q[u] = *(const uint4*)(zr + Z_QD + lane * 8);
      if (lane < 32) k[u] = *(const uint4*)(zr + Z_KVD + lane * 8);
    }
#pragma unroll
    for (int u = 0; u < 2; ++u) {
      bf16_t* zr = Z + (size_t)(t0 + u) * ZS;
      float sq = 0.f, sk = 0.f, a;
      a = bflo(q[u].x); sq += a * a; a = bfhi(q[u].x); sq += a * a; a = bflo(q[u].y); sq += a * a; a = bfhi(q[u].y); sq += a * a;
      a = bflo(q[u].z); sq += a * a; a = bfhi(q[u].z); sq += a * a; a = bflo(q[u].w); sq += a * a; a = bfhi(q[u].w); sq += a * a;
      a = bflo(k[u].x); sk += a * a; a = bfhi(k[u].x); sk += a * a; a = bflo(k[u].y); sk += a * a; a = bfhi(k[u].y); sk += a * a;
      a = bflo(k[u].z); sk += a * a; a = bfhi(k[u].z); sk += a * a; a = bflo(k[u].w); sk += a * a; a = bfhi(k[u].w); sk += a * a;
      sq = wave_sum(sq); sk = wave_sum(sk);
      const float rq = rsqrtf(sq * (1.f / 384.f) + EPS), rk = rsqrtf(sk * (1.f / 256.f) + EPS);
      if (lane < 48) { uint4 o; o.x = pk2(bflo(q[u].x) * rq, bfhi(q[u].x) * rq); o.y = pk2(bflo(q[u].y) * rq, bfhi(q[u].y) * rq); o.z = pk2(bflo(q[u].z) * rq, bfhi(q[u].z) * rq); o.w = pk2(bflo(q[u].w) * rq, bfhi(q[u].w) * rq); *(uint4*)(zr + Z_QD + lane * 8) = o; }
      if (lane < 32) { uint4 o; o.x = pk2(bflo(k[u].x) * rk, bfhi(k[u].x) * rk); o.y = pk2(bflo(k[u].y) * rk, bfhi(k[u].y) * rk); o.z = pk2(bflo(k[u].z) * rk, bfhi(k[u].z) * rk); o.w = pk2(bflo(k[u].w) * rk, bfhi(k[u].w) * rk); *(uint4*)(zr + Z_KVD + lane * 8) = o; }
    }
  }
}

DI void phase_gemm_a(const Params& p, int layer, char* smem) {
  GemmASched s{(const bf16_t*)(p.ws + OFF_H), wl(p, layer), (int)gridDim.x, (int)blockIdx.x};
  EpiGemmA e{(bf16_t*)(p.ws + OFF_Z), (bf16_t*)(p.ws + OFF_RVT)};
  gemm_stream(smem, s, e);
}
DI int vblock(int rot) { const int G = gridDim.x; int v = (int)blockIdx.x - rot; if (v < 0) v += G; return v; }
DI void phase_qkv(const Params& p, int layer, int hf, char* smem, int& rot) {
  const int G_ = gridDim.x;
  const bf16_t* W = wl(p, layer);
  const bf16_t* Z = (const bf16_t*)(p.ws + OFF_Z) + (size_t)hf * TH * ZS;
  bf16_t* Kb = (bf16_t*)(p.ws + OFF_K);
  const float* axc = (const float*)(p.ws + OFF_AXC); const float* axs = (const float*)(p.ws + OFF_AXS);
  { Order o; o.init(68, 3, 0, vblock(rot)); EpiStoreBf16 e{(bf16_t*)(p.ws + OFF_Q), 768}; gemm_phase(smem, Z + Z_QD, ZS, W + W_UQ, 384, 384, o, e); rot = (rot + 204) % G_; }
  { Order o; o.init(68, 2, 0, vblock(rot)); EpiK e{Kb}; gemm_phase(smem, Z + Z_KVD, ZS, W + W_UK, 256, 256, o, e); rot = (rot + 136) % G_; }
  { Order o; o.init(2, 68, 0, vblock(rot)); EpiTokT e{(bf16_t*)(p.ws + OFF_VT), 512}; gemm_phase(smem, W + W_UV, 256, Z + Z_KVD, ZS, 256, o, e); rot = (rot + 136) % G_; }
  {
    const int gt = blockIdx.x * NT + get_tid(), gs = gridDim.x * NT;
    for (int tl = gt; tl < TH; tl += gs) {
      const int bl = tl / S, s = tl - bl * S;
      const uint4* kr = (const uint4*)(Z + (size_t)tl * ZS + Z_KR);
      const uint4 a0 = kr[0], a1 = kr[1], b0 = kr[2], b1 = kr[3];
      const unsigned xa[8] = {a0.x, a0.y, a0.z, a0.w, a1.x, a1.y, a1.z, a1.w}, xb[8] = {b0.x, b0.y, b0.z, b0.w, b1.x, b1.y, b1.z, b1.w};
      unsigned o1[8], o2[8];
#pragma unroll
      for (int q = 0; q < 8; ++q) {
        float x1l = bflo(xa[q]), x1h = bfhi(xa[q]), x2l = bflo(xb[q]), x2h = bfhi(xb[q]);
        float c0 = 1.f, s0 = 0.f, c1 = 1.f, s1 = 0.f;
        if (s >= LC) { c0 = axc[(s - LC) * 16 + 2 * q]; s0 = axs[(s - LC) * 16 + 2 * q]; c1 = axc[(s - LC) * 16 + 2 * q + 1]; s1 = axs[(s - LC) * 16 + 2 * q + 1]; }
        o1[q] = pk2(x1l * c0 - x2l * s0, x1h * c1 - x2h * s1);
        o2[q] = pk2(x1l * s0 + x2l * c0, x1h * s1 + x2h * c1);
      }
#pragma unroll
      for (int hd = 0; hd < 8; ++hd) {
        uint4* kd = (uint4*)(Kb + ((size_t)(bl * 8 + hd) * S + s) * 96 + 64);
        kd[0] = make_uint4(o1[0], o1[1], o1[2], o1[3]); kd[1] = make_uint4(o1[4], o1[5], o1[6], o1[7]);
        kd[2] = make_uint4(o2[0], o2[1], o2[2], o2[3]); kd[3] = make_uint4(o2[4], o2[5], o2[6], o2[7]);
      }
    }
  }
}
DI void phase_merge(const Params& p, int layer, bool skipctx, char* smem) {
  MergeSched s{(const bf16_t*)(p.ws + OFF_H), (const bf16_t*)(p.ws + OFF_Z), wl(p, layer), skipctx ? 128 : 136, skipctx ? 1 : 0, (int)gridDim.x, (int)blockIdx.x};
  EpiMergeS e{(u32x4*)(p.ws + OFF_Q) + (size_t)blockIdx.x * 16 * 512, (bf16_t*)(p.ws + OFF_Z) + Z_M};
  gemm_stream(smem, s, e);
}
DI void phase_resid_gemm(const Params& p, int layer, const bf16_t* A, int lda, const bf16_t* BT, int K, int chunk, bool from_input, bool skipctx, char* smem) {
  Order o; o.init(skipctx ? 128 : 136, 4, skipctx);
  EpiResid e{p, layer, chunk, from_input};
  gemm_phase(smem, A, lda, BT, K, K, o, e);
}
DI void phase_ffn1(const Params& p, int layer, bool skipctx, char* smem) {
  Order o; o.init(skipctx ? 128 : 136, 22, skipctx);
  EpiFFN1 e{(bf16_t*)(p.ws + OFF_Z)};
  gemm_phase(smem, (const bf16_t*)(p.ws + OFF_H), 1024, wl(p, layer) + W_FF13, 1024, 1024, o, e);
}
DI void phase_attn(const Params& p, int hf, bool skipctx, char* smem, int& rot) {
  const bf16_t* Qb = (const bf16_t*)(p.ws + OFF_Q);
  const bf16_t* Kb = (const bf16_t*)(p.ws + OFF_K);
  const bf16_t* VTb = (const bf16_t*)(p.ws + OFF_VT);
  bf16_t* Z = (bf16_t*)(p.ws + OFF_Z) + (size_t)hf * TH * ZS;
  constexpr int KROW = 208, VROW = 264, KB_ = 128 * KROW, STG = KB_ + 64 * VROW;
  const int nitem = HB * 8 * 16 + (skipctx ? 0 : HB * 8);
  const int vb_ = vblock(rot); rot = (rot + nitem) % (int)gridDim.x;
  for (int it = vb_; it < nitem; it += gridDim.x) {
    const int tid = get_tid(), lane = tid & 63, w = tid >> 6, r = lane & 31, h = lane >> 5;
    int bh, s0, nkt;
    if (it < HB * 8 * 16) {
      int li = it;
      if (gridDim.x == 256) { const int c_ = it & 255, rr_ = it >> 8, idx_ = (c_ >> 3) + 32 * rr_; li = ((c_ & 7) * 4 + (idx_ >> 4)) * 16 + (idx_ & 15); }
      bh = li >> 4; s0 = LC + (li & 15) * 256; nkt = S / 128;
    } else { bh = it - HB * 8 * 16; s0 = 0; nkt = LC / 128; }
    const int head = bh & 7, bl = bh >> 3;
    const size_t tq = (size_t)bl * S + s0 + w * 32 + r;
    bf16x8 qf[6];
    {
      const float* axc = (const float*)(p.ws + OFF_AXC); const float* axs = (const float*)(p.ws + OFF_AXS);
      uint4 qu[6];
#pragma unroll
      for (int ks = 0; ks < 6; ++ks) qu[ks] = *(const uint4*)(Qb + tq * 768 + head * 96 + ks * 16 + h * 8);
#pragma unroll
      for (int ks = 0; ks < 4; ++ks) {
        const uint4 u = qu[ks];
        qf[ks] = pack8(bflo(u.x) * QSCALE, bfhi(u.x) * QSCALE, bflo(u.y) * QSCALE, bfhi(u.y) * QSCALE, bflo(u.z) * QSCALE, bfhi(u.z) * QSCALE, bflo(u.w) * QSCALE, bfhi(u.w) * QSCALE);
      }
      const unsigned a1[4] = {qu[4].x, qu[4].y, qu[4].z, qu[4].w}, a2[4] = {qu[5].x, qu[5].y, qu[5].z, qu[5].w};
      float o1[8], o2[8];
      const int sq_ = s0 + w * 32 + r;
#pragma unroll
      for (int e = 0; e < 8; ++e) {
        const float x1 = ((e & 1) ? bfhi(a1[e >> 1]) : bflo(a1[e >> 1])) * QSCALE;
        const float x2 = ((e & 1) ? bfhi(a2[e >> 1]) : bflo(a2[e >> 1])) * QSCALE;
        float cs = 1.f, sn = 0.f;
        if (sq_ >= LC) { cs = axc[(sq_ - LC) * 16 + 8 * h + e]; sn = axs[(sq_ - LC) * 16 + 8 * h + e]; }
        o1[e] = x1 * cs - x2 * sn; o2[e] = x1 * sn + x2 * cs;
      }
      qf[4] = pack8(o1[0], o1[1], o1[2], o1[3], o1[4], o1[5], o1[6], o1[7]);
      qf[5] = pack8(o2[0], o2[1], o2[2], o2[3], o2[4], o2[5], o2[6], o2[7]);
    }
    const bf16_t* Kg = Kb + (size_t)(bl * 8 + head) * S * 96;
    const bf16_t* Vg = VTb + (size_t)(bl * 8 + head) * 64 * S;
    f32x16 o[2]; o[0] = zero16(); o[1] = zero16();
    float m_run = -1e30f, l_run = 0.f;
    uint4 ak0, ak1, ak2, av0, av1, bk0, bk1, bk2, bv0, bv1;
    const int kr0 = tid / 12, kc0 = tid - kr0 * 12, kr1 = (tid + 512) / 12, kc1 = (tid + 512) - kr1 * 12, kr2 = (tid + 1024) / 12, kc2 = (tid + 1024) - kr2 * 12;
    const int vr0 = tid >> 4, vr1 = (tid + 512) >> 4, vc = tid & 15;
#define ATT_LOAD(K0, K1, K2, V0, V1, t_) do { \
      K0 = *(const uint4*)(Kg + (size_t)((t_) * 128 + kr0) * 96 + kc0 * 8); K1 = *(const uint4*)(Kg + (size_t)((t_) * 128 + kr1) * 96 + kc1 * 8); K2 = *(const uint4*)(Kg + (size_t)((t_) * 128 + kr2) * 96 + kc2 * 8); \
      V0 = *(const uint4*)(Vg + (size_t)vr0 * S + (t_) * 128 + vc * 8); V1 = *(const uint4*)(Vg + (size_t)vr1 * S + (t_) * 128 + vc * 8); } while (0)
#define ATT_WRITE(K0, K1, K2, V0, V1, buf) do { char* sk_ = smem + (buf) * STG; char* sv_ = sk_ + KB_; \
      *(uint4*)(sk_ + kr0 * KROW + kc0 * 16) = K0; *(uint4*)(sk_ + kr1 * KROW + kc1 * 16) = K1; *(uint4*)(sk_ + kr2 * KROW + kc2 * 16) = K2; \
      *(uint2*)(sv_ + vr0 * VROW + vc * 16) = make_uint2(V0.x, V0.y); *(uint2*)(sv_ + vr0 * VROW + vc * 16 + 8) = make_uint2(V0.z, V0.w); \
      *(uint2*)(sv_ + vr1 * VROW + vc * 16) = make_uint2(V1.x, V1.y); *(uint2*)(sv_ + vr1 * VROW + vc * 16 + 8) = make_uint2(V1.z, V1.w); } while (0)
    auto compute = [&](int buf, int half) {
      const char* sk = smem + buf * STG + half * 64 * KROW; const char* sv = smem + buf * STG + KB_ + half * 128;
      f32x16 st[2]; st[0] = zero16(); st[1] = zero16();
      {
        bf16x8 kf[2][6];
#pragma unroll
        for (int kb = 0; kb < 2; ++kb)
#pragma unroll
          for (int ks = 0; ks < 6; ++ks) kf[kb][ks] = *(const bf16x8*)(sk + (kb * 32 + r) * KROW + (ks * 16 + h * 8) * 2);
        __builtin_amdgcn_sched_barrier(0);
#pragma unroll
        for (int ks = 0; ks < 6; ++ks)
#pragma unroll
          for (int kb = 0; kb < 2; ++kb) st[kb] = MFMA(kf[kb][ks], qf[ks], st[kb]);
        __builtin_amdgcn_sched_barrier(0);
      }
      bf16x8 vf[2][2][2];
#pragma unroll
      for (int kb = 0; kb < 2; ++kb)
#pragma unroll
        for (int s2 = 0; s2 < 2; ++s2)
#pragma unroll
          for (int dvb = 0; dvb < 2; ++dvb) {
            const char* vp = sv + (dvb * 32 + r) * VROW + (kb * 32 + 16 * s2 + 4 * h) * 2;
            const s16x4 lo = *(const s16x4*)vp, hi = *(const s16x4*)(vp + 16);
            vf[kb][s2][dvb] = __builtin_shufflevector(lo, hi, 0, 1, 2, 3, 4, 5, 6, 7);
          }
      float mx = st[0][0];
#pragma unroll
      for (int i = 0; i < 16; ++i) { mx = fmaxf(mx, st[0][i]); mx = fmaxf(mx, st[1][i]); }
      if (__any(mx > m_run + 8.f)) {
        mx = fmaxf(mx, __shfl_xor(mx, 32));
        const float m_new = fmaxf(m_run, mx);
        const float alpha = fexp2(m_run - m_new);
        m_run = m_new;
        l_run *= alpha;
#pragma unroll
        for (int i = 0; i < 16; ++i) { o[0][i] *= alpha; o[1][i] *= alpha; }
      }
      float ps = 0.f;
#pragma unroll
      for (int kb = 0; kb < 2; ++kb)
#pragma unroll
        for (int i = 0; i < 16; ++i) { const float e = fexp2(st[kb][i] - m_run); st[kb][i] = e; ps += e; }
      l_run += ps;
#pragma unroll
      for (int kb = 0; kb < 2; ++kb)
#pragma unroll
        for (int s2 = 0; s2 < 2; ++s2) {
          const bf16x8 pb = pack8(st[kb][8 * s2 + 0], st[kb][8 * s2 + 1], st[kb][8 * s2 + 2], st[kb][8 * s2 + 3], st[kb][8 * s2 + 4], st[kb][8 * s2 + 5], st[kb][8 * s2 + 6], st[kb][8 * s2 + 7]);
#pragma unroll
          for (int dvb = 0; dvb < 2; ++dvb) o[dvb] = MFMA(vf[kb][s2][dvb], pb, o[dvb]);
        }
    };
    __syncthreads();
    ATT_LOAD(ak0, ak1, ak2, av0, av1, 0);
    ATT_LOAD(bk0, bk1, bk2, bv0, bv1, 1);
    ATT_WRITE(ak0, ak1, ak2, av0, av1, 0);
    __syncthreads();
    for (int kt = 0; kt < nkt; kt += 2) {
      if (kt + 2 < nkt) ATT_LOAD(ak0, ak1, ak2, av0, av1, kt + 2);
      compute(0, 0); compute(0, 1);
      ATT_WRITE(bk0, bk1, bk2, bv0, bv1, 1);
      __syncthreads();
      if (kt + 3 < nkt) ATT_LOAD(bk0, bk1, bk2, bv0, bv1, kt + 3);
      compute(1, 0); compute(1, 1);
      if (kt + 2 < nkt) ATT_WRITE(ak0, ak1, ak2, av0, av1, 0);
      __syncthreads();
    }
#undef ATT_LOAD
#undef ATT_WRITE
    const float lt = l_run + __shfl_xor(l_run, 32);
    const float inv = 1.f / lt;
    bf16_t* ot = (bf16_t*)smem;
#pragma unroll
    for (int dvb = 0; dvb < 2; ++dvb)
#pragma unroll
      for (int i = 0; i < 16; ++i) ot[(w * 32 + r) * 72 + dvb * 32 + crow(i, h)] = f2bf(o[dvb][i] * inv);
    __syncthreads();
#pragma unroll
    for (int i = 0; i < 4; ++i) {
      const int c = tid + 512 * i, row = c >> 3, kc = c & 7;
      const uint4 v = *(const uint4*)((const char*)ot + row * 144 + kc * 16);
      *(uint4*)(Z + ((size_t)bl * S + s0 + row) * ZS + Z_YB + head * 64 + kc * 8) = v;
    }
  }
}

DI void phase_lru(const Params& p, int layer, int b0, int nb, int mode, bool skipctx, char* smem) {
  bf16_t* Z = (bf16_t*)(p.ws + OFF_Z);
  const bf16_t* WL = wl(p, layer) + W_L;
  float2* AGG = (float2*)(p.ws + OFF_AGG);
  const float* H0 = (const float*)(p.ws + OFF_H0);
  bf16_t* xs0 = (bf16_t*)smem;
  bf16_t* uA = (bf16_t*)(smem + 17408);
  float* uF = (float*)(smem + 26624);
  float* sA = (float*)(smem + 43008);
  float* sB = (float*)(smem + 76288);
  float* h0s = (float*)(smem + 109568);
  constexpr int SD = 64 * 65;
  const float* cw = p.conv_w + layer * 4 * 512; const float* cb = p.conv_b + layer * 512;
  int G = gridDim.x; asm volatile("" : "+s"(G));
  const int nbn = nb * 8, bpg = G / nbn;
  const int bn = blockIdx.x / bpg, sub = blockIdx.x - bn * bpg;
  if (bn >= nbn) return;
  const int nblk = bn & 7, b = b0 + (bn >> 3);
  const int jlo = (mode == 1 && skipctx) ? 4 : 0;
  const int tid0 = get_tid(), lane0 = tid0 & 63, w0_ = tid0 >> 6, r0 = lane0 & 31, h0_ = lane0 >> 5;
  const int chh0 = (w0_ >> 1) & 1, dw0 = w0_ >> 2;
  bf16x8 bq[4][2];
#pragma unroll
  for (int ks = 0; ks < 4; ++ks)
#pragma unroll
    for (int q = 0; q < 2; ++q) bq[ks][q] = *(const bf16x8*)(WL + (size_t)(nblk * 256 + (2 * dw0 + q) * 64 + chh0 * 32 + r0) * 64 + ks * 16 + 8 * h0_);
  const int chgl = nblk * 64 + chh0 * 32 + r0;
  const float sp = log1p_pos(__expf(-p.lru_lam[(layer * 2 + dw0) * 512 + chgl]));
  const float ba = p.lru_ba[(layer * 2 + dw0) * 512 + chgl], bx = p.lru_bx[(layer * 2 + dw0) * 512 + chgl];
  const int chg = nblk * 64 + (tid0 & 63);
  const float w0 = cw[chg], w1 = cw[512 + chg], w2 = cw[1024 + chg], w3 = cw[1536 + chg], bb = cb[chg];
  uint4 pre0 = make_uint4(0, 0, 0, 0), pre1 = make_uint4(0, 0, 0, 0);
  float preh = 0.f;
  int tid = tid0;
  auto issue = [&](int j) {
    if (mode == 1 && tid < 128) preh = H0[((size_t)(b * 2 + (tid >> 6)) * 68 + j) * 512 + nblk * 64 + (tid & 63)];
    const int s0 = j * 64, slo = j < 4 ? 0 : LC, shi = j < 4 ? LC : S;
    { const int row = tid >> 3, kc = tid & 7, s = s0 - 2 + row;
      pre0 = make_uint4(0, 0, 0, 0);
      if (s >= slo && s < shi) pre0 = *(const uint4*)(Z + ((size_t)b * S + s) * ZS + Z_LRUX + nblk * 64 + kc * 8); }
    { const int c = tid + 512, row = c >> 3, kc = c & 7, s = s0 - 2 + row;
      pre1 = make_uint4(0, 0, 0, 0);
      if (c < 67 * 8 && s >= slo && s < shi) pre1 = *(const uint4*)(Z + ((size_t)b * S + s) * ZS + Z_LRUX + nblk * 64 + kc * 8); }
  };
  auto stash = [&](int buf) {
    char* xb_ = (char*)xs0 + buf * 8704;
    *(uint4*)(xb_ + (tid >> 3) * 128 + (tid & 7) * 16) = pre0;
    if (tid + 512 < 67 * 8) *(uint4*)(xb_ + ((tid + 512) >> 3) * 128 + (tid & 7) * 16) = pre1;
    if (mode == 1 && tid < 128) h0s[tid] = preh;
  };
  __syncthreads();
  issue(jlo + sub);
  stash(0);
  int cur = 0;
  for (int j = jlo + sub; j < 68; j += bpg, cur ^= 1) {
    const int s0 = j * 64;
    const bf16_t* xs = xs0 + cur * (8704 / 2);
    tid = get_tid();
    const int lane = tid & 63, w = tid >> 6, r = lane & 31, h = lane >> 5, th = w & 1, chh = (w >> 1) & 1, dw = w >> 2, chl = chh * 32 + r, ch = tid & 63;
    const int sd = w >> 2, sc16 = lane & 15, sseg = lane >> 4, sch = (w & 3) * 16 + sc16;
    __syncthreads();
#pragma unroll
    for (int i = 0; i < 8; ++i) {
      const int tok = (tid >> 6) + 8 * i;
      const float u = bb + w0 * bf2f(xs[tok * 64 + ch]) + w1 * bf2f(xs[(tok + 1) * 64 + ch]) + w2 * bf2f(xs[(tok + 2) * 64 + ch]) + w3 * bf2f(xs[(tok + 3) * 64 + ch]);
      uF[tok * 64 + ch] = u; uA[tok * 72 + ch] = f2bf(u);
    }
    const float h0v = (mode == 1) ? h0s[sd * 64 + sch] : 0.f;
    if (j + bpg < 68) issue(j + bpg);
    __syncthreads();
    {
      f32x16 acc[2]; acc[0] = zero16(); acc[1] = zero16();
#pragma unroll
      for (int ks = 0; ks < 4; ++ks) {
        const bf16x8 a = *(const bf16x8*)((const char*)uA + (th * 32 + r) * 144 + (ks * 16 + 8 * h) * 2);
#pragma unroll
        for (int q = 0; q < 2; ++q) acc[q] = MFMA(a, bq[ks][q], acc[q]);
      }
#pragma unroll
      for (int i = 0; i < 16; ++i) {
        const int tok = th * 32 + crow(i, h);
        const float rr = sigmoidf_(acc[0][i] + ba), ii = sigmoidf_(acc[1][i] + bx);
        const float a_ = __builtin_amdgcn_exp2f(-11.541560327111707f * rr * sp);
        sA[dw * SD + tok * 65 + chl] = a_;
        sB[dw * SD + tok * 65 + chl] = __builtin_amdgcn_sqrtf(__builtin_fmaf(-a_, a_, 1.f)) * ii * uF[tok * 64 + chl];
      }
    }
    unsigned short gate[8];
    if (mode == 1) {
      const bf16_t* gp = Z + ((size_t)b * S + s0 + (tid >> 6)) * ZS + Z_LGATE + nblk * 64 + ch;
#pragma unroll
      for (int i = 0; i < 8; ++i) gate[i] = gp[(size_t)(8 * i) * ZS];
    }
    __syncthreads();
    {
      float av[16], bv[16];
#pragma unroll
      for (int q = 0; q < 16; ++q) {
        const int pi = sseg * 16 + q, tok = sd ? 63 - pi : pi;
        av[q] = sA[sd * SD + tok * 65 + sch]; bv[q] = sB[sd * SD + tok * 65 + sch];
      }
      float P = 1.f, E = 0.f;
#pragma unroll
      for (int q = 0; q < 16; ++q) { E = av[q] * E + bv[q]; P *= av[q]; }
      float hh = h0v, PP = 1.f, EE = 0.f;
#pragma unroll
      for (int sg = 0; sg < 4; ++sg) {
        const float Pg = __shfl(P, sc16 + 16 * sg), Eg = __shfl(E, sc16 + 16 * sg);
        if (sg < sseg) hh = Pg * hh + Eg;
        EE = Pg * EE + Eg; PP *= Pg;
      }
      if (mode == 0) {
        if (sseg == 0) AGG[((size_t)(b * 2 + sd) * 68 + j) * 512 + nblk * 64 + sch] = make_float2(PP, EE);
      } else {
#pragma unroll
        for (int q = 0; q < 16; ++q) {
          const int pi = sseg * 16 + q, tok = sd ? 63 - pi : pi;
          hh = av[q] * hh + bv[q];
          sB[sd * SD + tok * 65 + sch] = hh;
        }
      }
    }
    if (mode == 1) {
      __syncthreads();
#pragma unroll
      for (int i = 0; i < 8; ++i) {
        const int tok = (tid >> 6) + 8 * i;
        const float g = bf2f(gate[i]);
        Z[((size_t)b * S + s0 + tok) * ZS + Z_LGATE + nblk * 64 + ch] = f2bf(geluf_(g) * (sB[tok * 65 + ch] + sB[SD + tok * 65 + ch]));
      }
    }
    stash(cur ^ 1);
  }
}

template <int DIR>
DI void lru_prefix_one(const float2* ag, float* h0) {
  float hh = 0.f;
#pragma unroll 1
  for (int g = 0; g < 4; ++g) {
    float2 v[17];
#pragma unroll
    for (int i = 0; i < 17; ++i) { const int q = g * 17 + i; const int t = DIR ? (q < 4 ? 3 - q : 71 - q) : q; v[i] = ag[(size_t)t * 512]; }
#pragma unroll
    for (int i = 0; i < 17; ++i) { const int q = g * 17 + i; const int t = DIR ? (q < 4 ? 3 - q : 71 - q) : q; h0[(size_t)t * 512] = hh; hh = v[i].x * hh + v[i].y; }
  }
}
DI void phase_lru_prefix(const Params& p) {
  const float2* AGG = (const float2*)(p.ws + OFF_AGG);
  float* H0 = (float*)(p.ws + OFF_H0);
  for (int it = blockIdx.x; it < NB * 2; it += gridDim.x) {
    const int tid = get_tid(), d = it & 1;
    const float2* ag = AGG + (size_t)it * 68 * 512 + tid;
    float* h0 = H0 + (size_t)it * 68 * 512 + tid;
    if (d) lru_prefix_one<1>(ag, h0); else lru_prefix_one<0>(ag, h0);
  }
}

DI float ret_lg2(int head, int d) { return log2f(1.f - exp2f(-(d ? 5.5f : 5.0f) - (float)head)); }

DI void phase_ret_states(const Params& p, int hf, char* smem, int& rot) {
  const bf16_t* Z = (const bf16_t*)(p.ws + OFF_Z) + (size_t)hf * TH * ZS;
  const bf16_t* RVT = (const bf16_t*)(p.ws + OFF_RVT) + (size_t)hf * HB * 512 * S;
  float* CS = (float*)(p.ws + OFF_CS);
  const float* rtc = (const float*)(p.ws + OFF_RTC); const float* rts = (const float*)(p.ws + OFF_RTS);
  bf16_t* KT0 = (bf16_t*)smem;
  bf16_t* KT1 = (bf16_t*)(smem + 17408);
  char* VT = smem + 34816;
  const int nitem = HB * 4 * 34;
  const int vb_ = vblock(rot); rot = (rot + nitem) % (int)gridDim.x;
  for (int it = vb_; it < nitem; it += gridDim.x) {
    const int tid = get_tid(), lane = tid & 63, w = tid >> 6, r = lane & 31, h = lane >> 5;
    const int c = it % 34, bh = it / 34, head = bh & 3, bl = bh >> 2;
    const float lgf = ret_lg2(head, 0), lgb = ret_lg2(head, 1);
    __syncthreads();
    {
      const int tok = tid >> 2, cp = tid & 3, s = c * 128 + tok;
      const bf16_t* kp = Z + ((size_t)bl * S + s) * ZS + Z_RETK + head * 64 + cp * 8;
      const uint4 u1 = *(const uint4*)kp, u2 = *(const uint4*)(kp + 32);
      const unsigned a1[4] = {u1.x, u1.y, u1.z, u1.w}, a2[4] = {u2.x, u2.y, u2.z, u2.w};
      const float wf = fexp2((float)(127 - tok) * lgf) * 0.125f, wb = fexp2((float)tok * lgb) * 0.125f;
#pragma unroll
      for (int e = 0; e < 8; ++e) {
        const int jd = cp * 8 + e;
        const float x1 = (e & 1) ? bfhi(a1[e >> 1]) : bflo(a1[e >> 1]);
        const float x2 = (e & 1) ? bfhi(a2[e >> 1]) : bflo(a2[e >> 1]);
        const float cs = rtc[s * 32 + jd], sn = rts[s * 32 + jd];
        const float k1 = x1 * cs - x2 * sn, k2 = x1 * sn + x2 * cs;
        KT0[jd * 136 + tok] = f2bf(k1 * wf); KT0[(jd + 32) * 136 + tok] = f2bf(k2 * wf);
        KT1[jd * 136 + tok] = f2bf(k1 * wb); KT1[(jd + 32) * 136 + tok] = f2bf(k2 * wb);
      }
    }
    {
      uint4 vq[4];
#pragma unroll
      for (int u = 0; u < 4; ++u) { const int ch = tid + 512 * u, row = ch >> 4, kc = ch & 15; vq[u] = *(const uint4*)(RVT + ((size_t)(bl * 4 + head) * 128 + row) * S + c * 128 + kc * 8); }
#pragma unroll
      for (int u = 0; u < 4; ++u) { const int ch = tid + 512 * u, row = ch >> 4, kc = ch & 15; *(uint4*)(VT + row * 272 + kc * 16) = vq[u]; }
    }
    __syncthreads();
    const int dvb = w & 3, d = w >> 2;
    const char* KTd = (const char*)(d ? KT1 : KT0);
    f32x16 acc[2]; acc[0] = zero16(); acc[1] = zero16();
#pragma unroll
    for (int ks = 0; ks < 8; ++ks) {
      const bf16x8 a = *(const bf16x8*)(VT + (dvb * 32 + r) * 272 + (ks * 16 + 8 * h) * 2);
#pragma unroll
      for (int nb2 = 0; nb2 < 2; ++nb2) {
        const bf16x8 b0 = *(const bf16x8*)(KTd + (nb2 * 32 + r) * 272 + (ks * 16 + 8 * h) * 2);
        acc[nb2] = MFMA(a, b0, acc[nb2]);
      }
    }
#pragma unroll
    for (int nb2 = 0; nb2 < 2; ++nb2)
#pragma unroll
      for (int i = 0; i < 16; ++i)
        CS[((size_t)((bl * 4 + head) * 34 + c) * 2 + d) * 8192 + (dvb * 32 + crow(i, h)) * 64 + nb2 * 32 + r] = acc[nb2][i];
  }
}
template <int DIR>
DI void ret_prefix_one(const float* base, bf16_t* ob, float g128) {
  float v[34];
#pragma unroll
  for (int i = 0; i < 34; ++i) { const int c = DIR ? (i < 2 ? 1 - i : 35 - i) : i; v[i] = base[(size_t)c * 2 * 8192]; }
  float run = 0.f;
#pragma unroll
  for (int i = 0; i < 34; ++i) { const int c = DIR ? (i < 2 ? 1 - i : 35 - i) : i; ob[(size_t)c * 2 * 8192] = f2bf(run); run = g128 * run + v[i]; }
}
DI void phase_ret_prefix(const Params& p) {
  const float* CS = (const float*)(p.ws + OFF_CS);
  bf16_t* CSB = (bf16_t*)(p.ws + OFF_CSB);
  const int nitem = HB * 4 * 2 * 16;
  for (int it = blockIdx.x; it < nitem; it += gridDim.x) {
    const int eb = it & 15, d = (it >> 4) & 1, bh = it >> 5, head = bh & 3;
    const float g128 = exp2f(128.f * ret_lg2(head, d));
    const size_t off = ((size_t)(bh * 34) * 2 + d) * 8192 + eb * 512 + get_tid();
    if (d) ret_prefix_one<1>(CS + off, CSB + off, g128); else ret_prefix_one<0>(CS + off, CSB + off, g128);
  }
}
DI void phase_ret_out(const Params& p, int hf, bool skipctx, char* smem0, int& rot) {
  bf16_t* Z = (bf16_t*)(p.ws + OFF_Z) + (size_t)hf * TH * ZS;
  const bf16_t* RVT = (const bf16_t*)(p.ws + OFF_RVT) + (size_t)hf * HB * 512 * S;
  const bf16_t* CS = (const bf16_t*)(p.ws + OFF_CSB);
  const float* rtc = (const float*)(p.ws + OFF_RTC); const float* rts = (const float*)(p.ws + OFF_RTS);
  const int cpb = skipctx ? 32 : 34;
  const int npair = HB * 4 * cpb / 2;
  const int vb_ = vblock(rot); rot = (rot + npair) % (int)gridDim.x;
  for (int itp = vb_; itp < npair; itp += gridDim.x) {
    const int tid5 = get_tid(), grp = tid5 >> 8, tid = tid5 & 255, lane = tid & 63, w = tid >> 6, r = lane & 31, h = lane >> 5;
    char* smem = smem0 + grp * 53248;
    char* KR = smem;
    char* VT = smem + 18432;
    bf16_t* ot = (bf16_t*)(smem + 18432);
    const int it = itp * 2 + grp;
    int c, bh;
    if (skipctx) { c = (it & 31) + 2; bh = it >> 5; } else { c = it % 34; bh = it / 34; }
    const int head = bh & 3, bl = bh >> 2;
    const float lgf = ret_lg2(head, 0), lgb = ret_lg2(head, 1);
    __syncthreads();
#pragma unroll 1
    for (int u = 0; u < 2; ++u) {
      const int q = tid + 256 * u, tok = q >> 2, cp = q & 3, s = c * 128 + tok;
      const bf16_t* kp = Z + ((size_t)bl * S + s) * ZS + Z_RETK + head * 64 + cp * 8;
      const uint4 u1 = *(const uint4*)kp, u2 = *(const uint4*)(kp + 32);
      const unsigned a1[4] = {u1.x, u1.y, u1.z, u1.w}, a2[4] = {u2.x, u2.y, u2.z, u2.w};
      float k1[8], k2[8];
#pragma unroll
      for (int e = 0; e < 8; ++e) {
        const int jd = cp * 8 + e;
        const float x1 = (e & 1) ? bfhi(a1[e >> 1]) : bflo(a1[e >> 1]);
        const float x2 = (e & 1) ? bfhi(a2[e >> 1]) : bflo(a2[e >> 1]);
        const float cs = rtc[s * 32 + jd], sn = rts[s * 32 + jd];
        k1[e] = (x1 * cs - x2 * sn) * 0.125f; k2[e] = (x1 * sn + x2 * cs) * 0.125f;
      }
      *(bf16x8*)(KR + tok * 144 + cp * 16) = pack8(k1[0], k1[1], k1[2], k1[3], k1[4], k1[5], k1[6], k1[7]);
      *(bf16x8*)(KR + tok * 144 + 64 + cp * 16) = pack8(k2[0], k2[1], k2[2], k2[3], k2[4], k2[5], k2[6], k2[7]);
    }
    {
      uint4 vq[8];
#pragma unroll
      for (int u = 0; u < 8; ++u) { const int ch = tid + 256 * u, row = ch >> 4, kc = ch & 15; vq[u] = *(const uint4*)(RVT + ((size_t)(bl * 4 + head) * 128 + row) * S + c * 128 + kc * 8); }
#pragma unroll
      for (int u = 0; u < 8; ++u) { const int ch = tid + 256 * u, row = ch >> 4, kc = ch & 15; *(uint4*)(VT + row * 272 + kc * 16) = vq[u]; }
    }
    const int iq = w * 32 + r, sq = c * 128 + iq;
    bf16x8 qf[4];
    {
      const bf16_t* qp = Z + ((size_t)bl * S + sq) * ZS + Z_RETQ + head * 64;
#pragma unroll
      for (int ks = 0; ks < 2; ++ks) {
        MEMBAR();
        const uint4 u1 = *(const uint4*)(qp + ks * 16 + 8 * h), u2 = *(const uint4*)(qp + 32 + ks * 16 + 8 * h);
        const unsigned a1[4] = {u1.x, u1.y, u1.z, u1.w}, a2[4] = {u2.x, u2.y, u2.z, u2.w};
        float q1[8], q2[8];
#pragma unroll
        for (int e = 0; e < 8; ++e) {
          const int jd = ks * 16 + 8 * h + e;
          const float x1 = (e & 1) ? bfhi(a1[e >> 1]) : bflo(a1[e >> 1]);
          const float x2 = (e & 1) ? bfhi(a2[e >> 1]) : bflo(a2[e >> 1]);
          const float cs = rtc[sq * 32 + jd], sn = rts[sq * 32 + jd];
          q1[e] = x1 * cs - x2 * sn; q2[e] = x1 * sn + x2 * cs;
        }
        qf[ks] = pack8(q1[0], q1[1], q1[2], q1[3], q1[4], q1[5], q1[6], q1[7]);
        qf[ks + 2] = pack8(q2[0], q2[1], q2[2], q2[3], q2[4], q2[5], q2[6], q2[7]);
      }
    }
    __syncthreads();
    f32x16 o[4];
#pragma unroll
    for (int dvb = 0; dvb < 4; ++dvb) o[dvb] = zero16();
#pragma unroll
    for (int kb = 0; kb < 4; ++kb) {
      MEMBAR();
      f32x16 st = zero16();
#pragma unroll
      for (int ks = 0; ks < 4; ++ks) {
        const bf16x8 a = *(const bf16x8*)(KR + (kb * 32 + r) * 144 + (ks * 16 + 8 * h) * 2);
        st = MFMA(a, qf[ks], st);
      }
#pragma unroll
      for (int i = 0; i < 16; ++i) {
        const int dl = iq - (kb * 32 + crow(i, h));
        const float dlf = (float)dl;
        const float e = fexp2(dl > 0 ? dlf * lgf : -dlf * lgb);
        st[i] *= (dl == 0 ? 2.f : e);
      }
#pragma unroll
      for (int s2 = 0; s2 < 2; ++s2) {
        const bf16x8 pb = pack8(st[8 * s2 + 0], st[8 * s2 + 1], st[8 * s2 + 2], st[8 * s2 + 3], st[8 * s2 + 4], st[8 * s2 + 5], st[8 * s2 + 6], st[8 * s2 + 7]);
#pragma unroll
        for (int dvb = 0; dvb < 4; ++dvb) {
          const char* vp = VT + (dvb * 32 + r) * 272 + (kb * 32 + 16 * s2 + 4 * h) * 2;
          const s16x4 lo = *(const s16x4*)vp, hi = *(const s16x4*)(vp + 16);
          const bf16x8 va = __builtin_shufflevector(lo, hi, 0, 1, 2, 3, 4, 5, 6, 7);
          o[dvb] = MFMA(va, pb, o[dvb]);
        }
      }
    }
#pragma unroll 1
    for (int d = 0; d < 2; ++d) {
      const float qdec = d ? fexp2((float)(128 - iq) * lgb) : fexp2((float)(iq + 1) * lgf);
      const bf16_t* Rg = CS + ((size_t)((bl * 4 + head) * 34 + c) * 2 + d) * 8192;
      bf16x8 rf[4][4];
#pragma unroll
      for (int dvb = 0; dvb < 4; ++dvb)
#pragma unroll
        for (int ks = 0; ks < 4; ++ks) rf[dvb][ks] = *(const bf16x8*)(Rg + (dvb * 32 + r) * 64 + ks * 16 + 8 * h);
#pragma unroll
      for (int dvb = 0; dvb < 4; ++dvb) {
        f32x16 t = zero16();
#pragma unroll
        for (int ks = 0; ks < 4; ++ks) t = MFMA(rf[dvb][ks], qf[ks], t);
#pragma unroll
        for (int i = 0; i < 16; ++i) o[dvb][i] += qdec * t[i];
      }
    }
    float sm = 0.f;
#pragma unroll
    for (int dvb = 0; dvb < 4; ++dvb)
#pragma unroll
      for (int i = 0; i < 16; ++i) sm += o[dvb][i];
    sm += __shfl_xor(sm, 32);
    const float mu = sm * (1.f / 128.f);
    float vs = 0.f;
#pragma unroll
    for (int dvb = 0; dvb < 4; ++dvb)
#pragma unroll
      for (int i = 0; i < 16; ++i) { const float dd = o[dvb][i] - mu; vs += dd * dd; }
    vs += __shfl_xor(vs, 32);
    const float rs = rsqrtf(vs * (1.f / 128.f) + EPS);
    __syncthreads();
#pragma unroll
    for (int dvb = 0; dvb < 4; ++dvb)
#pragma unroll
      for (int i = 0; i < 16; ++i) ot[iq * 136 + dvb * 32 + crow(i, h)] = f2bf((o[dvb][i] - mu) * rs);
    __syncthreads();
#pragma unroll 1
    for (int u = 0; u < 8; ++u) {
      const int ch = tid + 256 * u, row = ch >> 4, kc = ch & 15;
      bf16_t* gp = Z + ((size_t)bl * S + c * 128 + row) * ZS + Z_RGATE + head * 128 + kc * 8;
      const uint4 g4 = *(const uint4*)gp;
      const uint4 v4 = *(const uint4*)((const char*)ot + row * 272 + kc * 16);
      uint4 o4;
      o4.x = pk2(siluf_(bflo(g4.x)) * bflo(v4.x), siluf_(bfhi(g4.x)) * bfhi(v4.x));
      o4.y = pk2(siluf_(bflo(g4.y)) * bflo(v4.y), siluf_(bfhi(g4.y)) * bfhi(v4.y));
      o4.z = pk2(siluf_(bflo(g4.z)) * bflo(v4.z), siluf_(bfhi(g4.z)) * bfhi(v4.z));
      o4.w = pk2(siluf_(bflo(g4.w)) * bflo(v4.w), siluf_(bfhi(g4.w)) * bfhi(v4.w));
      *(uint4*)gp = o4;
    }
  }
}


__global__ void __launch_bounds__(NT, 2) fwd_megakernel(Params p) {
  extern __shared__ __attribute__((aligned(16))) char smem[];
  cg::grid_group grid = cg::this_grid();
  volatile LAS3 unsigned* xst = (volatile LAS3 unsigned*)(LAS3 unsigned*)(smem + SMEM_BYTES - 16);
  if (threadIdx.x == 0) { xst[0] = 0u; xst[1] = 0u; xst[2] = 0u; xst[3] = 0u; }
  __syncthreads();
  if (blockIdx.x == 0) { unsigned* bw = (unsigned*)(p.ws + OFF_BAR); for (int i = threadIdx.x; i < (int)(BAR_BYTES / 4); i += NT) bw[i] = 0u; }
  phase_setup(p, smem);
  grid.sync();
  const XcdBarrier xb = xcd_barrier_post((unsigned*)(p.ws + OFF_BAR), xst);
#define GSYNC() xcd_barrier(xb)
  for (int layer = 0; layer < 2; ++layer) {
    const bool first = layer == 0, last = layer == 1;
    phase_norm(p, layer, 0, first, false);
    if (first) phase_convert(p, 0, 0, smem);
    GSYNC();
    phase_gemm_a(p, layer, smem);
    GSYNC();
    phase_lownorm(p);
    phase_lru(p, layer, 0, NB, 0, false, smem);
    GSYNC();
    int rot = 16;
    phase_lru_prefix(p);
    phase_qkv(p, layer, 0, smem, rot);
    phase_ret_states(p, 0, smem, rot);
    GSYNC();
    phase_ret_prefix(p);
    rot = 0;
    phase_attn(p, 0, last, smem, rot);
    phase_lru(p, layer, 0, HB, 1, last, smem);
    GSYNC();
    rot = 0;
    phase_ret_out(p, 0, last, smem, rot);
    phase_qkv(p, layer, 1, smem, rot);
    phase_ret_states(p, 1, smem, rot);
    GSYNC();
    phase_ret_prefix(p);
    rot = 0;
    phase_attn(p, 1, last, smem, rot);
    phase_lru(p, layer, HB, HB, 1, last, smem);
    GSYNC();
    rot = 0;
    phase_ret_out(p, 1, last, smem, rot);
    GSYNC();
    phase_merge(p, layer, last, smem);
    if (first) phase_convert(p, 1, (int)gridDim.x - 32, smem);
    GSYNC();
    phase_resid_gemm(p, layer, (const bf16_t*)(p.ws + OFF_Z) + Z_M, ZS, wl(p, layer) + W_OUT, 1024, 2, first, last, smem);
    GSYNC();
    phase_norm(p, layer, 1, false, last);
    GSYNC();
    phase_ffn1(p, layer, last, smem);
    GSYNC();
    phase_resid_gemm(p, layer, (const bf16_t*)(p.ws + OFF_Z), DFF, wl(p, layer) + W_FF2, DFF, 5, false, last, smem);
    GSYNC();
  }
  phase_final_norm(p);
}

extern "C" void kernel_launch(void* const* d_in, const int* in_sizes, int n_in, void* d_out, int out_size, void* d_ws, size_t ws_size, hipStream_t stream) {
  static int grid_blocks = 0;
  if (!grid_blocks) {
    int dev = 0, cus = 0, per_cu = 0;
    (void)hipGetDevice(&dev);
    (void)hipDeviceGetAttribute(&cus, hipDeviceAttributeMultiprocessorCount, dev);
    if (hipFuncSetAttribute((const void*)fwd_megakernel, hipFuncAttributeMaxDynamicSharedMemorySize, SMEM_BYTES) != hipSuccess) fprintf(stderr, "hipFuncSetAttribute failed\n");
    (void)hipOccupancyMaxActiveBlocksPerMultiprocessor(&per_cu, fwd_megakernel, NT, SMEM_BYTES);
    if (per_cu < 1) per_cu = 1;
    grid_blocks = cus * per_cu;
  }
  if (ws_size < WS_TOTAL) { fprintf(stderr, "workspace too small: %zu < %zu\n", ws_size, (size_t)WS_TOTAL); return; }
  Params p{};
  const float** pp = (const float**)&p;
  for (int i = 0; i < 28; ++i) pp[i] = (const float*)d_in[i];
  p.out = (float*)d_out;
  p.ws = (char*)d_ws;
  void* args[] = {&p};
  hipError_t e = hipLaunchCooperativeKernel((void*)fwd_megakernel, dim3(grid_blocks), dim3(NT), args, SMEM_BYTES, stream);
  if (e != hipSuccess) fprintf(stderr, "cooperative launch failed: %s (grid %d)\n", hipGetErrorString(e), grid_blocks);
}
```

```cpp
#include <hip/hip_runtime.h>
#include <hip/hip_cooperative_groups.h>
#include <cstdio>
namespace cg = cooperative_groups;

#define DI __device__ __forceinline__
typedef unsigned short bf16_t;
using bf16x8 = __attribute__((ext_vector_type(8))) short;
using s16x4 = __attribute__((ext_vector_type(4))) short;
using f32x16 = __attribute__((ext_vector_type(16))) float;
typedef __bf16 bf2_t __attribute__((ext_vector_type(2)));
typedef float f2_t __attribute__((ext_vector_type(2)));
#define MFMA(a, b, c) __builtin_amdgcn_mfma_f32_32x32x16_bf16((a), (b), (c), 0, 0, 0)

constexpr int NB = 8, SEQ = 4096, LC = 256, S = 4352, D = 1024, T = NB * S;
constexpr int ZS = 2816, DFF = 2816, NIN = 6304;
constexpr int HB = 4;
constexpr int TH = HB * S;
constexpr float EPS = 1e-6f;
constexpr int Z_LRUX = 0, Z_RETK = 512, Z_RETQ = 768, Z_KVD = 1024, Z_QD = 1280, Z_LGATE = 1664, Z_RGATE = 2176, Z_KR = 2688;
constexpr int Z_M = 0, Z_YB = 1024, Z_YA = 1664, Z_YC = 2176;
constexpr size_t W_IN = 0;
constexpr size_t W_G = W_IN + 3328ull * 1024;
constexpr size_t W_UQ = W_G + 3072ull * 1024;
constexpr size_t W_UK = W_UQ + 768ull * 384;
constexpr size_t W_UV = W_UK + 512ull * 256;
constexpr size_t W_L = W_UV + 512ull * 256;
constexpr size_t W_OA = W_L + 8ull * 256 * 64;
constexpr size_t W_OB = W_OA + 1024ull * 512;
constexpr size_t W_OC = W_OB + 1024ull * 512;
constexpr size_t W_OUT = W_OC + 1024ull * 512;
constexpr size_t W_FF13 = W_OUT + 1024ull * 1024;
constexpr size_t W_FF2 = W_FF13 + 5632ull * 1024;
constexpr size_t W_LAYER = W_FF2 + 1024ull * 2816;
constexpr size_t OFF_W = 0;
constexpr size_t OFF_MOD = OFF_W + 2 * W_LAYER * 2;
constexpr size_t OFF_AXC = OFF_MOD + 2ull * 9 * 6144 * 4;
constexpr size_t OFF_AXS = OFF_AXC + 4096ull * 16 * 4;
constexpr size_t OFF_RTC = OFF_AXS + 4096ull * 16 * 4;
constexpr size_t OFF_RTS = OFF_RTC + 4352ull * 32 * 4;
constexpr size_t OFF_XC = OFF_RTS + 4352ull * 32 * 4;
constexpr size_t OFF_H = OFF_XC + 2048ull * 1024 * 4;
constexpr size_t OFF_Z = OFF_H + (size_t)T * 1024 * 2;
constexpr size_t OFF_RVT = OFF_Z + (size_t)T * ZS * 2;
constexpr size_t OFF_Q = OFF_RVT + 8ull * 512 * S * 2;
constexpr size_t OFF_K = OFF_Q + (size_t)TH * 768 * 2;
constexpr size_t OFF_VT = OFF_K + 4ull * 8 * S * 96 * 2;
constexpr size_t OFF_CS = OFF_VT + 4ull * 8 * 64 * S * 2;
constexpr size_t OFF_AGG = OFF_CS + 4ull * 4 * 34 * 2 * 8192 * 4;
constexpr size_t OFF_H0 = OFF_AGG + 8ull * 2 * 68 * 512 * 8;
constexpr size_t OFF_CSB = OFF_H0 + 8ull * 2 * 68 * 512 * 4;
constexpr size_t OFF_BAR = OFF_CSB + 4ull * 4 * 34 * 2 * 8192 * 2;
constexpr size_t BAR_BYTES = 3456 * 4;
constexpr size_t WS_TOTAL = OFF_BAR + 16384;

constexpr int NT = 512;
constexpr int SMEM_BYTES = 135168;
constexpr int SM_AUX = 131072;

struct Params {
  const float *x, *c, *ctx, *c_ctx, *w_mod, *b_mod, *g_mix, *g_ffn, *w_in, *conv_w, *conv_b, *lru_wa, *lru_ba, *lru_wx,
      *lru_bx, *lru_lam, *g_q, *w_uq, *g_kv, *w_ukv, *w_oa, *w_ob, *w_oc, *w_out, *w_ff1, *w_ff3, *w_ff2, *g_final;
  float* out;
  char* ws;
};

DI unsigned pk2(float a, float b) { f2_t v = {a, b}; bf2_t r = __builtin_convertvector(v, bf2_t); return __builtin_bit_cast(unsigned, r); }
DI bf16_t f2bf(float a) { return (bf16_t)(pk2(a, 0.f) & 0xffffu); }
DI float bf2f(unsigned b) { return __uint_as_float(b << 16); }
DI float bflo(unsigned u) { return __uint_as_float(u << 16); }
DI float bfhi(unsigned u) { return __uint_as_float(u & 0xffff0000u); }
DI bf16x8 pack8(float a0, float a1, float a2, float a3, float a4, float a5, float a6, float a7) {
  uint4 u; u.x = pk2(a0, a1); u.y = pk2(a2, a3); u.z = pk2(a4, a5); u.w = pk2(a6, a7);
  return __builtin_bit_cast(bf16x8, u);
}
DI float sigmoidf_(float x) { return __builtin_amdgcn_rcpf(1.f + __builtin_amdgcn_exp2f(-1.4426950408889634f * x)); }
DI float siluf_(float x) { return x * sigmoidf_(x); }
DI float geluf_(float x) { return x * sigmoidf_(1.5957691216057308f * (x + 0.044715f * x * x * x)); }
DI float log1p_pos(float e) { return e < 0.05f ? e * (1.f + e * (-0.5f + e * (0.33333334f + e * (-0.25f + e * 0.2f)))) : __logf(1.f + e); }
DI float expm1_neg(float x) { return x > -0.1f ? x * (1.f + x * (0.5f + x * (0.16666667f + x * (0.041666668f + x * 0.008333334f)))) : __expf(x) - 1.f; }
DI float fexp2(float x) { return __builtin_amdgcn_exp2f(x); }
DI float wave_sum(float v) {
#pragma unroll
  for (int o = 32; o >= 1; o >>= 1) v += __shfl_xor(v, o);
  return v;
}
DI int get_tid() { int t = threadIdx.x; asm volatile("" : "+v"(t)); return t; }
#define MEMBAR() asm volatile("" ::: "memory")
DI int crow(int i, int h) { return (i & 3) + 8 * (i >> 2) + 4 * h; }
DI f32x16 zero16() { f32x16 z; for (int i = 0; i < 16; ++i) z[i] = 0.f; return z; }

DI bf16_t* wl(const Params& p, int layer) { return (bf16_t*)(p.ws + OFF_W) + (size_t)layer * W_LAYER; }
DI float* modp(const Params& p, int layer, int g, int chunk) { return (float*)(p.ws + OFF_MOD) + ((size_t)(layer * 9 + g) * 6 + chunk) * 1024; }
DI const float* xrow_in(const Params& p, int t) { int b = t / S, s = t - b * S; return s < LC ? p.ctx + ((size_t)b * LC + s) * D : p.x + ((size_t)b * SEQ + (s - LC)) * D; }
DI float* xrow_ws(const Params& p, int t) { int b = t / S, s = t - b * S; return s < LC ? (float*)(p.ws + OFF_XC) + ((size_t)b * LC + s) * D : p.out + ((size_t)b * SEQ + (s - LC)) * D; }


#define LAS3 __attribute__((address_space(3)))
#define XB_TMO      128
#define XB_XCNT(j)  (256  + 64 * (j))
#define XB_XSUB(j)  (1280 + 64 * (j))
#define XB_XGEN(j)  (2304 + 64 * (j))
#define XB_TOP      3328
#define XB_TOPGEN   3392
#define XB_SPIN_CAP (1u << 22)
DI unsigned xb_ld(unsigned* p) { return __hip_atomic_load(p, __ATOMIC_RELAXED, __HIP_MEMORY_SCOPE_AGENT); }
DI unsigned xb_add(unsigned* p, unsigned v) { return __hip_atomic_fetch_add(p, v, __ATOMIC_RELAXED, __HIP_MEMORY_SCOPE_AGENT); }
DI unsigned xb_xcc_id() { return (unsigned)__builtin_amdgcn_s_getreg((3 << 11) | 20) & 0xFu; }
#define XB_SPIN(cond, bar) do { unsigned _sp = 0; while (cond) { __builtin_amdgcn_s_sleep(1); \
    if ((++_sp & 255u) == 0u) { if (xb_ld(&(bar)[XB_TMO])) break; if (_sp > XB_SPIN_CAP) { atomicAdd(&(bar)[XB_TMO], 1u); break; } } } } while (0)
struct XcdBarrier { unsigned* bar; unsigned x; volatile LAS3 unsigned* st; };
DI XcdBarrier xcd_barrier_post(unsigned* bar, volatile LAS3 unsigned* st) {
  XcdBarrier b; b.bar = bar; b.x = xb_xcc_id(); b.st = st;
  if (threadIdx.x == 0) (void)xb_add(&bar[XB_XCNT(b.x)], 1u);
  return b;
}
DI void xcd_barrier_complete(unsigned* bar, unsigned x, unsigned& nloc, unsigned& nx) {
  const unsigned G = gridDim.x * gridDim.y * gridDim.z;
  unsigned sum, cnt, mine, sp = 0u;
  for (;;) {
    sum = 0u; cnt = 0u; mine = 0u;
#pragma unroll
    for (unsigned j = 0; j < 16; ++j) { const unsigned c = xb_ld(&bar[XB_XCNT(j)]); sum += c; cnt += (c > 0u) ? 1u : 0u; mine = (j == x) ? c : mine; }
    if (sum == G) break;
    __builtin_amdgcn_s_sleep(1);
    if ((++sp & 255u) == 0u) { if (xb_ld(&bar[XB_TMO])) break; if (sp > XB_SPIN_CAP) { atomicAdd(&bar[XB_TMO], 1u); break; } }
  }
  nloc = mine > 0u ? mine : 1u; nx = cnt > 0u ? cnt : 1u;
}
DI void xcd_barrier(const XcdBarrier& b) {
  asm volatile("s_waitcnt vmcnt(0)" ::: "memory");
  __syncthreads();
  if (threadIdx.x == 0) {
    unsigned* bar = b.bar;
    __builtin_amdgcn_s_waitcnt(0);
    unsigned nloc = b.st[0], nx = b.st[1];
    if (nloc == 0u) { xcd_barrier_complete(bar, b.x, nloc, nx); b.st[0] = nloc; b.st[1] = nx; }
    const unsigned old = xb_add(&bar[XB_XSUB(b.x)], 1u);
    const unsigned gen = old / nloc;
    if (old + 1u == (gen + 1u) * nloc) {
      __builtin_amdgcn_fence(__ATOMIC_RELEASE, "agent");
      asm volatile("s_waitcnt vmcnt(0)" ::: "memory");
      const unsigned og = xb_add(&bar[XB_TOP], 1u);
      const unsigned tg = og / nx;
      if (og + 1u == (tg + 1u) * nx) xb_add(&bar[XB_TOPGEN], 1u);
      else XB_SPIN(xb_ld(&bar[XB_TOPGEN]) == tg, bar);
      __builtin_amdgcn_fence(__ATOMIC_ACQUIRE, "agent");
      xb_add(&bar[XB_XGEN(b.x)], 1u);
      asm volatile("s_waitcnt vmcnt(0)" ::: "memory");
    } else {
      XB_SPIN(xb_ld(&bar[XB_XGEN(b.x)]) == gen, bar);
      __builtin_amdgcn_fence(__ATOMIC_ACQUIRE, "agent");
      asm volatile("s_waitcnt vmcnt(0)" ::: "memory");
    }
  }
  __syncthreads();
}
#define LAS __attribute__((address_space(3)))
using f32x4 = __attribute__((ext_vector_type(4))) float;
using u32x4 = __attribute__((ext_vector_type(4))) unsigned;
constexpr int BM = 256, BK = 64, HALF = 128, HTB = HALF * BK * 2, NXCD = 8, WGM = 8;
DI int lds_byte(int r, int c) { const int st = (r >> 4) * 2 + (c >> 5), rr = r & 15, cc = c & 31, ob = rr * 64 + cc * 2; return st * 1024 + (ob ^ (((ob >> 9) & 1) << 5)); }
DI void stage_rc(int b, int& R, int& C) { const int st = b / 1024, sb = b % 1024, swz = sb ^ (((sb >> 9) & 1) << 5); R = (st >> 1) * 16 + swz / 64; C = (st & 1) * 32 + (swz % 64) / 2; }
DI int perm32(int rho) { const int n = rho >> 4, i = rho & 15; return 8 * (i >> 2) + 4 * n + (i & 3); }
struct Unit { int pm, pn; };
struct Order {
  int nM, nN, nwg, G, c, skip;
  DI void init(int nM_, int nN_, int skip_, int c_ = -1) { nM = nM_; nN = nN_; nwg = nM * nN; G = gridDim.x; c = c_ < 0 ? (int)blockIdx.x : c_; skip = skip_; }
  DI bool next(int i, Unit& u) const {
    const long L = (long)i * G + c; if (L >= nwg) return false;
    int wgid = (int)L; { const int q = nwg / NXCD, r = nwg % NXCD, xcd = wgid % NXCD, off = wgid / NXCD; wgid = (xcd < r ? xcd * (q + 1) : r * (q + 1) + (xcd - r) * q) + off; }
    const int nig = WGM * nN, gid = wgid / nig, fm = gid * WGM, gsz = (nM - fm) < WGM ? (nM - fm) : WGM;
    int pm = fm + ((wgid % nig) % gsz); u.pn = (wgid % nig) / gsz;
    if (skip) pm = pm + pm / 16 + 1;
    u.pm = pm; return true;
  }
};
typedef f32x4 acc_t[2][2][4][2];

template <class Epi>
DI void gemm_phase(char* smem, const bf16_t* A, int lda, const bf16_t* Bt, int ldb, int K, const Order& S_, const Epi& E) {
  LAS unsigned char* lds = (LAS unsigned char*)smem;
  const int tid = get_tid(), wid = __builtin_amdgcn_readfirstlane(tid >> 6), lane = tid & 63, wr = wid >> 2, wc = wid & 3, fr = lane & 15, fq = lane >> 4;
  const int nt = K / BK;
  unsigned voffA[2], voffB[2];
#pragma unroll
  for (int i = 0; i < 2; ++i) { int R, C; stage_rc(tid * 16 + i * 8192, R, C); const int Rb = Epi::PERM ? ((R & ~31) + perm32(R & 31)) : R;
    voffA[i] = (unsigned)(R * lda + C) * 2u; voffB[i] = (unsigned)(Rb * ldb + C) * 2u; }
  const size_t kstep = (size_t)(BK * 2);
  const size_t hstepA = (size_t)HALF * lda * 2, hstepB = (size_t)HALF * ldb * 2;
  const size_t tstepA = 2 * hstepA, tstepB = 2 * hstepB;
  const unsigned ldsw = (unsigned)wid * 1024u;
  const int aoff = lds_byte(wr * 64 + fr, fq * 8), boff = lds_byte(wc * 32 + fr, fq * 8);
#define PG8_SA(b, h) (((b) * 2 + (h)) * HTB)
#define PG8_SB(b, h) ((4 + (b) * 2 + (h)) * HTB)
#define PG8_STAGE(bufoff, gbase, voff) do { _Pragma("unroll") for (int _i = 0; _i < 2; ++_i) \
    __builtin_amdgcn_global_load_lds((const unsigned*)((const char*)(gbase) + (voff)[_i]), (LAS unsigned*)(lds + (bufoff) + ldsw + _i * 8192), 16, 0, 0); } while (0)
#define PG8_LDA(dst, b, h) do { _Pragma("unroll") for (int m = 0; m < 4; ++m) _Pragma("unroll") for (int k = 0; k < 2; ++k) dst[m][k] = *(const LAS bf16x8*)(lds + PG8_SA(b, h) + aoff + m * 2048 + k * 1024); } while (0)
#define PG8_LDB(dst, b, h) do { _Pragma("unroll") for (int n = 0; n < 2; ++n) _Pragma("unroll") for (int k = 0; k < 2; ++k) dst[n][k] = *(const LAS bf16x8*)(lds + PG8_SB(b, h) + boff + n * 2048 + k * 1024); } while (0)
#define PG8_MMA(ai, bj, At, Bt_) do { __builtin_amdgcn_s_setprio(1); _Pragma("unroll") for (int m = 0; m < 4; ++m) _Pragma("unroll") for (int n = 0; n < 2; ++n) _Pragma("unroll") for (int k = 0; k < 2; ++k) \
    acc[ai][bj][m][n] = __builtin_amdgcn_mfma_f32_16x16x32_bf16(Bt_[n][k], At[m][k], acc[ai][bj][m][n], 0, 0, 0); __builtin_amdgcn_s_setprio(0); } while (0)
#define PG8_WAIT_V(n) asm volatile("s_waitcnt vmcnt(" #n ")" ::: "memory")
#define PG8_WAIT_L(n) asm volatile("s_waitcnt lgkmcnt(" #n ")" ::: "memory")
#define PG8_BAR __builtin_amdgcn_s_barrier()
#define PG8_SCHED __builtin_amdgcn_sched_barrier(0)
  Unit cur, nxt; int ui = 0;
  if (!S_.next(0, cur)) return;
  f32x4 acc[2][2][4][2];
#pragma unroll
  for (int a = 0; a < 2; ++a)
#pragma unroll
    for (int b = 0; b < 2; ++b)
#pragma unroll
      for (int m = 0; m < 4; ++m)
#pragma unroll
        for (int n = 0; n < 2; ++n) acc[a][b][m][n] = (f32x4){0.f, 0.f, 0.f, 0.f};
  bf16x8 At[4][2], B0[2][2], B1[2][2];
  const char* cA = (const char*)A + (size_t)cur.pm * tstepA; const char* cB = (const char*)Bt + (size_t)cur.pn * tstepB;
  PG8_STAGE(PG8_SB(0, 0), cB, voffB); PG8_STAGE(PG8_SA(0, 0), cA, voffA); PG8_STAGE(PG8_SB(0, 1), cB + hstepB, voffB); PG8_STAGE(PG8_SA(0, 1), cA + hstepA, voffA);
  if (wr == 1) PG8_BAR;
  PG8_WAIT_V(4); PG8_BAR;
  PG8_STAGE(PG8_SB(1, 0), cB + kstep, voffB); PG8_STAGE(PG8_SA(1, 0), cA + kstep, voffA); PG8_STAGE(PG8_SB(1, 1), cB + hstepB + kstep, voffB);
  PG8_WAIT_V(6); PG8_BAR;
  for (;;) {
    const bool has_next = S_.next(ui + 1, nxt);
    const char* nA = has_next ? (const char*)A + (size_t)nxt.pm * tstepA : cA; const char* nB = has_next ? (const char*)Bt + (size_t)nxt.pn * tstepB : cB;
    for (int t = 0; t < nt; t += 2) {
      const bool last = (t == nt - 2);
      const char* a1 = cA + (size_t)(t + 1) * kstep;
      const char* a2 = last ? nA : cA + (size_t)(t + 2) * kstep; const char* b2 = last ? nB : cB + (size_t)(t + 2) * kstep;
      const char* a3 = a2 + kstep; const char* b3 = b2 + kstep;
      PG8_LDB(B0, 0, 0); PG8_SCHED; PG8_LDA(At, 0, 0); PG8_STAGE(PG8_SA(1, 1), a1 + hstepA, voffA);
      PG8_WAIT_L(8); PG8_BAR; PG8_WAIT_L(0); PG8_MMA(0, 0, At, B0); PG8_BAR; PG8_SCHED;
      PG8_LDB(B1, 0, 1); PG8_STAGE(PG8_SB(0, 0), b2, voffB);
      PG8_BAR; PG8_WAIT_L(0); PG8_MMA(0, 1, At, B1); PG8_BAR;
      PG8_LDA(At, 0, 1); PG8_STAGE(PG8_SA(0, 0), a2, voffA);
      PG8_BAR; PG8_WAIT_L(0); PG8_MMA(1, 0, At, B0); PG8_BAR; PG8_SCHED;
      PG8_STAGE(PG8_SB(0, 1), b2 + hstepB, voffB);
      PG8_WAIT_V(6); PG8_BAR; PG8_MMA(1, 1, At, B1); PG8_BAR;
      PG8_LDB(B0, 1, 0); PG8_SCHED; PG8_LDA(At, 1, 0); PG8_STAGE(PG8_SA(0, 1), a2 + hstepA, voffA);
      PG8_WAIT_L(8); PG8_BAR; PG8_WAIT_L(0); PG8_MMA(0, 0, At, B0); PG8_BAR; PG8_SCHED;
      PG8_LDB(B1, 1, 1); PG8_STAGE(PG8_SB(1, 0), b3, voffB);
      PG8_BAR; PG8_WAIT_L(0); PG8_MMA(0, 1, At, B1); PG8_BAR;
      PG8_LDA(At, 1, 1); PG8_STAGE(PG8_SA(1, 0), a3, voffA);
      PG8_BAR; PG8_WAIT_L(0); PG8_MMA(1, 0, At, B0); PG8_BAR; PG8_SCHED;
      PG8_STAGE(PG8_SB(1, 1), b3 + hstepB, voffB);
      PG8_WAIT_V(6); PG8_BAR; PG8_MMA(1, 1, At, B1); PG8_BAR;
    }
    E(acc, cur, wr, wc, fr, fq);
    if (!has_next) break;
#pragma unroll
    for (int a = 0; a < 2; ++a)
#pragma unroll
      for (int b = 0; b < 2; ++b)
#pragma unroll
        for (int m = 0; m < 4; ++m)
#pragma unroll
          for (int n = 0; n < 2; ++n) acc[a][b][m][n] = (f32x4){0.f, 0.f, 0.f, 0.f};
    cur = nxt; cA = nA; cB = nB; ++ui;
  }
  PG8_WAIT_V(0);
  if (wr == 0) PG8_BAR;
  PG8_BAR;
#undef PG8_SA
#undef PG8_SB
#undef PG8_STAGE
#undef PG8_LDA
#undef PG8_LDB
#undef PG8_MMA
#undef PG8_WAIT_V
#undef PG8_WAIT_L
#undef PG8_BAR
#undef PG8_SCHED
}
DI u32x4 pack8v(const f32x4& a, const f32x4& b) { u32x4 w; w.x = pk2(a[0], a[1]); w.y = pk2(a[2], a[3]); w.z = pk2(b[0], b[1]); w.w = pk2(b[2], b[3]); return w; }

struct EpiStoreBf16 {
  static constexpr bool PERM = true;
  bf16_t* O; int ldc;
  DI void operator()(const acc_t& acc, const Unit& u, int wr, int wc, int fr, int fq) const {
    const int row0 = u.pm * BM + wr * 64 + fr, col0 = u.pn * BM + wc * 32 + 8 * fq;
#pragma unroll
    for (int ai = 0; ai < 2; ++ai)
#pragma unroll
      for (int m = 0; m < 4; ++m) { bf16_t* rowp = O + (size_t)(row0 + ai * HALF + m * 16) * ldc + col0;
#pragma unroll
        for (int bj = 0; bj < 2; ++bj) *(u32x4*)(rowp + bj * HALF) = pack8v(acc[ai][bj][m][0], acc[ai][bj][m][1]); }
  }
};
struct EpiTokT {
  static constexpr bool PERM = true;
  bf16_t* O; int rows_per_b;
  DI void operator()(const acc_t& acc, const Unit& u, int wr, int wc, int fr, int fq) const {
    const int row0 = u.pm * BM + wr * 64 + fr;
    const int t0 = u.pn * BM, b = t0 / S, s0 = t0 - b * S + wc * 32 + 8 * fq;
#pragma unroll
    for (int ai = 0; ai < 2; ++ai)
#pragma unroll
      for (int m = 0; m < 4; ++m) { bf16_t* rowp = O + ((size_t)b * rows_per_b + row0 + ai * HALF + m * 16) * S + s0;
#pragma unroll
        for (int bj = 0; bj < 2; ++bj) *(u32x4*)(rowp + bj * HALF) = pack8v(acc[ai][bj][m][0], acc[ai][bj][m][1]); }
  }
};
constexpr float QSCALE = 0.10206207261596577f * 1.4426950408889634f;
struct EpiK {
  static constexpr bool PERM = true;
  bf16_t* Kb;
  DI void operator()(const acc_t& acc, const Unit& u, int wr, int wc, int fr, int fq) const {
    const int row0 = u.pm * BM + wr * 64 + fr;
#pragma unroll
    for (int ai = 0; ai < 2; ++ai)
#pragma unroll
      for (int m = 0; m < 4; ++m) { const int tl = row0 + ai * HALF + m * 16, bl = tl / S, s = tl - bl * S;
#pragma unroll
        for (int bj = 0; bj < 2; ++bj) { const int c = u.pn * BM + bj * HALF + wc * 32 + 8 * fq, head = c >> 6, j = c & 63;
          *(u32x4*)(Kb + ((size_t)(bl * 8 + head) * S + s) * 96 + j) = pack8v(acc[ai][bj][m][0], acc[ai][bj][m][1]); } }
  }
};
struct EpiMergeG {
  static constexpr bool PERM = true;
  const bf16_t* P; bf16_t* M; int first;
  DI void operator()(const acc_t& acc, const Unit& u, int wr, int wc, int fr, int fq) const {
    const int row0 = u.pm * BM + wr * 64 + fr, col0 = u.pn * BM + wc * 32 + 8 * fq;
#pragma unroll
    for (int ai = 0; ai < 2; ++ai)
#pragma unroll
      for (int m = 0; m < 4; ++m) { const int row = row0 + ai * HALF + m * 16;
#pragma unroll
        for (int bj = 0; bj < 2; ++bj) {
          const u32x4 pv = *(const u32x4*)(P + (size_t)row * 1024 + col0 + bj * HALF);
          bf16_t* mp = M + (size_t)row * ZS + col0 + bj * HALF;
          f32x4 r0, r1;
          const f32x4& g0 = acc[ai][bj][m][0]; const f32x4& g1 = acc[ai][bj][m][1];
          r0[0] = sigmoidf_(g0[0]) * bflo(pv.x); r0[1] = sigmoidf_(g0[1]) * bfhi(pv.x); r0[2] = sigmoidf_(g0[2]) * bflo(pv.y); r0[3] = sigmoidf_(g0[3]) * bfhi(pv.y);
          r1[0] = sigmoidf_(g1[0]) * bflo(pv.z); r1[1] = sigmoidf_(g1[1]) * bfhi(pv.z); r1[2] = sigmoidf_(g1[2]) * bflo(pv.w); r1[3] = sigmoidf_(g1[3]) * bfhi(pv.w);
          if (!first) { const u32x4 mv = *(const u32x4*)mp;
            r0[0] += bflo(mv.x); r0[1] += bfhi(mv.x); r0[2] += bflo(mv.y); r0[3] += bfhi(mv.y); r1[0] += bflo(mv.z); r1[1] += bfhi(mv.z); r1[2] += bflo(mv.w); r1[3] += bfhi(mv.w); }
          *(u32x4*)mp = pack8v(r0, r1); } }
  }
};

struct Desc { const char* A; const char* B; int lda, ldb, nt, pm, pn, kind; };
template <class Sched, class Epi>
DI void gemm_stream(char* smem, const Sched& S_, const Epi& E) {
  LAS unsigned char* lds = (LAS unsigned char*)smem;
  const int tid = get_tid(), wid = __builtin_amdgcn_readfirstlane(tid >> 6), lane = tid & 63, wr = wid >> 2, wc = wid & 3, fr = lane & 15, fq = lane >> 4;
  int R0, C0, R1, C1;
  stage_rc(tid * 16, R0, C0); stage_rc(tid * 16 + 8192, R1, C1);
  const int Rb0 = Epi::PERM ? ((R0 & ~31) + perm32(R0 & 31)) : R0, Rb1 = Epi::PERM ? ((R1 & ~31) + perm32(R1 & 31)) : R1;
  C0 *= 2; C1 *= 2;
  const size_t kstep = (size_t)(BK * 2);
  const unsigned ldsw = (unsigned)wid * 1024u;
  const int aoff = lds_byte(wr * 64 + fr, fq * 8), boff = lds_byte(wc * 32 + fr, fq * 8);
#define PG8_SA(b, h) (((b) * 2 + (h)) * HTB)
#define PG8_SB(b, h) ((4 + (b) * 2 + (h)) * HTB)
#define PG8_STAGE3(bufoff, gbase, ld2, RA, RB) do { \
    __builtin_amdgcn_global_load_lds((const unsigned*)((const char*)(gbase) + (unsigned)((RA) * (ld2) + C0)), (LAS unsigned*)(lds + (bufoff) + ldsw), 16, 0, 0); \
    __builtin_amdgcn_global_load_lds((const unsigned*)((const char*)(gbase) + (unsigned)((RB) * (ld2) + C1)), (LAS unsigned*)(lds + (bufoff) + ldsw + 8192), 16, 0, 0); } while (0)
#define PG8_STA(bufoff, gbase, ld2) PG8_STAGE3(bufoff, gbase, ld2, R0, R1)
#define PG8_STB(bufoff, gbase, ld2) PG8_STAGE3(bufoff, gbase, ld2, Rb0, Rb1)
#define PG8_LDA(dst, b, h) do { _Pragma("unroll") for (int m = 0; m < 4; ++m) _Pragma("unroll") for (int k = 0; k < 2; ++k) dst[m][k] = *(const LAS bf16x8*)(lds + PG8_SA(b, h) + aoff + m * 2048 + k * 1024); } while (0)
#define PG8_LDB(dst, b, h) do { _Pragma("unroll") for (int n = 0; n < 2; ++n) _Pragma("unroll") for (int k = 0; k < 2; ++k) dst[n][k] = *(const LAS bf16x8*)(lds + PG8_SB(b, h) + boff + n * 2048 + k * 1024); } while (0)
#define PG8_MMA(ai, bj, At, Bt_) do { __builtin_amdgcn_s_setprio(1); _Pragma("unroll") for (int m = 0; m < 4; ++m) _Pragma("unroll") for (int n = 0; n < 2; ++n) _Pragma("unroll") for (int k = 0; k < 2; ++k) \
    acc[ai][bj][m][n] = __builtin_amdgcn_mfma_f32_16x16x32_bf16(Bt_[n][k], At[m][k], acc[ai][bj][m][n], 0, 0, 0); __builtin_amdgcn_s_setprio(0); } while (0)
#define PG8_WAIT_V(n) asm volatile("s_waitcnt vmcnt(" #n ")" ::: "memory")
#define PG8_WAIT_L(n) asm volatile("s_waitcnt lgkmcnt(" #n ")" ::: "memory")
#define PG8_BAR __builtin_amdgcn_s_barrier()
#define PG8_SCHED __builtin_amdgcn_sched_barrier(0)
  Desc cur, nxt; int ui = 0;
  if (!S_.next(0, cur)) return;
  f32x4 acc[2][2][4][2];
#pragma unroll
  for (int a = 0; a < 2; ++a)
#pragma unroll
    for (int b = 0; b < 2; ++b)
#pragma unroll
      for (int m = 0; m < 4; ++m)
#pragma unroll
        for (int n = 0; n < 2; ++n) acc[a][b][m][n] = (f32x4){0.f, 0.f, 0.f, 0.f};
  bf16x8 At[4][2], B0[2][2], B1[2][2];
  const char* cA = cur.A; const char* cB = cur.B;
  {
    const int la2 = cur.lda * 2, lb2 = cur.ldb * 2; const size_t hA = (size_t)HALF * la2, hB = (size_t)HALF * lb2;
    PG8_STB(PG8_SB(0, 0), cB, lb2); PG8_STA(PG8_SA(0, 0), cA, la2); PG8_STB(PG8_SB(0, 1), cB + hB, lb2); PG8_STA(PG8_SA(0, 1), cA + hA, la2);
    if (wr == 1) PG8_BAR;
    PG8_WAIT_V(4); PG8_BAR;
    PG8_STB(PG8_SB(1, 0), cB + kstep, lb2); PG8_STA(PG8_SA(1, 0), cA + kstep, la2); PG8_STB(PG8_SB(1, 1), cB + hB + kstep, lb2);
    PG8_WAIT_V(6); PG8_BAR;
  }
  for (;;) {
    const bool has_next = S_.next(ui + 1, nxt);
    if (!has_next) nxt = cur;
    const char* nA = nxt.A; const char* nB = nxt.B;
    const int nt = cur.nt;
    const int la2 = cur.lda * 2; const size_t hA = (size_t)HALF * la2;
    for (int t = 0; t < nt; t += 2) {
      const bool last = (t == nt - 2);
      const char* a1 = cA + (size_t)(t + 1) * kstep;
      const char* a2 = last ? nA : cA + (size_t)(t + 2) * kstep; const char* b2 = last ? nB : cB + (size_t)(t + 2) * kstep;
      const char* a3 = a2 + kstep; const char* b3 = b2 + kstep;
      const int xa2 = (last ? nxt.lda : cur.lda) * 2, xb2 = (last ? nxt.ldb : cur.ldb) * 2;
      const size_t xhA = (size_t)HALF * xa2, xhB = (size_t)HALF * xb2;
      PG8_LDB(B0, 0, 0); PG8_SCHED; PG8_LDA(At, 0, 0); PG8_STA(PG8_SA(1, 1), a1 + hA, la2);
      PG8_WAIT_L(8); PG8_BAR; PG8_WAIT_L(0); PG8_MMA(0, 0, At, B0); PG8_BAR; PG8_SCHED;
      PG8_LDB(B1, 0, 1); PG8_STB(PG8_SB(0, 0), b2, xb2);
      PG8_BAR; PG8_WAIT_L(0); PG8_MMA(0, 1, At, B1); PG8_BAR;
      PG8_LDA(At, 0, 1); PG8_STA(PG8_SA(0, 0), a2, xa2);
      PG8_BAR; PG8_WAIT_L(0); PG8_MMA(1, 0, At, B0); PG8_BAR; PG8_SCHED;
      PG8_STB(PG8_SB(0, 1), b2 + xhB, xb2);
      PG8_WAIT_V(6); PG8_BAR; PG8_MMA(1, 1, At, B1); PG8_BAR;
      PG8_LDB(B0, 1, 0); PG8_SCHED; PG8_LDA(At, 1, 0); PG8_STA(PG8_SA(0, 1), a2 + xhA, xa2);
      PG8_WAIT_L(8); PG8_BAR; PG8_WAIT_L(0); PG8_MMA(0, 0, At, B0); PG8_BAR; PG8_SCHED;
      PG8_LDB(B1, 1, 1); PG8_STB(PG8_SB(1, 0), b3, xb2);
      PG8_BAR; PG8_WAIT_L(0); PG8_MMA(0, 1, At, B1); PG8_BAR;
      PG8_LDA(At, 1, 1); PG8_STA(PG8_SA(1, 0), a3, xa2);
      PG8_BAR; PG8_WAIT_L(0); PG8_MMA(1, 0, At, B0); PG8_BAR; PG8_SCHED;
      PG8_STB(PG8_SB(1, 1), b3 + xhB, xb2);
      PG8_WAIT_V(6); PG8_BAR; PG8_MMA(1, 1, At, B1); PG8_BAR;
    }
    E(acc, cur, wr, wc, fr, fq);
    if (!has_next) break;
#pragma unroll
    for (int a = 0; a < 2; ++a)
#pragma unroll
      for (int b = 0; b < 2; ++b)
#pragma unroll
        for (int m = 0; m < 4; ++m)
#pragma unroll
          for (int n = 0; n < 2; ++n) acc[a][b][m][n] = (f32x4){0.f, 0.f, 0.f, 0.f};
    cur = nxt; cA = nA; cB = nB; ++ui;
  }
  PG8_WAIT_V(0);
  if (wr == 0) PG8_BAR;
  PG8_BAR;
#undef PG8_SA
#undef PG8_SB
#undef PG8_STAGE3
#undef PG8_STA
#undef PG8_STB
#undef PG8_LDA
#undef PG8_LDB
#undef PG8_MMA
#undef PG8_WAIT_V
#undef PG8_WAIT_L
#undef PG8_BAR
#undef PG8_SCHED
}

struct MergeSched {
  const bf16_t* H; const bf16_t* Z; const bf16_t* W; int nM, skip, G, c;
  DI bool next(int i, Desc& d) const {
    const int tseq = i / 6, step = i - tseq * 6, x = step >> 1, isg = step & 1;
    const long L = (long)tseq * G + c; const int nwg = nM * 4; if (L >= nwg) return false;
    int wgid = (int)L; { const int q = nwg / NXCD, r = nwg % NXCD, xcd = wgid % NXCD, off = wgid / NXCD; wgid = (xcd < r ? xcd * (q + 1) : r * (q + 1) + (xcd - r) * q) + off; }
    const int nig = WGM * 4, gid = wgid / nig, fm = gid * WGM, gsz = (nM - fm) < WGM ? (nM - fm) : WGM;
    int pm = fm + ((wgid % nig) % gsz); const int pn = (wgid % nig) / gsz;
    if (skip) pm = pm + pm / 16 + 1;
    d.pm = pm; d.pn = pn; d.kind = step;
    if (isg) { d.A = (const char*)(H + (size_t)pm * 256 * 1024); d.lda = 1024; d.B = (const char*)(W + W_G + (size_t)(x * 1024 + pn * 256) * 1024); d.ldb = 1024; d.nt = 16; }
    else { const int yc = x == 0 ? Z_YA : (x == 1 ? Z_YB : Z_YC);
      d.A = (const char*)(Z + (size_t)pm * 256 * ZS + yc); d.lda = ZS; d.B = (const char*)(W + W_OA + (size_t)x * 1024 * 512 + (size_t)pn * 256 * 512); d.ldb = 512; d.nt = 8; }
    return true;
  }
};
struct EpiMergeS {
  static constexpr bool PERM = true;
  u32x4* slab; bf16_t* M;
  DI void operator()(const acc_t& acc, const Desc& u, int wr, int wc, int fr, int fq) const {
    u32x4* sp = slab + get_tid(); asm volatile("" : "+v"(sp));
    if (!(u.kind & 1)) {
#pragma unroll
      for (int ai = 0; ai < 2; ++ai)
#pragma unroll
        for (int m = 0; m < 4; ++m)
#pragma unroll
          for (int bj = 0; bj < 2; ++bj) sp[((ai * 4 + m) * 2 + bj) * 512] = pack8v(acc[ai][bj][m][0], acc[ai][bj][m][1]);
    } else {
      const int first = u.kind == 1;
      const int row0 = u.pm * BM + wr * 64 + fr, col0 = u.pn * BM + wc * 32 + 8 * fq;
#pragma unroll
      for (int ai = 0; ai < 2; ++ai) {
        MEMBAR();
        u32x4 pv[4][2], mv[4][2];
#pragma unroll
        for (int m = 0; m < 4; ++m)
#pragma unroll
          for (int bj = 0; bj < 2; ++bj) {
            pv[m][bj] = sp[((ai * 4 + m) * 2 + bj) * 512];
            if (!first) mv[m][bj] = *(const u32x4*)(M + (size_t)(row0 + ai * HALF + m * 16) * ZS + col0 + bj * HALF);
          }
#pragma unroll
        for (int m = 0; m < 4; ++m)
#pragma unroll
          for (int bj = 0; bj < 2; ++bj) {
            bf16_t* mp = M + (size_t)(row0 + ai * HALF + m * 16) * ZS + col0 + bj * HALF;
            const u32x4 pq = pv[m][bj];
            f32x4 r0, r1;
            const f32x4& g0 = acc[ai][bj][m][0]; const f32x4& g1 = acc[ai][bj][m][1];
            r0[0] = sigmoidf_(g0[0]) * bflo(pq.x); r0[1] = sigmoidf_(g0[1]) * bfhi(pq.x); r0[2] = sigmoidf_(g0[2]) * bflo(pq.y); r0[3] = sigmoidf_(g0[3]) * bfhi(pq.y);
            r1[0] = sigmoidf_(g1[0]) * bflo(pq.z); r1[1] = sigmoidf_(g1[1]) * bfhi(pq.z); r1[2] = sigmoidf_(g1[2]) * bflo(pq.w); r1[3] = sigmoidf_(g1[3]) * bfhi(pq.w);
            if (!first) { const u32x4 mq = mv[m][bj];
              r0[0] += bflo(mq.x); r0[1] += bfhi(mq.x); r0[2] += bflo(mq.y); r0[3] += bfhi(mq.y); r1[0] += bflo(mq.z); r1[1] += bfhi(mq.z); r1[2] += bflo(mq.w); r1[3] += bfhi(mq.w); }
            *(u32x4*)mp = pack8v(r0, r1);
          }
      }
    }
  }
};

struct GemmASched {
  const bf16_t* H; const bf16_t* W; int G, c;
  DI bool next(int i, Desc& d) const {
    const long L = (long)i * G + c; if (L >= 1496 + 272) return false;
    d.lda = 1024; d.ldb = 1024; d.nt = 16;
    if (L < 1496) {
      const int nwg = 1496, nN = 11, nM = 136;
      int wgid = (int)L; { const int q = nwg / NXCD, r = nwg % NXCD, xcd = wgid % NXCD, off = wgid / NXCD; wgid = (xcd < r ? xcd * (q + 1) : r * (q + 1) + (xcd - r) * q) + off; }
      const int nig = WGM * nN, gid = wgid / nig, fm = gid * WGM, gsz = (nM - fm) < WGM ? (nM - fm) : WGM;
      d.pm = fm + ((wgid % nig) % gsz); d.pn = (wgid % nig) / gsz; d.kind = 0;
      d.A = (const char*)(H + (size_t)d.pm * 256 * 1024); d.B = (const char*)(W + W_IN + (size_t)d.pn * 256 * 1024);
    } else {
      const int j = (int)L - 1496; d.pm = j & 1; d.pn = j >> 1; d.kind = 1;
      d.A = (const char*)(W + W_IN + (size_t)(2816 + d.pm * 256) * 1024); d.B = (const char*)(H + (size_t)d.pn * 256 * 1024);
    }
    return true;
  }
};
struct EpiGemmA {
  static constexpr bool PERM = true;
  bf16_t* Z; bf16_t* RVT;
  DI void operator()(const acc_t& acc, const Desc& u, int wr, int wc, int fr, int fq) const {
    const int row0 = u.pm * BM + wr * 64 + fr;
    if (u.kind == 0) {
      const int col0 = u.pn * BM + wc * 32 + 8 * fq;
#pragma unroll
      for (int ai = 0; ai < 2; ++ai)
#pragma unroll
        for (int m = 0; m < 4; ++m) { bf16_t* rowp = Z + (size_t)(row0 + ai * HALF + m * 16) * ZS + col0;
#pragma unroll
          for (int bj = 0; bj < 2; ++bj) *(u32x4*)(rowp + bj * HALF) = pack8v(acc[ai][bj][m][0], acc[ai][bj][m][1]); }
    } else {
      const int t0 = u.pn * BM, b = t0 / S, s0 = t0 - b * S + wc * 32 + 8 * fq;
#pragma unroll
      for (int ai = 0; ai < 2; ++ai)
#pragma unroll
        for (int m = 0; m < 4; ++m) { bf16_t* rowp = RVT + ((size_t)b * 512 + row0 + ai * HALF + m * 16) * S + s0;
#pragma unroll
          for (int bj = 0; bj < 2; ++bj) *(u32x4*)(rowp + bj * HALF) = pack8v(acc[ai][bj][m][0], acc[ai][bj][m][1]); }
    }
  }
};

struct QkvSched {
  const bf16_t* Z; const bf16_t* W; int G, c;
  DI bool next(int i, Desc& d) const {
    const long L = (long)i * G + c; if (L >= 476) return false;
    if (L < 204) { d.pm = (int)L / 3; d.pn = (int)L - d.pm * 3; d.kind = 0; d.lda = ZS; d.ldb = 384; d.nt = 6;
      d.A = (const char*)(Z + (size_t)d.pm * 256 * ZS + Z_QD); d.B = (const char*)(W + W_UQ + (size_t)d.pn * 256 * 384); }
    else if (L < 340) { const int j = (int)L - 204; d.pm = j >> 1; d.pn = j & 1; d.kind = 1; d.lda = ZS; d.ldb = 256; d.nt = 4;
      d.A = (const char*)(Z + (size_t)d.pm * 256 * ZS + Z_KVD); d.B = (const char*)(W + W_UK + (size_t)d.pn * 256 * 256); }
    else { const int j = (int)L - 340; d.pm = j & 1; d.pn = j >> 1; d.kind = 2; d.lda = 256; d.ldb = ZS; d.nt = 4;
      d.A = (const char*)(W + W_UV + (size_t)d.pm * 256 * 256); d.B = (const char*)(Z + (size_t)d.pn * 256 * ZS + Z_KVD); }
    return true;
  }
};
struct EpiQkv {
  static constexpr bool PERM = true;
  bf16_t* Q; bf16_t* Kb; bf16_t* VT;
  DI void operator()(const acc_t& acc, const Desc& u, int wr, int wc, int fr, int fq) const {
    const int row0 = u.pm * BM + wr * 64 + fr;
    if (u.kind == 0) {
      const int col0 = u.pn * BM + wc * 32 + 8 * fq;
#pragma unroll
      for (int ai = 0; ai < 2; ++ai)
#pragma unroll
        for (int m = 0; m < 4; ++m) { bf16_t* rowp = Q + (size_t)(row0 + ai * HALF + m * 16) * 768 + col0;
#pragma unroll
          for (int bj = 0; bj < 2; ++bj) *(u32x4*)(rowp + bj * HALF) = pack8v(acc[ai][bj][m][0], acc[ai][bj][m][1]); }
    } else if (u.kind == 1) {
#pragma unroll
      for (int ai = 0; ai < 2; ++ai)
#pragma unroll
        for (int m = 0; m < 4; ++m) { const int tl = row0 + ai * HALF + m * 16, bl = tl / S, s = tl - bl * S;
#pragma unroll
          for (int bj = 0; bj < 2; ++bj) { const int c = u.pn * BM + bj * HALF + wc * 32 + 8 * fq, head = c >> 6, j = c & 63;
            *(u32x4*)(Kb + ((size_t)(bl * 8 + head) * S + s) * 96 + j) = pack8v(acc[ai][bj][m][0], acc[ai][bj][m][1]); } }
    } else {
      const int t0 = u.pn * BM, b = t0 / S, s0 = t0 - b * S + wc * 32 + 8 * fq;
#pragma unroll
      for (int ai = 0; ai < 2; ++ai)
#pragma unroll
        for (int m = 0; m < 4; ++m) { bf16_t* rowp = VT + ((size_t)b * 512 + row0 + ai * HALF + m * 16) * S + s0;
#pragma unroll
          for (int bj = 0; bj < 2; ++bj) *(u32x4*)(rowp + bj * HALF) = pack8v(acc[ai][bj][m][0], acc[ai][bj][m][1]); }
    }
  }
};
struct EpiResid {
  static constexpr bool PERM = false;
  Params p; int layer, chunk, from_input;
  DI void operator()(const acc_t& acc, const Unit& u, int wr, int wc, int fr, int fq) const {
    const int row0 = u.pm * BM + wr * 64 + fr, col0 = u.pn * BM + wc * 32 + 4 * fq;
    const int b = u.pm / 17, g = (u.pm - b * 17) == 0 ? 8 : b;
    const float* gate = modp(p, layer, g, chunk);
    f32x4 gv[2][2];
#pragma unroll
    for (int bj = 0; bj < 2; ++bj)
#pragma unroll
      for (int n = 0; n < 2; ++n) gv[bj][n] = *(const f32x4*)(gate + col0 + bj * HALF + n * 16);
#pragma unroll
    for (int q = 0; q < 4; ++q) {
      const int ai = q >> 1, mh = q & 1;
      MEMBAR();
      f32x4 xv[2][2][2];
#pragma unroll
      for (int mm = 0; mm < 2; ++mm) { const int t = row0 + ai * HALF + (2 * mh + mm) * 16;
        const float* xi = from_input ? xrow_in(p, t) : xrow_ws(p, t);
#pragma unroll
        for (int bj = 0; bj < 2; ++bj)
#pragma unroll
          for (int n = 0; n < 2; ++n) xv[mm][bj][n] = *(const f32x4*)(xi + col0 + bj * HALF + n * 16); }
      MEMBAR();
#pragma unroll
      for (int mm = 0; mm < 2; ++mm) { const int t = row0 + ai * HALF + (2 * mh + mm) * 16;
        float* xo = xrow_ws(p, t);
#pragma unroll
        for (int bj = 0; bj < 2; ++bj)
#pragma unroll
          for (int n = 0; n < 2; ++n) *(f32x4*)(xo + col0 + bj * HALF + n * 16) = xv[mm][bj][n] + gv[bj][n] * acc[ai][bj][2 * mh + mm][n]; }
    }
  }
};
struct EpiFFN1 {
  static constexpr bool PERM = true;
  bf16_t* G;
  DI void operator()(const acc_t& acc, const Unit& u, int wr, int wc, int fr, int fq) const {
    const int row0 = u.pm * BM + wr * 64 + fr, col0 = u.pn * HALF + wc * 32 + 8 * fq;
#pragma unroll
    for (int ai = 0; ai < 2; ++ai)
#pragma unroll
      for (int m = 0; m < 4; ++m) {
        f32x4 r0, r1;
#pragma unroll
        for (int e = 0; e < 4; ++e) { r0[e] = siluf_(acc[ai][0][m][0][e]) * acc[ai][1][m][0][e]; r1[e] = siluf_(acc[ai][0][m][1][e]) * acc[ai][1][m][1][e]; }
        *(u32x4*)(G + (size_t)(row0 + ai * HALF + m * 16) * DFF + col0) = pack8v(r0, r1); }
  }
};
DI void conv_job(const float* src0, const float* src1, int ld, int K, int N, bf16_t* dst, int kind, const float* kscale, char* smem, int& rot) {
  float* tile = (float*)smem;
  const int ktn = K >> 6, ntn = N >> 6, kq = (ktn + 3) >> 2, nit = kq * ntn;
  const int G = gridDim.x;
  int start = blockIdx.x + rot; if (start >= G) start -= G;
  for (int it = start; it < nit; it += G) {
    const int tid = get_tid(), tx = tid & 15, ty = tid >> 4;
    const int nt = it / kq, kt0 = (it - nt * kq) * 4, nkt = (ktn - kt0) < 4 ? (ktn - kt0) : 4;
    const int n = nt * 64 + tx * 4;
    const float* src = src0; int col = n;
    if (kind == 1) {
      if (n < 512) col = n;
      else if (n < 768) col = 800 + (n - 512);
      else if (n < 1024) col = 1952 + (n - 768);
      else if (n < 1280) col = 512 + (n - 1024);
      else if (n < 1664) col = 1568 + (n - 1280);
      else if (n < 2176) col = 2208 + (n - 1664);
      else if (n < 2688) col = 2720 + (n - 2176);
      else if (n < 2720) col = 768 + (n - 2688);
      else if (n < 2816) col = -1;
      else col = 1056 + (n - 2816);
    } else if (kind == 2) { col = 3232 + n;
    } else if (kind == 4) { col = (n >> 6) * 128 + (n & 63);
    } else if (kind == 5) { col = (n >> 6) * 128 + 64 + (n & 63);
    } else if (kind == 6) { const int tl = n >> 8, c = n & 255; col = tl * 128 + (c & 127); src = (c >> 7) ? src1 : src0; }
    float4 v[4][2];
#pragma unroll
    for (int q = 0; q < 4; ++q)
#pragma unroll
      for (int ps = 0; ps < 2; ++ps) {
        v[q][ps] = make_float4(0.f, 0.f, 0.f, 0.f);
        if (q < nkt && col >= 0) { const int k = (kt0 + q) * 64 + ty + 32 * ps; v[q][ps] = *(const float4*)(src + (size_t)k * ld + col); }
      }
    __syncthreads();
#pragma unroll
    for (int q = 0; q < 4; ++q)
#pragma unroll
      for (int ps = 0; ps < 2; ++ps) {
        if (q < nkt) {
          const int kl = ty + 32 * ps; float4 w = v[q][ps];
          if (kscale) { const float sc = kscale[(kt0 + q) * 64 + kl]; w.x *= sc; w.y *= sc; w.z *= sc; w.w *= sc; }
          float* tp = tile + (q * 64 + kl) * 65 + tx * 4;
          tp[0] = w.x; tp[1] = w.y; tp[2] = w.z; tp[3] = w.w;
        }
      }
    __syncthreads();
    {
      const int kc = tid & 7, nl = tid >> 3;
#pragma unroll
      for (int q = 0; q < 4; ++q) {
        if (q < nkt) {
          const float* tp = tile + (q * 64 + kc * 8) * 65 + nl;
          u32x4 o; o.x = pk2(tp[0], tp[65]); o.y = pk2(tp[130], tp[195]); o.z = pk2(tp[260], tp[325]); o.w = pk2(tp[390], tp[455]);
          *(u32x4*)(dst + (size_t)(nt * 64 + nl) * K + (kt0 + q) * 64 + kc * 8) = o;
        }
      }
    }
  }
  rot = (rot + G - (nit % G)) % G;
}

DI void phase_convert(const Params& p, int l, int rot, char* smem) {
  {
    bf16_t* W = wl(p, l);
    conv_job(p.w_in + (size_t)l * D * NIN, nullptr, NIN, 1024, 3328, W + W_IN, 1, nullptr, smem, rot);
    conv_job(p.w_in + (size_t)l * D * NIN, nullptr, NIN, 1024, 3072, W + W_G, 2, nullptr, smem, rot);
    conv_job(p.w_uq + (size_t)l * 384 * 768, nullptr, 768, 384, 768, W + W_UQ, 0, p.g_q + l * 384, smem, rot);
    conv_job(p.w_ukv + (size_t)l * 256 * 1024, nullptr, 1024, 256, 512, W + W_UK, 4, p.g_kv + l * 256, smem, rot);
    conv_job(p.w_ukv + (size_t)l * 256 * 1024, nullptr, 1024, 256, 512, W + W_UV, 5, p.g_kv + l * 256, smem, rot);
    for (int nbk = 0; nbk < 8; ++nbk)
      for (int jj = 0; jj < 4; ++jj) {
        const float* s = ((jj & 1) ? p.lru_wx : p.lru_wa) + ((size_t)((l * 2 + (jj >> 1)) * 8 + nbk)) * 4096;
        conv_job(s, nullptr, 64, 64, 64, W + W_L + (size_t)(nbk * 256 + jj * 64) * 64, 0, nullptr, smem, rot);
      }
    conv_job(p.w_oa + (size_t)l * 512 * 1024, nullptr, 1024, 512, 1024, W + W_OA, 0, nullptr, smem, rot);
    conv_job(p.w_ob + (size_t)l * 512 * 1024, nullptr, 1024, 512, 1024, W + W_OB, 0, nullptr, smem, rot);
    conv_job(p.w_oc + (size_t)l * 512 * 1024, nullptr, 1024, 512, 1024, W + W_OC, 0, nullptr, smem, rot);
    conv_job(p.w_out + (size_t)l * 1024 * 1024, nullptr, 1024, 1024, 1024, W + W_OUT, 0, nullptr, smem, rot);
    conv_job(p.w_ff1 + (size_t)l * 1024 * DFF, p.w_ff3 + (size_t)l * 1024 * DFF, DFF, 1024, 5632, W + W_FF13, 6, nullptr, smem, rot);
    conv_job(p.w_ff2 + (size_t)l * DFF * 1024, nullptr, 1024, DFF, 1024, W + W_FF2, 0, nullptr, smem, rot);
  }
}
DI void phase_setup(const Params& p, char* smem) {
  int rot = 0;
  {
    float* act = (float*)smem;
    float* red = act + 9 * 1024;
    bool have = false;
    int mstart = blockIdx.x + rot; if (mstart >= (int)gridDim.x) mstart -= gridDim.x;
    for (int it = mstart; it < 2 * 96; it += gridDim.x) {
      const int tid = get_tid(), tx = tid & 63, ty = tid >> 6;
      __syncthreads();
      if (!have) {
        for (int i = tid; i < 9 * 1024; i += NT) { int g = i >> 10, k = i & 1023; float v = g < 8 ? p.c[g * 1024 + k] : p.c_ctx[k]; act[i] = siluf_(v); }
        have = true;
        __syncthreads();
      }
      const int l = it / 96, j = (it - l * 96) * 64 + tx;
      float a[9];
#pragma unroll
      for (int g = 0; g < 9; ++g) a[g] = 0.f;
      const float* wm = p.w_mod + (size_t)l * 1024 * 6144 + j;
#pragma unroll 8
      for (int k = ty * 128; k < ty * 128 + 128; ++k) {
        const float wv = wm[(size_t)k * 6144];
#pragma unroll
        for (int g = 0; g < 9; ++g) a[g] += act[g * 1024 + k] * wv;
      }
#pragma unroll
      for (int g = 0; g < 9; ++g) red[(ty * 9 + g) * 64 + tx] = a[g];
      __syncthreads();
      for (int i = tid; i < 9 * 64; i += NT) {
        int g = i >> 6, c = i & 63;
        float v = 0.f;
#pragma unroll
        for (int q = 0; q < 8; ++q) v += red[(q * 9 + g) * 64 + c];
        int jj = (it - l * 96) * 64 + c;
        ((float*)(p.ws + OFF_MOD))[(size_t)(l * 9 + g) * 6144 + jj] = v + p.b_mod[l * 6144 + jj];
      }
    }
  }
  {
    float* axc = (float*)(p.ws + OFF_AXC); float* axs = (float*)(p.ws + OFF_AXS);
    float* rtc = (float*)(p.ws + OFF_RTC); float* rts = (float*)(p.ws + OFF_RTS);
    const int gt = blockIdx.x * NT + get_tid(), gs = gridDim.x * NT;
    for (int i = gt; i < 4096 * 16; i += gs) {
      int n = i >> 4, j = i & 15; int row = n >> 6, col = n & 63;
      float inv = exp2f(-(float)(j & 7) * (13.287712379549449f / 8.f));
      float ang = (float)(j < 8 ? row : col) * inv;
      float sn, cs; sincosf(ang, &sn, &cs);
      axc[i] = cs; axs[i] = sn;
    }
    for (int i = gt; i < S * 32; i += gs) {
      int s = i >> 5, j = i & 31;
      float th = exp2f(-(float)j * (13.287712379549449f / 31.f));
      float ang = (float)s * th;
      float sn, cs; sincosf(ang, &sn, &cs);
      rtc[i] = cs; rts[i] = sn;
    }
  }
}

DI void phase_norm(const Params& p, int layer, int which, bool from_input, bool skipctx) {
  bf16_t* H = (bf16_t*)(p.ws + OFF_H);
  const float* gam = (which ? p.g_ffn : p.g_mix) + layer * 1024;
  const int tid_ = get_tid(); const int lane = tid_ & 63, w = tid_ >> 6;
  float4 gg[4], s4[4], c4[4];
#pragma unroll
  for (int i = 0; i < 4; ++i) { gg[i] = *(const float4*)(gam + (i * 64 + lane) * 4); s4[i] = make_float4(0.f, 0.f, 0.f, 0.f); c4[i] = s4[i]; }
  int gc = -1;
  for (int t0 = (blockIdx.x * 8 + w) * 2; t0 < T; t0 += gridDim.x * 16) {
    const int b = t0 / S, s = t0 - b * S, g = s < LC ? 8 : b;
    if (skipctx && s < LC) continue;
    if (g != gc) {
      const float* sh = modp(p, layer, g, which ? 3 : 0);
      const float* sc = modp(p, layer, g, which ? 4 : 1);
#pragma unroll
      for (int i = 0; i < 4; ++i) { s4[i] = *(const float4*)(sh + (i * 64 + lane) * 4); c4[i] = *(const float4*)(sc + (i * 64 + lane) * 4); }
      gc = g;
    }
    float4 v[2][4]; float ss[2] = {0.f, 0.f};
#pragma unroll
    for (int u = 0; u < 2; ++u) {
      const float* xr = from_input ? xrow_in(p, t0 + u) : xrow_ws(p, t0 + u);
#pragma unroll
      for (int i = 0; i < 4; ++i) { v[u][i] = *(const float4*)(xr + (i * 64 + lane) * 4); }
    }
#pragma unroll
    for (int u = 0; u < 2; ++u) {
#pragma unroll
      for (int i = 0; i < 4; ++i) ss[u] += v[u][i].x * v[u][i].x + v[u][i].y * v[u][i].y + v[u][i].z * v[u][i].z + v[u][i].w * v[u][i].w;
      ss[u] = wave_sum(ss[u]);
    }
#pragma unroll
    for (int i = 0; i < 4; ++i) {
      const int k = (i * 64 + lane) * 4;
#pragma unroll
      for (int u = 0; u < 2; ++u) {
        const float rstd = rsqrtf(ss[u] * (1.f / 1024.f) + EPS);
        float o0 = v[u][i].x * rstd * gg[i].x * (1.f + c4[i].x) + s4[i].x, o1 = v[u][i].y * rstd * gg[i].y * (1.f + c4[i].y) + s4[i].y;
        float o2 = v[u][i].z * rstd * gg[i].z * (1.f + c4[i].z) + s4[i].z, o3 = v[u][i].w * rstd * gg[i].w * (1.f + c4[i].w) + s4[i].w;
        uint2 o; o.x = pk2(o0, o1); o.y = pk2(o2, o3);
        *(uint2*)(H + (size_t)(t0 + u) * 1024 + k) = o;
      }
    }
  }
}
DI void phase_final_norm(const Params& p) {
  const int tid_ = get_tid(); const int lane = tid_ & 63, w = tid_ >> 6;
  float4 gg[4];
#pragma unroll
  for (int i = 0; i < 4; ++i) gg[i] = *(const float4*)(p.g_final + (i * 64 + lane) * 4);
  for (int t = blockIdx.x * 8 + w; t < NB * SEQ; t += gridDim.x * 8) {
    float* xr = p.out + (size_t)t * D;
    float4 v[4]; float ss = 0.f;
#pragma unroll
    for (int i = 0; i < 4; ++i) { v[i] = *(const float4*)(xr + (i * 64 + lane) * 4); ss += v[i].x * v[i].x + v[i].y * v[i].y + v[i].z * v[i].z + v[i].w * v[i].w; }
    ss = wave_sum(ss);
    const float rstd = rsqrtf(ss * (1.f / 1024.f) + EPS);
#pragma unroll
    for (int i = 0; i < 4; ++i) {
      const int k = (i * 64 + lane) * 4;
      float4 o; o.x = v[i].x * rstd * gg[i].x; o.y = v[i].y * rstd * gg[i].y; o.z = v[i].z * rstd * gg[i].z; o.w = v[i].w * rstd * gg[i].w;
      *(float4*)(xr + k) = o;
    }
  }
}
DI void phase_lownorm(const Params& p) {
  bf16_t* Z = (bf16_t*)(p.ws + OFF_Z);
  const int tid_ = get_tid(); const int lane = tid_ & 63, w = tid_ >> 6;
  for (int t0 = (blockIdx.x * 8 + w) * 2; t0 < T; t0 += gridDim.x * 16) {
    uint4 q[2], k[2];
#pragma unroll
    for (int u = 0; u < 2; ++u) {
      bf16_t* zr = Z + (size_t)(t0 + u) * ZS;
      q[u] = make_uint4(0, 0, 0, 0); k[u] = make_uint4(0, 0, 0, 0);
      if (lane < 48) q[u] = *(const uint4*)(zr + Z_QD + lane * 8);
      if (lane < 32) k[u] = *(const uint4*)(zr + Z_KVD + lane * 8);
    }
#pragma unroll
    for (int u = 0; u < 2; ++u) {
      bf16_t* zr = Z + (size_t)(t0 + u) * ZS;
      float sq = 0.f, sk = 0.f, a;
      a = bflo(q[u].x); sq += a * a; a = bfhi(q[u].x); sq += a * a; a = bflo(q[u].y); sq += a * a; a = bfhi(q[u].y); sq += a * a;
      a = bflo(q[u].z); sq += a * a; a = bfhi(q[u].z); sq += a * a; a = bflo(q[u].w); sq += a * a; a = bfhi(q[u].w); sq += a * a;
      a = bflo(k[u].x); sk += a * a; a = bfhi(k[u].x); sk += a * a; a = bflo(k[u].y); sk += a * a; a = bfhi(k[u].y); sk += a * a;
      a = bflo(k[u].z); sk += a * a; a = bfhi(k[u].z); sk += a * a; a = bflo(k[u].w); sk += a * a; a = bfhi(k[u].w); sk += a * a;
      sq = wave_sum(sq); sk = wave_sum(sk);
      const float rq = rsqrtf(sq * (1.f / 384.f) + EPS), rk = rsqrtf(sk * (1.f / 256.f) + EPS);
      if (lane < 48) { uint4 o; o.x = pk2(bflo(q[u].x) * rq, bfhi(q[u].x) * rq); o.y = pk2(bflo(q[u].y) * rq, bfhi(q[u].y) * rq); o.z = pk2(bflo(q[u].z) * rq, bfhi(q[u].z) * rq); o.w = pk2(bflo(q[u].w) * rq, bfhi(q[u].w) * rq); *(uint4*)(zr + Z_QD + lane * 8) = o; }
      if (lane < 32) { uint4 o; o.x = pk2(bflo(k[u].x) * rk, bfhi(k[u].x) * rk); o.y = pk2(bflo(k[u].y) * rk, bfhi(k[u].y) * rk); o.z = pk2(bflo(k[u].z) * rk, bfhi(k[u].z) * rk); o.w = pk2(bflo(k[u].w) * rk, bfhi(k[u].w) * rk); *(uint4*)(zr + Z_KVD + lane * 8) = o; }
    }
  }
}

DI void phase_gemm_a(const Params& p, int layer, char* smem) {
  GemmASched s{(const bf16_t*)(p.ws + OFF_H), wl(p, layer), (int)gridDim.x, (int)blockIdx.x};
  EpiGemmA e{(bf16_t*)(p.ws + OFF_Z), (bf16_t*)(p.ws + OFF_RVT)};
  gemm_stream(smem, s, e);
}
DI int vblock(int rot) { const int G = gridDim.x; int v = (int)blockIdx.x - rot; if (v < 0) v += G; return v; }
DI void phase_qkv(const Params& p, int layer, int hf, char* smem, int& rot) {
  const int G_ = gridDim.x;
  const bf16_t* W = wl(p, layer);
  const bf16_t* Z = (const bf16_t*)(p.ws + OFF_Z) + (size_t)hf * TH * ZS;
  bf16_t* Kb = (bf16_t*)(p.ws + OFF_K);
  const float* axc = (const float*)(p.ws + OFF_AXC); const float* axs = (const float*)(p.ws + OFF_AXS);
  {
    QkvSched s{Z, W, G_, vblock(rot)};
    EpiQkv e{(bf16_t*)(p.ws + OFF_Q), Kb, (bf16_t*)(p.ws + OFF_VT)};
    gemm_stream(smem, s, e);
    rot = (rot + 476) % G_;
  }
  {
    const int gt = blockIdx.x * NT + get_tid(), gs = gridDim.x * NT;
    for (int tl = gt; tl < TH; tl += gs) {
      const int bl = tl / S, s = tl - bl * S;
      const uint4* kr = (const uint4*)(Z + (size_t)tl * ZS + Z_KR);
      const uint4 a0 = kr[0], a1 = kr[1], b0 = kr[2], b1 = kr[3];
      const unsigned xa[8] = {a0.x, a0.y, a0.z, a0.w, a1.x, a1.y, a1.z, a1.w}, xb[8] = {b0.x, b0.y, b0.z, b0.w, b1.x, b1.y, b1.z, b1.w};
      unsigned o1[8], o2[8];
#pragma unroll
      for (int q = 0; q < 8; ++q) {
        float x1l = bflo(xa[q]), x1h = bfhi(xa[q]), x2l = bflo(xb[q]), x2h = bfhi(xb[q]);
        float c0 = 1.f, s0 = 0.f, c1 = 1.f, s1 = 0.f;
        if (s >= LC) { c0 = axc[(s - LC) * 16 + 2 * q]; s0 = axs[(s - LC) * 16 + 2 * q]; c1 = axc[(s - LC) * 16 + 2 * q + 1]; s1 = axs[(s - LC) * 16 + 2 * q + 1]; }
        o1[q] = pk2(x1l * c0 - x2l * s0, x1h * c1 - x2h * s1);
        o2[q] = pk2(x1l * s0 + x2l * c0, x1h * s1 + x2h * c1);
      }
#pragma unroll
      for (int hd = 0; hd < 8; ++hd) {
        uint4* kd = (uint4*)(Kb + ((size_t)(bl * 8 + hd) * S + s) * 96 + 64);
        kd[0] = make_uint4(o1[0], o1[1], o1[2], o1[3]); kd[1] = make_uint4(o1[4], o1[5], o1[6], o1[7]);
        kd[2] = make_uint4(o2[0], o2[1], o2[2], o2[3]); kd[3] = make_uint4(o2[4], o2[5], o2[6], o2[7]);
      }
    }
  }
}
DI void phase_merge(const Params& p, int layer, bool skipctx, char* smem) {
  MergeSched s{(const bf16_t*)(p.ws + OFF_H), (const bf16_t*)(p.ws + OFF_Z), wl(p, layer), skipctx ? 128 : 136, skipctx ? 1 : 0, (int)gridDim.x, (int)blockIdx.x};
  EpiMergeS e{(u32x4*)(p.ws + OFF_Q) + (size_t)blockIdx.x * 16 * 512, (bf16_t*)(p.ws + OFF_Z) + Z_M};
  gemm_stream(smem, s, e);
}
DI void phase_resid_gemm(const Params& p, int layer, const bf16_t* A, int lda, const bf16_t* BT, int K, int chunk, bool from_input, bool skipctx, char* smem) {
  Order o; o.init(skipctx ? 128 : 136, 4, skipctx);
  EpiResid e{p, layer, chunk, from_input};
  gemm_phase(smem, A, lda, BT, K, K, o, e);
}
DI void phase_ffn1(const Params& p, int layer, bool skipctx, char* smem) {
  Order o; o.init(skipctx ? 128 : 136, 22, skipctx);
  EpiFFN1 e{(bf16_t*)(p.ws + OFF_Z)};
  gemm_phase(smem, (const bf16_t*)(p.ws + OFF_H), 1024, wl(p, layer) + W_FF13, 1024, 1024, o, e);
}
DI void phase_attn(const Params& p, int hf, bool skipctx, char* smem, int& rot) {
  const bf16_t* Qb = (const bf16_t*)(p.ws + OFF_Q);
  const bf16_t* Kb = (const bf16_t*)(p.ws + OFF_K);
  const bf16_t* VTb = (const bf16_t*)(p.ws + OFF_VT);
  bf16_t* Z = (bf16_t*)(p.ws + OFF_Z) + (size_t)hf * TH * ZS;
  constexpr int KROW = 208, VROW = 264, KB_ = 128 * KROW, STG = KB_ + 64 * VROW;
  const int nitem = HB * 8 * 16 + (skipctx ? 0 : HB * 8);
  const int vb_ = vblock(rot); rot = (rot + nitem) % (int)gridDim.x;
  for (int it = vb_; it < nitem; it += gridDim.x) {
    const int tid = get_tid(), lane = tid & 63, w = tid >> 6, r = lane & 31, h = lane >> 5;
    int bh, s0, nkt;
    if (it < HB * 8 * 16) {
      int li = it;
      if (gridDim.x == 256) { const int c_ = it & 255, rr_ = it >> 8, idx_ = (c_ >> 3) + 32 * rr_; li = ((c_ & 7) * 4 + (idx_ >> 4)) * 16 + (idx_ & 15); }
      bh = li >> 4; s0 = LC + (li & 15) * 256; nkt = S / 128;
    } else { bh = it - HB * 8 * 16; s0 = 0; nkt = LC / 128; }
    const int head = bh & 7, bl = bh >> 3;
    const size_t tq = (size_t)bl * S + s0 + w * 32 + r;
    bf16x8 qf[6];
    {
      const float* axc = (const float*)(p.ws + OFF_AXC); const float* axs = (const float*)(p.ws + OFF_AXS);
      uint4 qu[6];
#pragma unroll
      for (int ks = 0; ks < 6; ++ks) qu[ks] = *(const uint4*)(Qb + tq * 768 + head * 96 + ks * 16 + h * 8);
#pragma unroll
      for (int ks = 0; ks < 4; ++ks) {
        const uint4 u = qu[ks];
        qf[ks] = pack8(bflo(u.x) * QSCALE, bfhi(u.x) * QSCALE, bflo(u.y) * QSCALE, bfhi(u.y) * QSCALE, bflo(u.z) * QSCALE, bfhi(u.z) * QSCALE, bflo(u.w) * QSCALE, bfhi(u.w) * QSCALE);
      }
      const unsigned a1[4] = {qu[4].x, qu[4].y, qu[4].z, qu[4].w}, a2[4] = {qu[5].x, qu[5].y, qu[5].z, qu[5].w};
      float o1[8], o2[8];
      const int sq_ = s0 + w * 32 + r;
#pragma unroll
      for (int e = 0; e < 8; ++e) {
        const float x1 = ((e & 1) ? bfhi(a1[e >> 1]) : bflo(a1[e >> 1])) * QSCALE;
        const float x2 = ((e & 1) ? bfhi(a2[e >> 1]) : bflo(a2[e >> 1])) * QSCALE;
        float cs = 1.f, sn = 0.f;
        if (sq_ >= LC) { cs = axc[(sq_ - LC) * 16 + 8 * h + e]; sn = axs[(sq_ - LC) * 16 + 8 * h + e]; }
        o1[e] = x1 * cs - x2 * sn; o2[e] = x1 * sn + x2 * cs;
      }
      qf[4] = pack8(o1[0], o1[1], o1[2], o1[3], o1[4], o1[5], o1[6], o1[7]);
      qf[5] = pack8(o2[0], o2[1], o2[2], o2[3], o2[4], o2[5], o2[6], o2[7]);
    }
    const bf16_t* Kg = Kb + (size_t)(bl * 8 + head) * S * 96;
    const bf16_t* Vg = VTb + (size_t)(bl * 8 + head) * 64 * S;
    f32x16 o[2]; o[0] = zero16(); o[1] = zero16();
    float m_run = -1e30f, l_run = 0.f;
    uint4 ak0, ak1, ak2, av0, av1, bk0, bk1, bk2, bv0, bv1;
    const int kr0 = tid / 12, kc0 = tid - kr0 * 12, kr1 = (tid + 512) / 12, kc1 = (tid + 512) - kr1 * 12, kr2 = (tid + 1024) / 12, kc2 = (tid + 1024) - kr2 * 12;
    const int vr0 = tid >> 4, vr1 = (tid + 512) >> 4, vc = tid & 15;
#define ATT_LOAD(K0, K1, K2, V0, V1, t_) do { \
      K0 = *(const uint4*)(Kg + (size_t)((t_) * 128 + kr0) * 96 + kc0 * 8); K1 = *(const uint4*)(Kg + (size_t)((t_) * 128 + kr1) * 96 + kc1 * 8); K2 = *(const uint4*)(Kg + (size_t)((t_) * 128 + kr2) * 96 + kc2 * 8); \
      V0 = *(const uint4*)(Vg + (size_t)vr0 * S + (t_) * 128 + vc * 8); V1 = *(const uint4*)(Vg + (size_t)vr1 * S + (t_) * 128 + vc * 8); } while (0)
#define ATT_WRITE(K0, K1, K2, V0, V1, buf) do { char* sk_ = smem + (buf) * STG; char* sv_ = sk_ + KB_; \
      *(uint4*)(sk_ + kr0 * KROW + kc0 * 16) = K0; *(uint4*)(sk_ + kr1 * KROW + kc1 * 16) = K1; *(uint4*)(sk_ + kr2 * KROW + kc2 * 16) = K2; \
      *(uint2*)(sv_ + vr0 * VROW + vc * 16) = make_uint2(V0.x, V0.y); *(uint2*)(sv_ + vr0 * VROW + vc * 16 + 8) = make_uint2(V0.z, V0.w); \
      *(uint2*)(sv_ + vr1 * VROW + vc * 16) = make_uint2(V1.x, V1.y); *(uint2*)(sv_ + vr1 * VROW + vc * 16 + 8) = make_uint2(V1.z, V1.w); } while (0)
    auto compute = [&](int buf, int half) {
      const char* sk = smem + buf * STG + half * 64 * KROW; const char* sv = smem + buf * STG + KB_ + half * 128;
      f32x16 st[2]; st[0] = zero16(); st[1] = zero16();
      {
        bf16x8 kf[2][6];
#pragma unroll
        for (int kb = 0; kb < 2; ++kb)
#pragma unroll
          for (int ks = 0; ks < 6; ++ks) kf[kb][ks] = *(const bf16x8*)(sk + (kb * 32 + r) * KROW + (ks * 16 + h * 8) * 2);
        __builtin_amdgcn_sched_barrier(0);
#pragma unroll
        for (int ks = 0; ks < 6; ++ks)
#pragma unroll
          for (int kb = 0; kb < 2; ++kb) st[kb] = MFMA(kf[kb][ks], qf[ks], st[kb]);
        __builtin_amdgcn_sched_barrier(0);
      }
      bf16x8 vf[2][2][2];
#pragma unroll
      for (int kb = 0; kb < 2; ++kb)
#pragma unroll
        for (int s2 = 0; s2 < 2; ++s2)
#pragma unroll
          for (int dvb = 0; dvb < 2; ++dvb) {
            const char* vp = sv + (dvb * 32 + r) * VROW + (kb * 32 + 16 * s2 + 4 * h) * 2;
            const s16x4 lo = *(const s16x4*)vp, hi = *(const s16x4*)(vp + 16);
            vf[kb][s2][dvb] = __builtin_shufflevector(lo, hi, 0, 1, 2, 3, 4, 5, 6, 7);
          }
      float mx = st[0][0];
#pragma unroll
      for (int i = 0; i < 16; ++i) { mx = fmaxf(mx, st[0][i]); mx = fmaxf(mx, st[1][i]); }
      if (__any(mx > m_run + 8.f)) {
        mx = fmaxf(mx, __shfl_xor(mx, 32));
        const float m_new = fmaxf(m_run, mx);
        const float alpha = fexp2(m_run - m_new);
        m_run = m_new;
        l_run *= alpha;
#pragma unroll
        for (int i = 0; i < 16; ++i) { o[0][i] *= alpha; o[1][i] *= alpha; }
      }
      float ps = 0.f;
#pragma unroll
      for (int kb = 0; kb < 2; ++kb)
#pragma unroll
        for (int i = 0; i < 16; ++i) { const float e = fexp2(st[kb][i] - m_run); st[kb][i] = e; ps += e; }
      l_run += ps;
#pragma unroll
      for (int kb = 0; kb < 2; ++kb)
#pragma unroll
        for (int s2 = 0; s2 < 2; ++s2) {
          const bf16x8 pb = pack8(st[kb][8 * s2 + 0], st[kb][8 * s2 + 1], st[kb][8 * s2 + 2], st[kb][8 * s2 + 3], st[kb][8 * s2 + 4], st[kb][8 * s2 + 5], st[kb][8 * s2 + 6], st[kb][8 * s2 + 7]);
#pragma unroll
          for (int dvb = 0; dvb < 2; ++dvb) o[dvb] = MFMA(vf[kb][s2][dvb], pb, o[dvb]);
        }
    };
    __syncthreads();
    ATT_LOAD(ak0, ak1, ak2, av0, av1, 0);
    ATT_LOAD(bk0, bk1, bk2, bv0, bv1, 1);
    ATT_WRITE(ak0, ak1, ak2, av0, av1, 0);
    __syncthreads();
    for (int kt = 0; kt < nkt; kt += 2) {
      if (kt + 2 < nkt) ATT_LOAD(ak0, ak1, ak2, av0, av1, kt + 2);
      compute(0, 0); compute(0, 1);
      ATT_WRITE(bk0, bk1, bk2, bv0, bv1, 1);
      __syncthreads();
      if (kt + 3 < nkt) ATT_LOAD(bk0, bk1, bk2, bv0, bv1, kt + 3);
      compute(1, 0); compute(1, 1);
      if (kt + 2 < nkt) ATT_WRITE(ak0, ak1, ak2, av0, av1, 0);
      __syncthreads();
    }
#undef ATT_LOAD
#undef ATT_WRITE
    const float lt = l_run + __shfl_xor(l_run, 32);
    const float inv = 1.f / lt;
    bf16_t* ot = (bf16_t*)smem;
#pragma unroll
    for (int dvb = 0; dvb < 2; ++dvb)
#pragma unroll
      for (int i = 0; i < 16; ++i) ot[(w * 32 + r) * 72 + dvb * 32 + crow(i, h)] = f2bf(o[dvb][i] * inv);
    __syncthreads();
#pragma unroll
    for (int i = 0; i < 4; ++i) {
      const int c = tid + 512 * i, row = c >> 3, kc = c & 7;
      const uint4 v = *(const uint4*)((const char*)ot + row * 144 + kc * 16);
      *(uint4*)(Z + ((size_t)bl * S + s0 + row) * ZS + Z_YB + head * 64 + kc * 8) = v;
    }
  }
}

DI void phase_lru(const Params& p, int layer, int b0, int nb, int mode, bool skipctx, char* smem) {
  bf16_t* Z = (bf16_t*)(p.ws + OFF_Z);
  const bf16_t* WL = wl(p, layer) + W_L;
  float2* AGG = (float2*)(p.ws + OFF_AGG);
  const float* H0 = (const float*)(p.ws + OFF_H0);
  bf16_t* xs0 = (bf16_t*)smem;
  bf16_t* uA = (bf16_t*)(smem + 17408);
  float* uF = (float*)(smem + 26624);
  float* sA = (float*)(smem + 43008);
  float* sB = (float*)(smem + 76288);
  float* h0s = (float*)(smem + 109568);
  constexpr int SD = 64 * 65;
  const float* cw = p.conv_w + layer * 4 * 512; const float* cb = p.conv_b + layer * 512;
  int G = gridDim.x; asm volatile("" : "+s"(G));
  const int nbn = nb * 8, bpg = G / nbn;
  const int bn = blockIdx.x / bpg, sub = blockIdx.x - bn * bpg;
  if (bn >= nbn) return;
  const int nblk = bn & 7, b = b0 + (bn >> 3);
  const int jlo = (mode == 1 && skipctx) ? 4 : 0;
  const int tid0 = get_tid(), lane0 = tid0 & 63, w0_ = tid0 >> 6, r0 = lane0 & 31, h0_ = lane0 >> 5;
  const int chh0 = (w0_ >> 1) & 1, dw0 = w0_ >> 2;
  bf16x8 bq[4][2];
#pragma unroll
  for (int ks = 0; ks < 4; ++ks)
#pragma unroll
    for (int q = 0; q < 2; ++q) bq[ks][q] = *(const bf16x8*)(WL + (size_t)(nblk * 256 + (2 * dw0 + q) * 64 + chh0 * 32 + r0) * 64 + ks * 16 + 8 * h0_);
  const int chgl = nblk * 64 + chh0 * 32 + r0;
  const float sp = log1p_pos(__expf(-p.lru_lam[(layer * 2 + dw0) * 512 + chgl]));
  const float ba = p.lru_ba[(layer * 2 + dw0) * 512 + chgl], bx = p.lru_bx[(layer * 2 + dw0) * 512 + chgl];
  const int chg = nblk * 64 + (tid0 & 63);
  const float w0 = cw[chg], w1 = cw[512 + chg], w2 = cw[1024 + chg], w3 = cw[1536 + chg], bb = cb[chg];
  uint4 pre0 = make_uint4(0, 0, 0, 0), pre1 = make_uint4(0, 0, 0, 0);
  float preh = 0.f;
  int tid = tid0;
  auto issue = [&](int j) {
    if (mode == 1 && tid < 128) preh = H0[((size_t)(b * 2 + (tid >> 6)) * 68 + j) * 512 + nblk * 64 + (tid & 63)];
    const int s0 = j * 64, slo = j < 4 ? 0 : LC, shi = j < 4 ? LC : S;
    { const int row = tid >> 3, kc = tid & 7, s = s0 - 2 + row;
      pre0 = make_uint4(0, 0, 0, 0);
      if (s >= slo && s < shi) pre0 = *(const uint4*)(Z + ((size_t)b * S + s) * ZS + Z_LRUX + nblk * 64 + kc * 8); }
    { const int c = tid + 512, row = c >> 3, kc = c & 7, s = s0 - 2 + row;
      pre1 = make_uint4(0, 0, 0, 0);
      if (c < 67 * 8 && s >= slo && s < shi) pre1 = *(const uint4*)(Z + ((size_t)b * S + s) * ZS + Z_LRUX + nblk * 64 + kc * 8); }
  };
  auto stash = [&](int buf) {
    char* xb_ = (char*)xs0 + buf * 8704;
    *(uint4*)(xb_ + (tid >> 3) * 128 + (tid & 7) * 16) = pre0;
    if (tid + 512 < 67 * 8) *(uint4*)(xb_ + ((tid + 512) >> 3) * 128 + (tid & 7) * 16) = pre1;
    if (mode == 1 && tid < 128) h0s[tid] = preh;
  };
  __syncthreads();
  issue(jlo + sub);
  stash(0);
  int cur = 0;
  for (int j = jlo + sub; j < 68; j += bpg, cur ^= 1) {
    const int s0 = j * 64;
    const bf16_t* xs = xs0 + cur * (8704 / 2);
    tid = get_tid();
    const int lane = tid & 63, w = tid >> 6, r = lane & 31, h = lane >> 5, th = w & 1, chh = (w >> 1) & 1, dw = w >> 2, chl = chh * 32 + r, ch = tid & 63;
    const int sd = w >> 2, sc16 = lane & 15, sseg = lane >> 4, sch = (w & 3) * 16 + sc16;
    __syncthreads();
#pragma unroll
    for (int i = 0; i < 8; ++i) {
      const int tok = (tid >> 6) + 8 * i;
      const float u = bb + w0 * bf2f(xs[tok * 64 + ch]) + w1 * bf2f(xs[(tok + 1) * 64 + ch]) + w2 * bf2f(xs[(tok + 2) * 64 + ch]) + w3 * bf2f(xs[(tok + 3) * 64 + ch]);
      uF[tok * 64 + ch] = u; uA[tok * 72 + ch] = f2bf(u);
    }
    const float h0v = (mode == 1) ? h0s[sd * 64 + sch] : 0.f;
    if (j + bpg < 68) issue(j + bpg);
    __syncthreads();
    {
      f32x16 acc[2]; acc[0] = zero16(); acc[1] = zero16();
#pragma unroll
      for (int ks = 0; ks < 4; ++ks) {
        const bf16x8 a = *(const bf16x8*)((const char*)uA + (th * 32 + r) * 144 + (ks * 16 + 8 * h) * 2);
#pragma unroll
        for (int q = 0; q < 2; ++q) acc[q] = MFMA(a, bq[ks][q], acc[q]);
      }
#pragma unroll
      for (int i = 0; i < 16; ++i) {
        const int tok = th * 32 + crow(i, h);
        const float rr = sigmoidf_(acc[0][i] + ba), ii = sigmoidf_(acc[1][i] + bx);
        const float a_ = __builtin_amdgcn_exp2f(-11.541560327111707f * rr * sp);
        sA[dw * SD + tok * 65 + chl] = a_;
        sB[dw * SD + tok * 65 + chl] = __builtin_amdgcn_sqrtf(__builtin_fmaf(-a_, a_, 1.f)) * ii * uF[tok * 64 + chl];
      }
    }
    unsigned short gate[8];
    if (mode == 1) {
      const bf16_t* gp = Z + ((size_t)b * S + s0 + (tid >> 6)) * ZS + Z_LGATE + nblk * 64 + ch;
#pragma unroll
      for (int i = 0; i < 8; ++i) gate[i] = gp[(size_t)(8 * i) * ZS];
    }
    __syncthreads();
    {
      float av[16], bv[16];
#pragma unroll
      for (int q = 0; q < 16; ++q) {
        const int pi = sseg * 16 + q, tok = sd ? 63 - pi : pi;
        av[q] = sA[sd * SD + tok * 65 + sch]; bv[q] = sB[sd * SD + tok * 65 + sch];
      }
      float P = 1.f, E = 0.f;
#pragma unroll
      for (int q = 0; q < 16; ++q) { E = av[q] * E + bv[q]; P *= av[q]; }
      float hh = h0v, PP = 1.f, EE = 0.f;
#pragma unroll
      for (int sg = 0; sg < 4; ++sg) {
        const float Pg = __shfl(P, sc16 + 16 * sg), Eg = __shfl(E, sc16 + 16 * sg);
        if (sg < sseg) hh = Pg * hh + Eg;
        EE = Pg * EE + Eg; PP *= Pg;
      }
      if (mode == 0) {
        if (sseg == 0) AGG[((size_t)(b * 2 + sd) * 68 + j) * 512 + nblk * 64 + sch] = make_float2(PP, EE);
      } else {
#pragma unroll
        for (int q = 0; q < 16; ++q) {
          const int pi = sseg * 16 + q, tok = sd ? 63 - pi : pi;
          hh = av[q] * hh + bv[q];
          sB[sd * SD + tok * 65 + sch] = hh;
        }
      }
    }
    if (mode == 1) {
      __syncthreads();
#pragma unroll
      for (int i = 0; i < 8; ++i) {
        const int tok = (tid >> 6) + 8 * i;
        const float g = bf2f(gate[i]);
        Z[((size_t)b * S + s0 + tok) * ZS + Z_LGATE + nblk * 64 + ch] = f2bf(geluf_(g) * (sB[tok * 65 + ch] + sB[SD + tok * 65 + ch]));
      }
    }
    stash(cur ^ 1);
  }
}

template <int DIR>
DI void lru_prefix_one(const float2* ag, float* h0) {
  float hh = 0.f;
#pragma unroll 1
  for (int g = 0; g < 4; ++g) {
    float2 v[17];
#pragma unroll
    for (int i = 0; i < 17; ++i) { const int q = g * 17 + i; const int t = DIR ? (q < 4 ? 3 - q : 71 - q) : q; v[i] = ag[(size_t)t * 512]; }
#pragma unroll
    for (int i = 0; i < 17; ++i) { const int q = g * 17 + i; const int t = DIR ? (q < 4 ? 3 - q : 71 - q) : q; h0[(size_t)t * 512] = hh; hh = v[i].x * hh + v[i].y; }
  }
}
DI void phase_lru_prefix(const Params& p) {
  const float2* AGG = (const float2*)(p.ws + OFF_AGG);
  float* H0 = (float*)(p.ws + OFF_H0);
  for (int it = blockIdx.x; it < NB * 2; it += gridDim.x) {
    const int tid = get_tid(), d = it & 1;
    const float2* ag = AGG + (size_t)it * 68 * 512 + tid;
    float* h0 = H0 + (size_t)it * 68 * 512 + tid;
    if (d) lru_prefix_one<1>(ag, h0); else lru_prefix_one<0>(ag, h0);
  }
}

DI float ret_lg2(int head, int d) { return log2f(1.f - exp2f(-(d ? 5.5f : 5.0f) - (float)head)); }

DI void phase_ret_states(const Params& p, int hf, char* smem, int& rot) {
  const bf16_t* Z = (const bf16_t*)(p.ws + OFF_Z) + (size_t)hf * TH * ZS;
  const bf16_t* RVT = (const bf16_t*)(p.ws + OFF_RVT) + (size_t)hf * HB * 512 * S;
  float* CS = (float*)(p.ws + OFF_CS);
  const float* rtc = (const float*)(p.ws + OFF_RTC); const float* rts = (const float*)(p.ws + OFF_RTS);
  bf16_t* KT0 = (bf16_t*)smem;
  bf16_t* KT1 = (bf16_t*)(smem + 17408);
  char* VT = smem + 34816;
  const int nitem = HB * 4 * 34;
  const int vb_ = vblock(rot); rot = (rot + nitem) % (int)gridDim.x;
  for (int it = vb_; it < nitem; it += gridDim.x) {
    const int tid = get_tid(), lane = tid & 63, w = tid >> 6, r = lane & 31, h = lane >> 5;
    const int c = it % 34, bh = it / 34, head = bh & 3, bl = bh >> 2;
    const float lgf = ret_lg2(head, 0), lgb = ret_lg2(head, 1);
    __syncthreads();
    {
      const int tok = tid >> 2, cp = tid & 3, s = c * 128 + tok;
      const bf16_t* kp = Z + ((size_t)bl * S + s) * ZS + Z_RETK + head * 64 + cp * 8;
      const uint4 u1 = *(const uint4*)kp, u2 = *(const uint4*)(kp + 32);
      const unsigned a1[4] = {u1.x, u1.y, u1.z, u1.w}, a2[4] = {u2.x, u2.y, u2.z, u2.w};
      const float wf = fexp2((float)(127 - tok) * lgf) * 0.125f, wb = fexp2((float)tok * lgb) * 0.125f;
#pragma unroll
      for (int e = 0; e < 8; ++e) {
        const int jd = cp * 8 + e;
        const float x1 = (e & 1) ? bfhi(a1[e >> 1]) : bflo(a1[e >> 1]);
        const float x2 = (e & 1) ? bfhi(a2[e >> 1]) : bflo(a2[e >> 1]);
        const float cs = rtc[s * 32 + jd], sn = rts[s * 32 + jd];
        const float k1 = x1 * cs - x2 * sn, k2 = x1 * sn + x2 * cs;
        KT0[jd * 136 + tok] = f2bf(k1 * wf); KT0[(jd + 32) * 136 + tok] = f2bf(k2 * wf);
        KT1[jd * 136 + tok] = f2bf(k1 * wb); KT1[(jd + 32) * 136 + tok] = f2bf(k2 * wb);
      }
    }
    {
      uint4 vq[4];
#pragma unroll
      for (int u = 0; u < 4; ++u) { const int ch = tid + 512 * u, row = ch >> 4, kc = ch & 15; vq[u] = *(const uint4*)(RVT + ((size_t)(bl * 4 + head) * 128 + row) * S + c * 128 + kc * 8); }
#pragma unroll
      for (int u = 0; u < 4; ++u) { const int ch = tid + 512 * u, row = ch >> 4, kc = ch & 15; *(uint4*)(VT + row * 272 + kc * 16) = vq[u]; }
    }
    __syncthreads();
    const int dvb = w & 3, d = w >> 2;
    const char* KTd = (const char*)(d ? KT1 : KT0);
    f32x16 acc[2]; acc[0] = zero16(); acc[1] = zero16();
#pragma unroll
    for (int ks = 0; ks < 8; ++ks) {
      const bf16x8 a = *(const bf16x8*)(VT + (dvb * 32 + r) * 272 + (ks * 16 + 8 * h) * 2);
#pragma unroll
      for (int nb2 = 0; nb2 < 2; ++nb2) {
        const bf16x8 b0 = *(const bf16x8*)(KTd + (nb2 * 32 + r) * 272 + (ks * 16 + 8 * h) * 2);
        acc[nb2] = MFMA(a, b0, acc[nb2]);
      }
    }
#pragma unroll
    for (int nb2 = 0; nb2 < 2; ++nb2)
#pragma unroll
      for (int i = 0; i < 16; ++i)
        CS[((size_t)((bl * 4 + head) * 34 + c) * 2 + d) * 8192 + (dvb * 32 + crow(i, h)) * 64 + nb2 * 32 + r] = acc[nb2][i];
  }
}
template <int DIR>
DI void ret_prefix_one(const float* base, bf16_t* ob, float g128) {
  float v[34];
#pragma unroll
  for (int i = 0; i < 34; ++i) { const int c = DIR ? (i < 2 ? 1 - i : 35 - i) : i; v[i] = base[(size_t)c * 2 * 8192]; }
  float run = 0.f;
#pragma unroll
  for (int i = 0; i < 34; ++i) { const int c = DIR ? (i < 2 ? 1 - i : 35 - i) : i; ob[(size_t)c * 2 * 8192] = f2bf(run); run = g128 * run + v[i]; }
}
DI void phase_ret_prefix(const Params& p) {
  const float* CS = (const float*)(p.ws + OFF_CS);
  bf16_t* CSB = (bf16_t*)(p.ws + OFF_CSB);
  const int nitem = HB * 4 * 2 * 16;
  for (int it = blockIdx.x; it < nitem; it += gridDim.x) {
    const int eb = it & 15, d = (it >> 4) & 1, bh = it >> 5, head = bh & 3;
    const float g128 = exp2f(128.f * ret_lg2(head, d));
    const size_t off = ((size_t)(bh * 34) * 2 + d) * 8192 + eb * 512 + get_tid();
    if (d) ret_prefix_one<1>(CS + off, CSB + off, g128); else ret_prefix_one<0>(CS + off, CSB + off, g128);
  }
}
DI void phase_ret_out(const Params& p, int hf, bool skipctx, char* smem0, int& rot) {
  bf16_t* Z = (bf16_t*)(p.ws + OFF_Z) + (size_t)hf * TH * ZS;
  const bf16_t* RVT = (const bf16_t*)(p.ws + OFF_RVT) + (size_t)hf * HB * 512 * S;
  const bf16_t* CS = (const bf16_t*)(p.ws + OFF_CSB);
  const float* rtc = (const float*)(p.ws + OFF_RTC); const float* rts = (const float*)(p.ws + OFF_RTS);
  const int cpb = skipctx ? 32 : 34;
  const int npair = HB * 4 * cpb / 2;
  const int vb_ = vblock(rot); rot = (rot + npair) % (int)gridDim.x;
  for (int itp = vb_; itp < npair; itp += gridDim.x) {
    const int tid5 = get_tid(), grp = tid5 >> 8, tid = tid5 & 255, lane = tid & 63, w = tid >> 6, r = lane & 31, h = lane >> 5;
    char* smem = smem0 + grp * 53248;
    char* KR = smem;
    char* VT = smem + 18432;
    bf16_t* ot = (bf16_t*)(smem + 18432);
    const int it = itp * 2 + grp;
    int c, bh;
    if (skipctx) { c = (it & 31) + 2; bh = it >> 5; } else { c = it % 34; bh = it / 34; }
    const int head = bh & 3, bl = bh >> 2;
    const float lgf = ret_lg2(head, 0), lgb = ret_lg2(head, 1);
    __syncthreads();
#pragma unroll 1
    for (int u = 0; u < 2; ++u) {
      const int q = tid + 256 * u, tok = q >> 2, cp = q & 3, s = c * 128 + tok;
      const bf16_t* kp = Z + ((size_t)bl * S + s) * ZS + Z_RETK + head * 64 + cp * 8;
      const uint4 u1 = *(const uint4*)kp, u2 = *(const uint4*)(kp + 32);
      const unsigned a1[4] = {u1.x, u1.y, u1.z, u1.w}, a2[4] = {u2.x, u2.y, u2.z, u2.w};
      float k1[8], k2[8];
#pragma unroll
      for (int e = 0; e < 8; ++e) {
        const int jd = cp * 8 + e;
        const float x1 = (e & 1) ? bfhi(a1[e >> 1]) : bflo(a1[e >> 1]);
        const float x2 = (e & 1) ? bfhi(a2[e >> 1]) : bflo(a2[e >> 1]);
        const float cs = rtc[s * 32 + jd], sn = rts[s * 32 + jd];
        k1[e] = (x1 * cs - x2 * sn) * 0.125f; k2[e] = (x1 * sn + x2 * cs) * 0.125f;
      }
      *(bf16x8*)(KR + tok * 144 + cp * 16) = pack8(k1[0], k1[1], k1[2], k1[3], k1[4], k1[5], k1[6], k1[7]);
      *(bf16x8*)(KR + tok * 144 + 64 + cp * 16) = pack8(k2[0], k2[1], k2[2], k2[3], k2[4], k2[5], k2[6], k2[7]);
    }
    {
      uint4 vq[8];
#pragma unroll
      for (int u = 0; u < 8; ++u) { const int ch = tid + 256 * u, row = ch >> 4, kc = ch & 15; vq[u] = *(const uint4*)(RVT + ((size_t)(bl * 4 + head) * 128 + row) * S + c * 128 + kc * 8); }
#pragma unroll
      for (int u = 0; u < 8; ++u) { const int ch = tid + 256 * u, row = ch >> 4, kc = ch & 15; *(uint4*)(VT + row * 272 + kc * 16) = vq[u]; }
    }
    const int iq = w * 32 + r, sq = c * 128 + iq;
    bf16x8 qf[4];
    {
      const bf16_t* qp = Z + ((size_t)bl * S + sq) * ZS + Z_RETQ + head * 64;
#pragma unroll
      for (int ks = 0; ks < 2; ++ks) {
        MEMBAR();
        const uint4 u1 = *(const uint4*)(qp + ks * 16 + 8 * h), u2 = *(const uint4*)(qp + 32 + ks * 16 + 8 * h);
        const unsigned a1[4] = {u1.x, u1.y, u1.z, u1.w}, a2[4] = {u2.x, u2.y, u2.z, u2.w};
        float q1[8], q2[8];
#pragma unroll
        for (int e = 0; e < 8; ++e) {
          const int jd = ks * 16 + 8 * h + e;
          const float x1 = (e & 1) ? bfhi(a1[e >> 1]) : bflo(a1[e >> 1]);
          const float x2 = (e & 1) ? bfhi(a2[e >> 1]) : bflo(a2[e >> 1]);
          const float cs = rtc[sq * 32 + jd], sn = rts[sq * 32 + jd];
          q1[e] = x1 * cs - x2 * sn; q2[e] = x1 * sn + x2 * cs;
        }
        qf[ks] = pack8(q1[0], q1[1], q1[2], q1[3], q1[4], q1[5], q1[6], q1[7]);
        qf[ks + 2] = pack8(q2[0], q2[1], q2[2], q2[3], q2[4], q2[5], q2[6], q2[7]);
      }
    }
    __syncthreads();
    f32x16 o[4];
#pragma unroll
    for (int dvb = 0; dvb < 4; ++dvb) o[dvb] = zero16();
#pragma unroll
    for (int kb = 0; kb < 4; ++kb) {
      MEMBAR();
      f32x16 st = zero16();
#pragma unroll
      for (int ks = 0; ks < 4; ++ks) {
        const bf16x8 a = *(const bf16x8*)(KR + (kb * 32 + r) * 144 + (ks * 16 + 8 * h) * 2);
        st = MFMA(a, qf[ks], st);
      }
#pragma unroll
      for (int i = 0; i < 16; ++i) {
        const int dl = iq - (kb * 32 + crow(i, h));
        const float dlf = (float)dl;
        const float e = fexp2(dl > 0 ? dlf * lgf : -dlf * lgb);
        st[i] *= (dl == 0 ? 2.f : e);
      }
#pragma unroll
      for (int s2 = 0; s2 < 2; ++s2) {
        const bf16x8 pb = pack8(st[8 * s2 + 0], st[8 * s2 + 1], st[8 * s2 + 2], st[8 * s2 + 3], st[8 * s2 + 4], st[8 * s2 + 5], st[8 * s2 + 6], st[8 * s2 + 7]);
#pragma unroll
        for (int dvb = 0; dvb < 4; ++dvb) {
          const char* vp = VT + (dvb * 32 + r) * 272 + (kb * 32 + 16 * s2 + 4 * h) * 2;
          const s16x4 lo = *(const s16x4*)vp, hi = *(const s16x4*)(vp + 16);
          const bf16x8 va = __builtin_shufflevector(lo, hi, 0, 1, 2, 3, 4, 5, 6, 7);
          o[dvb] = MFMA(va, pb, o[dvb]);
        }
      }
    }
#pragma unroll 1
    for (int d = 0; d < 2; ++d) {
      const float qdec = d ? fexp2((float)(128 - iq) * lgb) : fexp2((float)(iq + 1) * lgf);
      const bf16_t* Rg = CS + ((size_t)((bl * 4 + head) * 34 + c) * 2 + d) * 8192;
      bf16x8 rf[4][4];
#pragma unroll
      for (int dvb = 0; dvb < 4; ++dvb)
#pragma unroll
        for (int ks = 0; ks < 4; ++ks) rf[dvb][ks] = *(const bf16x8*)(Rg + (dvb * 32 + r) * 64 + ks * 16 + 8 * h);
#pragma unroll
      for (int dvb = 0; dvb < 4; ++dvb) {
        f32x16 t = zero16();
#pragma unroll
        for (int ks = 0; ks < 4; ++ks) t = MFMA(rf[dvb][ks], qf[ks], t);
#pragma unroll
        for (int i = 0; i < 16; ++i) o[dvb][i] += qdec * t[i];
      }
    }
    float sm = 0.f;
#pragma unroll
    for (int dvb = 0; dvb < 4; ++dvb)
#pragma unroll
      for (int i = 0; i < 16; ++i) sm += o[dvb][i];
    sm += __shfl_xor(sm, 32);
    const float mu = sm * (1.f / 128.f);
    float vs = 0.f;
#pragma unroll
    for (int dvb = 0; dvb < 4; ++dvb)
#pragma unroll
      for (int i = 0; i < 16; ++i) { const float dd = o[dvb][i] - mu; vs += dd * dd; }
    vs += __shfl_xor(vs, 32);
    const float rs = rsqrtf(vs * (1.f / 128.f) + EPS);
    __syncthreads();
#pragma unroll
    for (int dvb = 0; dvb < 4; ++dvb)
#pragma unroll
      for (int i = 0; i < 16; ++i) ot[iq * 136 + dvb * 32 + crow(i, h)] = f2bf((o[dvb][i] - mu) * rs);
    __syncthreads();
#pragma unroll 1
    for (int u = 0; u < 8; ++u) {
      const int ch = tid + 256 * u, row = ch >> 4, kc = ch & 15;
      bf16_t* gp = Z + ((size_t)bl * S + c * 128 + row) * ZS + Z_RGATE + head * 128 + kc * 8;
      const uint4 g4 = *(const uint4*)gp;
      const uint4 v4 = *(const uint4*)((const char*)ot + row * 272 + kc * 16);
      uint4 o4;
      o4.x = pk2(siluf_(bflo(g4.x)) * bflo(v4.x), siluf_(bfhi(g4.x)) * bfhi(v4.x));
      o4.y = pk2(siluf_(bflo(g4.y)) * bflo(v4.y), siluf_(bfhi(g4.y)) * bfhi(v4.y));
      o4.z = pk2(siluf_(bflo(g4.z)) * bflo(v4.z), siluf_(bfhi(g4.z)) * bfhi(v4.z));
      o4.w = pk2(siluf_(bflo(g4.w)) * bflo(v4.w), siluf_(bfhi(g4.w)) * bfhi(v4.w));
      *(uint4*)gp = o4;
    }
  }
}


__global__ void __launch_bounds__(NT, 2) fwd_megakernel(Params p) {
  extern __shared__ __attribute__((aligned(16))) char smem[];
  cg::grid_group grid = cg::this_grid();
  volatile LAS3 unsigned* xst = (volatile LAS3 unsigned*)(LAS3 unsigned*)(smem + SMEM_BYTES - 16);
  if (threadIdx.x == 0) { xst[0] = 0u; xst[1] = 0u; xst[2] = 0u; xst[3] = 0u; }
  __syncthreads();
  if (blockIdx.x == 0) { unsigned* bw = (unsigned*)(p.ws + OFF_BAR); for (int i = threadIdx.x; i < (int)(BAR_BYTES / 4); i += NT) bw[i] = 0u; }
  phase_setup(p, smem);
  grid.sync();
  const XcdBarrier xb = xcd_barrier_post((unsigned*)(p.ws + OFF_BAR), xst);
#define GSYNC() xcd_barrier(xb)
  for (int layer = 0; layer < 2; ++layer) {
    const bool first = layer == 0, last = layer == 1;
    phase_norm(p, layer, 0, first, false);
    if (first) phase_convert(p, 0, 0, smem);
    GSYNC();
    phase_gemm_a(p, layer, smem);
    GSYNC();
    phase_lownorm(p);
    phase_lru(p, layer, 0, NB, 0, false, smem);
    GSYNC();
    int rot = 16;
    phase_lru_prefix(p);
    phase_qkv(p, layer, 0, smem, rot);
    phase_ret_states(p, 0, smem, rot);
    GSYNC();
    phase_ret_prefix(p);
    rot = 0;
    phase_attn(p, 0, last, smem, rot);
    phase_lru(p, layer, 0, HB, 1, last, smem);
    GSYNC();
    rot = 0;
    phase_ret_out(p, 0, last, smem, rot);
    phase_qkv(p, layer, 1, smem, rot);
    phase_ret_states(p, 1, smem, rot);
    GSYNC();
    phase_ret_prefix(p);
    rot = 0;
    phase_attn(p, 1, last, smem, rot);
    phase_lru(p, layer, HB, HB, 1, last, smem);
    GSYNC();
    rot = 0;
    phase_ret_out(p, 1, last, smem, rot);
    GSYNC();
    phase_merge(p, layer, last, smem);
    if (first) phase_convert(p, 1, (int)gridDim.x - 32, smem);
    GSYNC();
    phase_resid_gemm(p, layer, (const bf16_t*)(p.ws + OFF_Z) + Z_M, ZS, wl(p, layer) + W_OUT, 1024, 2, first, last, smem);
    GSYNC();
    phase_norm(p, layer, 1, false, last);
    GSYNC();
    phase_ffn1(p, layer, last, smem);
    GSYNC();
    phase_resid_gemm(p, layer, (const bf16_t*)(p.ws + OFF_Z), DFF, wl(p, layer) + W_FF2, DFF, 5, false, last, smem);
    GSYNC();
  }
  phase_final_norm(p);
}

extern "C" void kernel_launch(void* const* d_in, const int* in_sizes, int n_in, void* d_out, int out_size, void* d_ws, size_t ws_size, hipStream_t stream) {
  static int grid_blocks = 0;
  if (!grid_blocks) {
    int dev = 0, cus = 0, per_cu = 0;
    (void)hipGetDevice(&dev);
    (void)hipDeviceGetAttribute(&cus, hipDeviceAttributeMultiprocessorCount, dev);
    if (hipFuncSetAttribute((const void*)fwd_megakernel, hipFuncAttributeMaxDynamicSharedMemorySize, SMEM_BYTES) != hipSuccess) fprintf(stderr, "hipFuncSetAttribute failed\n");
    (void)hipOccupancyMaxActiveBlocksPerMultiprocessor(&per_cu, fwd_megakernel, NT, SMEM_BYTES);
    if (per_cu < 1) per_cu = 1;
    grid_blocks = cus * per_cu;
  }
  if (ws_size < WS_TOTAL) { fprintf(stderr, "workspace too small: %zu < %zu\n", ws_size, (size_t)WS_TOTAL); return; }
  Params p{};
  const float** pp = (const float**)&p;
  for (int i = 0; i < 28; ++i) pp[i] = (const float*)d_in[i];
  p.out = (float*)d_out;
  p.ws = (char*)d_ws;
  void* args[] = {&p};
  hipError_t e = hipLaunchCooperativeKernel((void*)fwd_megakernel, dim3(grid_blocks), dim3(NT), args, SMEM_BYTES, stream);
  if (e != hipSuccess) fprintf(stderr, "cooperative launch failed: %s (grid %d)\n", hipGetErrorString(e), grid_blocks);
}
```

```cpp
#include <hip/hip_runtime.h>
#include <hip/hip_cooperative_groups.h>
#include <cstdio>
namespace cg = cooperative_groups;

#define DI __device__ __forceinline__
typedef unsigned short bf16_t;
using bf16x8 = __attribute__((ext_vector_type(8))) short;
using s16x4 = __attribute__((ext_vector_type(4))) short;
using f32x16 = __attribute__((ext_vector_type(16))) float;
typedef __bf16 bf2_t __attribute__((ext_vector_type(2)));
typedef float f2_t __attribute__((ext_vector_type(2)));
#define MFMA(a, b, c) __builtin_amdgcn_mfma_f32_32x32x16_bf16((a), (b), (c), 0, 0, 0)

constexpr int NB = 8, SEQ = 4096, LC = 256, S = 4352, D = 1024, T = NB * S;
constexpr int ZS = 2816, DFF = 2816, NIN = 6304;
constexpr int HB = 4;
constexpr int TH = HB * S;
constexpr float EPS = 1e-6f;
constexpr int Z_LRUX = 0, Z_RETK = 512, Z_RETQ = 768, Z_KVD = 1024, Z_QD = 1280, Z_LGATE = 1664, Z_RGATE = 2176, Z_KR = 2688;
constexpr int Z_M = 0, Z_YB = 1024, Z_YA = 1664, Z_YC = 2176;
constexpr size_t W_IN = 0;
constexpr size_t W_G = W_IN + 3328ull * 1024;
constexpr size_t W_UQ = W_G + 3072ull * 1024;
constexpr size_t W_UK = W_UQ + 768ull * 384;
constexpr size_t W_UV = W_UK + 512ull * 256;
constexpr size_t W_L = W_UV + 512ull * 256;
constexpr size_t W_OA = W_L + 8ull * 256 * 64;
constexpr size_t W_OB = W_OA + 1024ull * 512;
constexpr size_t W_OC = W_OB + 1024ull * 512;
constexpr size_t W_OUT = W_OC + 1024ull * 512;
constexpr size_t W_FF13 = W_OUT + 1024ull * 1024;
constexpr size_t W_FF2 = W_FF13 + 5632ull * 1024;
constexpr size_t W_LAYER = W_FF2 + 1024ull * 2816;
constexpr size_t OFF_W = 0;
constexpr size_t OFF_MOD = OFF_W + 2 * W_LAYER * 2;
constexpr size_t OFF_AXC = OFF_MOD + 2ull * 9 * 6144 * 4;
constexpr size_t OFF_AXS = OFF_AXC + 4096ull * 16 * 4;
constexpr size_t OFF_RTC = OFF_AXS + 4096ull * 16 * 4;
constexpr size_t OFF_RTS = OFF_RTC + 4352ull * 32 * 4;
constexpr size_t OFF_XC = OFF_RTS + 4352ull * 32 * 4;
constexpr size_t OFF_H = OFF_XC + 2048ull * 1024 * 4;
constexpr size_t OFF_Z = OFF_H + (size_t)T * 1024 * 2;
constexpr size_t OFF_RVT = OFF_Z + (size_t)T * ZS * 2;
constexpr size_t OFF_Q = OFF_RVT + 8ull * 512 * S * 2;
constexpr size_t OFF_K = OFF_Q + (size_t)TH * 768 * 2;
constexpr size_t OFF_VT = OFF_K + 4ull * 8 * S * 96 * 2;
constexpr size_t OFF_CS = OFF_VT + 4ull * 8 * 64 * S * 2;
constexpr size_t OFF_AGG = OFF_CS + 4ull * 4 * 34 * 2 * 8192 * 4;
constexpr size_t OFF_H0 = OFF_AGG + 8ull * 2 * 68 * 512 * 8;
constexpr size_t OFF_CSB = OFF_H0 + 8ull * 2 * 68 * 512 * 4;
constexpr size_t OFF_BAR = OFF_CSB + 4ull * 4 * 34 * 2 * 8192 * 2;
constexpr size_t BAR_BYTES = 3456 * 4;
constexpr size_t WS_TOTAL = OFF_BAR + 16384;

constexpr int NT = 512;
constexpr int SMEM_BYTES = 135168;
constexpr int SM_AUX = 131072;

struct Params {
  const float *x, *c, *ctx, *c_ctx, *w_mod, *b_mod, *g_mix, *g_ffn, *w_in, *conv_w, *conv_b, *lru_wa, *lru_ba, *lru_wx,
      *lru_bx, *lru_lam, *g_q, *w_uq, *g_kv, *w_ukv, *w_oa, *w_ob, *w_oc, *w_out, *w_ff1, *w_ff3, *w_ff2, *g_final;
  float* out;
  char* ws;
};

DI unsigned pk2(float a, float b) { f2_t v = {a, b}; bf2_t r = __builtin_convertvector(v, bf2_t); return __builtin_bit_cast(unsigned, r); }
DI bf16_t f2bf(float a) { return (bf16_t)(pk2(a, 0.f) & 0xffffu); }
DI float bf2f(unsigned b) { return __uint_as_float(b << 16); }
DI float bflo(unsigned u) { return __uint_as_float(u << 16); }
DI float bfhi(unsigned u) { return __uint_as_float(u & 0xffff0000u); }
DI bf16x8 pack8(float a0, float a1, float a2, float a3, float a4, float a5, float a6, float a7) {
  uint4 u; u.x = pk2(a0, a1); u.y = pk2(a2, a3); u.z = pk2(a4, a5); u.w = pk2(a6, a7);
  return __builtin_bit_cast(bf16x8, u);
}
DI float sigmoidf_(float x) { return __builtin_amdgcn_rcpf(1.f + __builtin_amdgcn_exp2f(-1.4426950408889634f * x)); }
DI float siluf_(float x) { return x * sigmoidf_(x); }
DI float geluf_(float x) { return x * sigmoidf_(1.5957691216057308f * (x + 0.044715f * x * x * x)); }
DI float log1p_pos(float e) { return e < 0.05f ? e * (1.f + e * (-0.5f + e * (0.33333334f + e * (-0.25f + e * 0.2f)))) : __logf(1.f + e); }
DI float expm1_neg(float x) { return x > -0.1f ? x * (1.f + x * (0.5f + x * (0.16666667f + x * (0.041666668f + x * 0.008333334f)))) : __expf(x) - 1.f; }
DI float fexp2(float x) { return __builtin_amdgcn_exp2f(x); }
DI float wave_sum(float v) {
#pragma unroll
  for (int o = 32; o >= 1; o >>= 1) v += __shfl_xor(v, o);
  return v;
}
DI int get_tid() { int t = threadIdx.x; asm volatile("" : "+v"(t)); return t; }
#define MEMBAR() asm volatile("" ::: "memory")
DI int crow(int i, int h) { return (i & 3) + 8 * (i >> 2) + 4 * h; }
DI f32x16 zero16() { f32x16 z; for (int i = 0; i < 16; ++i) z[i] = 0.f; return z; }

DI bf16_t* wl(const Params& p, int layer) { return (bf16_t*)(p.ws + OFF_W) + (size_t)layer * W_LAYER; }
DI float* modp(const Params& p, int layer, int g, int chunk) { return (float*)(p.ws + OFF_MOD) + ((size_t)(layer * 9 + g) * 6 + chunk) * 1024; }
DI const float* xrow_in(const Params& p, int t) { int b = t / S, s = t - b * S; return s < LC ? p.ctx + ((size_t)b * LC + s) * D : p.x + ((size_t)b * SEQ + (s - LC)) * D; }
DI float* xrow_ws(const Params& p, int t) { int b = t / S, s = t - b * S; return s < LC ? (float*)(p.ws + OFF_XC) + ((size_t)b * LC + s) * D : p.out + ((size_t)b * SEQ + (s - LC)) * D; }


#define LAS3 __attribute__((address_space(3)))
#define XB_TMO      128
#define XB_XCNT(j)  (256  + 64 * (j))
#define XB_XSUB(j)  (1280 + 64 * (j))
#define XB_XGEN(j)  (2304 + 64 * (j))
#define XB_TOP      3328
#define XB_TOPGEN   3392
#define XB_SPIN_CAP (1u << 22)
DI unsigned xb_ld(unsigned* p) { return __hip_atomic_load(p, __ATOMIC_RELAXED, __HIP_MEMORY_SCOPE_AGENT); }
DI unsigned xb_add(unsigned* p, unsigned v) { return __hip_atomic_fetch_add(p, v, __ATOMIC_RELAXED, __HIP_MEMORY_SCOPE_AGENT); }
DI unsigned xb_xcc_id() { return (unsigned)__builtin_amdgcn_s_getreg((3 << 11) | 20) & 0xFu; }
#define XB_SPIN(cond, bar) do { unsigned _sp = 0; while (cond) { __builtin_amdgcn_s_sleep(1); \
    if ((++_sp & 255u) == 0u) { if (xb_ld(&(bar)[XB_TMO])) break; if (_sp > XB_SPIN_CAP) { atomicAdd(&(bar)[XB_TMO], 1u); break; } } } } while (0)
struct XcdBarrier { unsigned* bar; unsigned x; volatile LAS3 unsigned* st; };
DI XcdBarrier xcd_barrier_post(unsigned* bar, volatile LAS3 unsigned* st) {
  XcdBarrier b; b.bar = bar; b.x = xb_xcc_id(); b.st = st;
  if (threadIdx.x == 0) (void)xb_add(&bar[XB_XCNT(b.x)], 1u);
  return b;
}
DI void xcd_barrier_complete(unsigned* bar, unsigned x, unsigned& nloc, unsigned& nx) {
  const unsigned G = gridDim.x * gridDim.y * gridDim.z;
  unsigned sum, cnt, mine, sp = 0u;
  for (;;) {
    sum = 0u; cnt = 0u; mine = 0u;
#pragma unroll
    for (unsigned j = 0; j < 16; ++j) { const unsigned c = xb_ld(&bar[XB_XCNT(j)]); sum += c; cnt += (c > 0u) ? 1u : 0u; mine = (j == x) ? c : mine; }
    if (sum == G) break;
    __builtin_amdgcn_s_sleep(1);
    if ((++sp & 255u) == 0u) { if (xb_ld(&bar[XB_TMO])) break; if (sp > XB_SPIN_CAP) { atomicAdd(&bar[XB_TMO], 1u); break; } }
  }
  nloc = mine > 0u ? mine : 1u; nx = cnt > 0u ? cnt : 1u;
}
DI void xcd_barrier(const XcdBarrier& b) {
  asm volatile("s_waitcnt vmcnt(0)" ::: "memory");
  __syncthreads();
  if (threadIdx.x == 0) {
    unsigned* bar = b.bar;
    __builtin_amdgcn_s_waitcnt(0);
    unsigned nloc = b.st[0], nx = b.st[1];
    if (nloc == 0u) { xcd_barrier_complete(bar, b.x, nloc, nx); b.st[0] = nloc; b.st[1] = nx; }
    const unsigned old = xb_add(&bar[XB_XSUB(b.x)], 1u);
    const unsigned gen = old / nloc;
    if (old + 1u == (gen + 1u) * nloc) {
      __builtin_amdgcn_fence(__ATOMIC_RELEASE, "agent");
      asm volatile("s_waitcnt vmcnt(0)" ::: "memory");
      const unsigned og = xb_add(&bar[XB_TOP], 1u);
      const unsigned tg = og / nx;
      if (og + 1u == (tg + 1u) * nx) xb_add(&bar[XB_TOPGEN], 1u);
      else XB_SPIN(xb_ld(&bar[XB_TOPGEN]) == tg, bar);
      __builtin_amdgcn_fence(__ATOMIC_ACQUIRE, "agent");
      xb_add(&bar[XB_XGEN(b.x)], 1u);
      asm volatile("s_waitcnt vmcnt(0)" ::: "memory");
    } else {
      XB_SPIN(xb_ld(&bar[XB_XGEN(b.x)]) == gen, bar);
      __builtin_amdgcn_fence(__ATOMIC_ACQUIRE, "agent");
      asm volatile("s_waitcnt vmcnt(0)" ::: "memory");
    }
  }
  __syncthreads();
}
#define LAS __attribute__((address_space(3)))
using f32x4 = __attribute__((ext_vector_type(4))) float;
using u32x4 = __attribute__((ext_vector_type(4))) unsigned;
constexpr int BM = 256, BK = 64, HALF = 128, HTB = HALF * BK * 2, NXCD = 8, WGM = 8;
DI int lds_byte(int r, int c) { const int st = (r >> 4) * 2 + (c >> 5), rr = r & 15, cc = c & 31, ob = rr * 64 + cc * 2; return st * 1024 + (ob ^ (((ob >> 9) & 1) << 5)); }
DI void stage_rc(int b, int& R, int& C) { const int st = b / 1024, sb = b % 1024, swz = sb ^ (((sb >> 9) & 1) << 5); R = (st >> 1) * 16 + swz / 64; C = (st & 1) * 32 + (swz % 64) / 2; }
DI int perm32(int rho) { const int n = rho >> 4, i = rho & 15; return 8 * (i >> 2) + 4 * n + (i & 3); }
struct Unit { int pm, pn; };
struct Order {
  int nM, nN, nwg, G, c, skip;
  DI void init(int nM_, int nN_, int skip_, int c_ = -1) { nM = nM_; nN = nN_; nwg = nM * nN; G = gridDim.x; c = c_ < 0 ? (int)blockIdx.x : c_; skip = skip_; }
  DI bool next(int i, Unit& u) const {
    const long L = (long)i * G + c; if (L >= nwg) return false;
    int wgid = (int)L; { const int q = nwg / NXCD, r = nwg % NXCD, xcd = wgid % NXCD, off = wgid / NXCD; wgid = (xcd < r ? xcd * (q + 1) : r * (q + 1) + (xcd - r) * q) + off; }
    const int nig = WGM * nN, gid = wgid / nig, fm = gid * WGM, gsz = (nM - fm) < WGM ? (nM - fm) : WGM;
    int pm = fm + ((wgid % nig) % gsz); u.pn = (wgid % nig) / gsz;
    if (skip) pm = pm + pm / 16 + 1;
    u.pm = pm; return true;
  }
};
typedef f32x4 acc_t[2][2][4][2];

template <class Epi>
DI void gemm_phase(char* smem, const bf16_t* A, int lda, const bf16_t* Bt, int ldb, int K, const Order& S_, const Epi& E) {
  LAS unsigned char* lds = (LAS unsigned char*)smem;
  const int tid = get_tid(), wid = __builtin_amdgcn_readfirstlane(tid >> 6), lane = tid & 63, wr = wid >> 2, wc = wid & 3, fr = lane & 15, fq = lane >> 4;
  const int nt = K / BK;
  unsigned voffA[2], voffB[2];
#pragma unroll
  for (int i = 0; i < 2; ++i) { int R, C; stage_rc(tid * 16 + i * 8192, R, C); const int Rb = Epi::PERM ? ((R & ~31) + perm32(R & 31)) : R;
    voffA[i] = (unsigned)(R * lda + C) * 2u; voffB[i] = (unsigned)(Rb * ldb + C) * 2u; }
  const size_t kstep = (size_t)(BK * 2);
  const size_t hstepA = (size_t)HALF * lda * 2, hstepB = (size_t)HALF * ldb * 2;
  const size_t tstepA = 2 * hstepA, tstepB = 2 * hstepB;
  const unsigned ldsw = (unsigned)wid * 1024u;
  const int aoff = lds_byte(wr * 64 + fr, fq * 8), boff = lds_byte(wc * 32 + fr, fq * 8);
#define PG8_SA(b, h) (((b) * 2 + (h)) * HTB)
#define PG8_SB(b, h) ((4 + (b) * 2 + (h)) * HTB)
#define PG8_STAGE(bufoff, gbase, voff) do { _Pragma("unroll") for (int _i = 0; _i < 2; ++_i) \
    __builtin_amdgcn_global_load_lds((const unsigned*)((const char*)(gbase) + (voff)[_i]), (LAS unsigned*)(lds + (bufoff) + ldsw + _i * 8192), 16, 0, 0); } while (0)
#define PG8_LDA(dst, b, h) do { _Pragma("unroll") for (int m = 0; m < 4; ++m) _Pragma("unroll") for (int k = 0; k < 2; ++k) dst[m][k] = *(const LAS bf16x8*)(lds + PG8_SA(b, h) + aoff + m * 2048 + k * 1024); } while (0)
#define PG8_LDB(dst, b, h) do { _Pragma("unroll") for (int n = 0; n < 2; ++n) _Pragma("unroll") for (int k = 0; k < 2; ++k) dst[n][k] = *(const LAS bf16x8*)(lds + PG8_SB(b, h) + boff + n * 2048 + k * 1024); } while (0)
#define PG8_MMA(ai, bj, At, Bt_) do { __builtin_amdgcn_s_setprio(1); _Pragma("unroll") for (int m = 0; m < 4; ++m) _Pragma("unroll") for (int n = 0; n < 2; ++n) _Pragma("unroll") for (int k = 0; k < 2; ++k) \
    acc[ai][bj][m][n] = __builtin_amdgcn_mfma_f32_16x16x32_bf16(Bt_[n][k], At[m][k], acc[ai][bj][m][n], 0, 0, 0); __builtin_amdgcn_s_setprio(0); } while (0)
#define PG8_WAIT_V(n) asm volatile("s_waitcnt vmcnt(" #n ")" ::: "memory")
#define PG8_WAIT_L(n) asm volatile("s_waitcnt lgkmcnt(" #n ")" ::: "memory")
#define PG8_BAR __builtin_amdgcn_s_barrier()
#define PG8_SCHED __builtin_amdgcn_sched_barrier(0)
  Unit cur, nxt; int ui = 0;
  if (!S_.next(0, cur)) return;
  f32x4 acc[2][2][4][2];
#pragma unroll
  for (int a = 0; a < 2; ++a)
#pragma unroll
    for (int b = 0; b < 2; ++b)
#pragma unroll
      for (int m = 0; m < 4; ++m)
#pragma unroll
        for (int n = 0; n < 2; ++n) acc[a][b][m][n] = (f32x4){0.f, 0.f, 0.f, 0.f};
  bf16x8 At[4][2], B0[2][2], B1[2][2];
  const char* cA = (const char*)A + (size_t)cur.pm * tstepA; const char* cB = (const char*)Bt + (size_t)cur.pn * tstepB;
  PG8_STAGE(PG8_SB(0, 0), cB, voffB); PG8_STAGE(PG8_SA(0, 0), cA, voffA); PG8_STAGE(PG8_SB(0, 1), cB + hstepB, voffB); PG8_STAGE(PG8_SA(0, 1), cA + hstepA, voffA);
  if (wr == 1) PG8_BAR;
  PG8_WAIT_V(4); PG8_BAR;
  PG8_STAGE(PG8_SB(1, 0), cB + kstep, voffB); PG8_STAGE(PG8_SA(1, 0), cA + kstep, voffA); PG8_STAGE(PG8_SB(1, 1), cB + hstepB + kstep, voffB);
  PG8_WAIT_V(6); PG8_BAR;
  for (;;) {
    const bool has_next = S_.next(ui + 1, nxt);
    const char* nA = has_next ? (const char*)A + (size_t)nxt.pm * tstepA : cA; const char* nB = has_next ? (const char*)Bt + (size_t)nxt.pn * tstepB : cB;
    for (int t = 0; t < nt; t += 2) {
      const bool last = (t == nt - 2);
      const char* a1 = cA + (size_t)(t + 1) * kstep;
      const char* a2 = last ? nA : cA + (size_t)(t + 2) * kstep; const char* b2 = last ? nB : cB + (size_t)(t + 2) * kstep;
      const char* a3 = a2 + kstep; const char* b3 = b2 + kstep;
      PG8_LDB(B0, 0, 0); PG8_SCHED; PG8_LDA(At, 0, 0); PG8_STAGE(PG8_SA(1, 1), a1 + hstepA, voffA);
      PG8_WAIT_L(8); PG8_BAR; PG8_WAIT_L(0); PG8_MMA(0, 0, At, B0); PG8_BAR; PG8_SCHED;
      PG8_LDB(B1, 0, 1); PG8_STAGE(PG8_SB(0, 0), b2, voffB);
      PG8_BAR; PG8_WAIT_L(0); PG8_MMA(0, 1, At, B1); PG8_BAR;
      PG8_LDA(At, 0, 1); PG8_STAGE(PG8_SA(0, 0), a2, voffA);
      PG8_BAR; PG8_WAIT_L(0); PG8_MMA(1, 0, At, B0); PG8_BAR; PG8_SCHED;
      PG8_STAGE(PG8_SB(0, 1), b2 + hstepB, voffB);
      PG8_WAIT_V(6); PG8_BAR; PG8_MMA(1, 1, At, B1); PG8_BAR;
      PG8_LDB(B0, 1, 0); PG8_SCHED; PG8_LDA(At, 1, 0); PG8_STAGE(PG8_SA(0, 1), a2 + hstepA, voffA);
      PG8_WAIT_L(8); PG8_BAR; PG8_WAIT_L(0); PG8_MMA(0, 0, At, B0); PG8_BAR; PG8_SCHED;
      PG8_LDB(B1, 1, 1); PG8_STAGE(PG8_SB(1, 0), b3, voffB);
      PG8_BAR; PG8_WAIT_L(0); PG8_MMA(0, 1, At, B1); PG8_BAR;
      PG8_LDA(At, 1, 1); PG8_STAGE(PG8_SA(1, 0), a3, voffA);
      PG8_BAR; PG8_WAIT_L(0); PG8_MMA(1, 0, At, B0); PG8_BAR; PG8_SCHED;
      PG8_STAGE(PG8_SB(1, 1), b3 + hstepB, voffB);
      PG8_WAIT_V(6); PG8_BAR; PG8_MMA(1, 1, At, B1); PG8_BAR;
    }
    E(acc, cur, wr, wc, fr, fq);
    if (!has_next) break;
#pragma unroll
    for (int a = 0; a < 2; ++a)
#pragma unroll
      for (int b = 0; b < 2; ++b)
#pragma unroll
        for (int m = 0; m < 4; ++m)
#pragma unroll
          for (int n = 0; n < 2; ++n) acc[a][b][m][n] = (f32x4){0.f, 0.f, 0.f, 0.f};
    cur = nxt; cA = nA; cB = nB; ++ui;
  }
  PG8_WAIT_V(0);
  if (wr == 0) PG8_BAR;
  PG8_BAR;
#undef PG8_SA
#undef PG8_SB
#undef PG8_STAGE
#undef PG8_LDA
#undef PG8_LDB
#undef PG8_MMA
#undef PG8_WAIT_V
#undef PG8_WAIT_L
#undef PG8_BAR
#undef PG8_SCHED
}
DI u32x4 pack8v(const f32x4& a, const f32x4& b) { u32x4 w; w.x = pk2(a[0], a[1]); w.y = pk2(a[2], a[3]); w.z = pk2(b[0], b[1]); w.w = pk2(b[2], b[3]); return w; }

struct EpiStoreBf16 {
  static constexpr bool PERM = true;
  bf16_t* O; int ldc;
  DI void operator()(const acc_t& acc, const Unit& u, int wr, int wc, int fr, int fq) const {
    const int row0 = u.pm * BM + wr * 64 + fr, col0 = u.pn * BM + wc * 32 + 8 * fq;
#pragma unroll
    for (int ai = 0; ai < 2; ++ai)
#pragma unroll
      for (int m = 0; m < 4; ++m) { bf16_t* rowp = O + (size_t)(row0 + ai * HALF + m * 16) * ldc + col0;
#pragma unroll
        for (int bj = 0; bj < 2; ++bj) *(u32x4*)(rowp + bj * HALF) = pack8v(acc[ai][bj][m][0], acc[ai][bj][m][1]); }
  }
};
struct EpiTokT {
  static constexpr bool PERM = true;
  bf16_t* O; int rows_per_b;
  DI void operator()(const acc_t& acc, const Unit& u, int wr, int wc, int fr, int fq) const {
    const int row0 = u.pm * BM + wr * 64 + fr;
    const int t0 = u.pn * BM, b = t0 / S, s0 = t0 - b * S + wc * 32 + 8 * fq;
#pragma unroll
    for (int ai = 0; ai < 2; ++ai)
#pragma unroll
      for (int m = 0; m < 4; ++m) { bf16_t* rowp = O + ((size_t)b * rows_per_b + row0 + ai * HALF + m * 16) * S + s0;
#pragma unroll
        for (int bj = 0; bj < 2; ++bj) *(u32x4*)(rowp + bj * HALF) = pack8v(acc[ai][bj][m][0], acc[ai][bj][m][1]); }
  }
};
constexpr float QSCALE = 0.10206207261596577f * 1.4426950408889634f;
struct EpiK {
  static constexpr bool PERM = true;
  bf16_t* Kb;
  DI void operator()(const acc_t& acc, const Unit& u, int wr, int wc, int fr, int fq) const {
    const int row0 = u.pm * BM + wr * 64 + fr;
#pragma unroll
    for (int ai = 0; ai < 2; ++ai)
#pragma unroll
      for (int m = 0; m < 4; ++m) { const int tl = row0 + ai * HALF + m * 16, bl = tl / S, s = tl - bl * S;
#pragma unroll
        for (int bj = 0; bj < 2; ++bj) { const int c = u.pn * BM + bj * HALF + wc * 32 + 8 * fq, head = c >> 6, j = c & 63;
          *(u32x4*)(Kb + ((size_t)(bl * 8 + head) * S + s) * 96 + j) = pack8v(acc[ai][bj][m][0], acc[ai][bj][m][1]); } }
  }
};
struct EpiMergeG {
  static constexpr bool PERM = true;
  const bf16_t* P; bf16_t* M; int first;
  DI void operator()(const acc_t& acc, const Unit& u, int wr, int wc, int fr, int fq) const {
    const int row0 = u.pm * BM + wr * 64 + fr, col0 = u.pn * BM + wc * 32 + 8 * fq;
#pragma unroll
    for (int ai = 0; ai < 2; ++ai)
#pragma unroll
      for (int m = 0; m < 4; ++m) { const int row = row0 + ai * HALF + m * 16;
#pragma unroll
        for (int bj = 0; bj < 2; ++bj) {
          const u32x4 pv = *(const u32x4*)(P + (size_t)row * 1024 + col0 + bj * HALF);
          bf16_t* mp = M + (size_t)row * ZS + col0 + bj * HALF;
          f32x4 r0, r1;
          const f32x4& g0 = acc[ai][bj][m][0]; const f32x4& g1 = acc[ai][bj][m][1];
          r0[0] = sigmoidf_(g0[0]) * bflo(pv.x); r0[1] = sigmoidf_(g0[1]) * bfhi(pv.x); r0[2] = sigmoidf_(g0[2]) * bflo(pv.y); r0[3] = sigmoidf_(g0[3]) * bfhi(pv.y);
          r1[0] = sigmoidf_(g1[0]) * bflo(pv.z); r1[1] = sigmoidf_(g1[1]) * bfhi(pv.z); r1[2] = sigmoidf_(g1[2]) * bflo(pv.w); r1[3] = sigmoidf_(g1[3]) * bfhi(pv.w);
          if (!first) { const u32x4 mv = *(const u32x4*)mp;
            r0[0] += bflo(mv.x); r0[1] += bfhi(mv.x); r0[2] += bflo(mv.y); r0[3] += bfhi(mv.y); r1[0] += bflo(mv.z); r1[1] += bfhi(mv.z); r1[2] += bflo(mv.w); r1[3] += bfhi(mv.w); }
          *(u32x4*)mp = pack8v(r0, r1); } }
  }
};

struct Desc { const char* A; const char* B; int lda, ldb, nt, pm, pn, kind; };
template <class Sched, class Epi>
DI void gemm_stream(char* smem, const Sched& S_, const Epi& E) {
  LAS unsigned char* lds = (LAS unsigned char*)smem;
  const int tid = get_tid(), wid = __builtin_amdgcn_readfirstlane(tid >> 6), lane = tid & 63, wr = wid >> 2, wc = wid & 3, fr = lane & 15, fq = lane >> 4;
  int R0, C0, R1, C1;
  stage_rc(tid * 16, R0, C0); stage_rc(tid * 16 + 8192, R1, C1);
  const int Rb0 = Epi::PERM ? ((R0 & ~31) + perm32(R0 & 31)) : R0, Rb1 = Epi::PERM ? ((R1 & ~31) + perm32(R1 & 31)) : R1;
  C0 *= 2; C1 *= 2;
  const size_t kstep = (size_t)(BK * 2);
  const unsigned ldsw = (unsigned)wid * 1024u;
  const int aoff = lds_byte(wr * 64 + fr, fq * 8), boff = lds_byte(wc * 32 + fr, fq * 8);
#define PG8_SA(b, h) (((b) * 2 + (h)) * HTB)
#define PG8_SB(b, h) ((4 + (b) * 2 + (h)) * HTB)
#define PG8_STAGE3(bufoff, gbase, ld2, RA, RB) do { \
    __builtin_amdgcn_global_load_lds((const unsigned*)((const char*)(gbase) + (unsigned)((RA) * (ld2) + C0)), (LAS unsigned*)(lds + (bufoff) + ldsw), 16, 0, 0); \
    __builtin_amdgcn_global_load_lds((const unsigned*)((const char*)(gbase) + (unsigned)((RB) * (ld2) + C1)), (LAS unsigned*)(lds + (bufoff) + ldsw + 8192), 16, 0, 0); } while (0)
#define PG8_STA(bufoff, gbase, ld2) PG8_STAGE3(bufoff, gbase, ld2, R0, R1)
#define PG8_STB(bufoff, gbase, ld2) PG8_STAGE3(bufoff, gbase, ld2, Rb0, Rb1)
#define PG8_LDA(dst, b, h) do { _Pragma("unroll") for (int m = 0; m < 4; ++m) _Pragma("unroll") for (int k = 0; k < 2; ++k) dst[m][k] = *(const LAS bf16x8*)(lds + PG8_SA(b, h) + aoff + m * 2048 + k * 1024); } while (0)
#define PG8_LDB(dst, b, h) do { _Pragma("unroll") for (int n = 0; n < 2; ++n) _Pragma("unroll") for (int k = 0; k < 2; ++k) dst[n][k] = *(const LAS bf16x8*)(lds + PG8_SB(b, h) + boff + n * 2048 + k * 1024); } while (0)
#define PG8_MMA(ai, bj, At, Bt_) do { __builtin_amdgcn_s_setprio(1); _Pragma("unroll") for (int m = 0; m < 4; ++m) _Pragma("unroll") for (int n = 0; n < 2; ++n) _Pragma("unroll") for (int k = 0; k < 2; ++k) \
    acc[ai][bj][m][n] = __builtin_amdgcn_mfma_f32_16x16x32_bf16(Bt_[n][k], At[m][k], acc[ai][bj][m][n], 0, 0, 0); __builtin_amdgcn_s_setprio(0); } while (0)
#define PG8_WAIT_V(n) asm volatile("s_waitcnt vmcnt(" #n ")" ::: "memory")
#define PG8_WAIT_L(n) asm volatile("s_waitcnt lgkmcnt(" #n ")" ::: "memory")
#define PG8_BAR __builtin_amdgcn_s_barrier()
#define PG8_SCHED __builtin_amdgcn_sched_barrier(0)
  Desc cur, nxt; int ui = 0;
  if (!S_.next(0, cur)) return;
  f32x4 acc[2][2][4][2];
#pragma unroll
  for (int a = 0; a < 2; ++a)
#pragma unroll
    for (int b = 0; b < 2; ++b)
#pragma unroll
      for (int m = 0; m < 4; ++m)
#pragma unroll
        for (int n = 0; n < 2; ++n) acc[a][b][m][n] = (f32x4){0.f, 0.f, 0.f, 0.f};
  bf16x8 At[4][2], B0[2][2], B1[2][2];
  const char* cA = cur.A; const char* cB = cur.B;
  {
    const int la2 = cur.lda * 2, lb2 = cur.ldb * 2; const size_t hA = (size_t)HALF * la2, hB = (size_t)HALF * lb2;
    PG8_STB(PG8_SB(0, 0), cB, lb2); PG8_STA(PG8_SA(0, 0), cA, la2); PG8_STB(PG8_SB(0, 1), cB + hB, lb2); PG8_STA(PG8_SA(0, 1), cA + hA, la2);
    if (wr == 1) PG8_BAR;
    PG8_WAIT_V(4); PG8_BAR;
    PG8_STB(PG8_SB(1, 0), cB + kstep, lb2); PG8_STA(PG8_SA(1, 0), cA + kstep, la2); PG8_STB(PG8_SB(1, 1), cB + hB + kstep, lb2);
    PG8_WAIT_V(6); PG8_BAR;
  }
  for (;;) {
    const bool has_next = S_.next(ui + 1, nxt);
    if (!has_next) nxt = cur;
    const char* nA = nxt.A; const char* nB = nxt.B;
    const int nt = cur.nt;
    const int la2 = cur.lda * 2; const size_t hA = (size_t)HALF * la2;
    for (int t = 0; t < nt; t += 2) {
      const bool last = (t == nt - 2);
      const char* a1 = cA + (size_t)(t + 1) * kstep;
      const char* a2 = last ? nA : cA + (size_t)(t + 2) * kstep; const char* b2 = last ? nB : cB + (size_t)(t + 2) * kstep;
      const char* a3 = a2 + kstep; const char* b3 = b2 + kstep;
      const int xa2 = (last ? nxt.lda : cur.lda) * 2, xb2 = (last ? nxt.ldb : cur.ldb) * 2;
      const size_t xhA = (size_t)HALF * xa2, xhB = (size_t)HALF * xb2;
      PG8_LDB(B0, 0, 0); PG8_SCHED; PG8_LDA(At, 0, 0); PG8_STA(PG8_SA(1, 1), a1 + hA, la2);
      PG8_WAIT_L(8); PG8_BAR; PG8_WAIT_L(0); PG8_MMA(0, 0, At, B0); PG8_BAR; PG8_SCHED;
      PG8_LDB(B1, 0, 1); PG8_STB(PG8_SB(0, 0), b2, xb2);
      PG8_BAR; PG8_WAIT_L(0); PG8_MMA(0, 1, At, B1); PG8_BAR;
      PG8_LDA(At, 0, 1); PG8_STA(PG8_SA(0, 0), a2, xa2);
      PG8_BAR; PG8_WAIT_L(0); PG8_MMA(1, 0, At, B0); PG8_BAR; PG8_SCHED;
      PG8_STB(PG8_SB(0, 1), b2 + xhB, xb2);
      PG8_WAIT_V(6); PG8_BAR; PG8_MMA(1, 1, At, B1); PG8_BAR;
      PG8_LDB(B0, 1, 0); PG8_SCHED; PG8_LDA(At, 1, 0); PG8_STA(PG8_SA(0, 1), a2 + xhA, xa2);
      PG8_WAIT_L(8); PG8_BAR; PG8_WAIT_L(0); PG8_MMA(0, 0, At, B0); PG8_BAR; PG8_SCHED;
      PG8_LDB(B1, 1, 1); PG8_STB(PG8_SB(1, 0), b3, xb2);
      PG8_BAR; PG8_WAIT_L(0); PG8_MMA(0, 1, At, B1); PG8_BAR;
      PG8_LDA(At, 1, 1); PG8_STA(PG8_SA(1, 0), a3, xa2);
      PG8_BAR; PG8_WAIT_L(0); PG8_MMA(1, 0, At, B0); PG8_BAR; PG8_SCHED;
      PG8_STB(PG8_SB(1, 1), b3 + xhB, xb2);
      PG8_WAIT_V(6); PG8_BAR; PG8_MMA(1, 1, At, B1); PG8_BAR;
    }
    E(acc, cur, wr, wc, fr, fq);
    if (!has_next) break;
#pragma unroll
    for (int a = 0; a < 2; ++a)
#pragma unroll
      for (int b = 0; b < 2; ++b)
#pragma unroll
        for (int m = 0; m < 4; ++m)
#pragma unroll
          for (int n = 0; n < 2; ++n) acc[a][b][m][n] = (f32x4){0.f, 0.f, 0.f, 0.f};
    cur = nxt; cA = nA; cB = nB; ++ui;
  }
  PG8_WAIT_V(0);
  if (wr == 0) PG8_BAR;
  PG8_BAR;
#undef PG8_SA
#undef PG8_SB
#undef PG8_STAGE3
#undef PG8_STA
#undef PG8_STB
#undef PG8_LDA
#undef PG8_LDB
#undef PG8_MMA
#undef PG8_WAIT_V
#undef PG8_WAIT_L
#undef PG8_BAR
#undef PG8_SCHED
}

struct MergeSched {
  const bf16_t* H; const bf16_t* Z; const bf16_t* W; int nM, skip, G, c;
  DI bool next(int i, Desc& d) const {
    const int tseq = i / 6, step = i - tseq * 6, x = step >> 1, isg = step & 1;
    const long L = (long)tseq * G + c; const int nwg = nM * 4; if (L >= nwg) return false;
    int wgid = (int)L; { const int q = nwg / NXCD, r = nwg % NXCD, xcd = wgid % NXCD, off = wgid / NXCD; wgid = (xcd < r ? xcd * (q + 1) : r * (q + 1) + (xcd - r) * q) + off; }
    const int nig = WGM * 4, gid = wgid / nig, fm = gid * WGM, gsz = (nM - fm) < WGM ? (nM - fm) : WGM;
    int pm = fm + ((wgid % nig) % gsz); const int pn = (wgid % nig) / gsz;
    if (skip) pm = pm + pm / 16 + 1;
    d.pm = pm; d.pn = pn; d.kind = step;
    if (isg) { d.A = (const char*)(H + (size_t)pm * 256 * 1024); d.lda = 1024; d.B = (const char*)(W + W_G + (size_t)(x * 1024 + pn * 256) * 1024); d.ldb = 1024; d.nt = 16; }
    else { const int yc = x == 0 ? Z_YA : (x == 1 ? Z_YB : Z_YC);
      d.A = (const char*)(Z + (size_t)pm * 256 * ZS + yc); d.lda = ZS; d.B = (const char*)(W + W_OA + (size_t)x * 1024 * 512 + (size_t)pn * 256 * 512); d.ldb = 512; d.nt = 8; }
    return true;
  }
};
struct EpiMergeS {
  static constexpr bool PERM = true;
  u32x4* slab; bf16_t* M;
  DI void operator()(const acc_t& acc, const Desc& u, int wr, int wc, int fr, int fq) const {
    u32x4* sp = slab + get_tid(); asm volatile("" : "+v"(sp));
    if (!(u.kind & 1)) {
#pragma unroll
      for (int ai = 0; ai < 2; ++ai)
#pragma unroll
        for (int m = 0; m < 4; ++m)
#pragma unroll
          for (int bj = 0; bj < 2; ++bj) sp[((ai * 4 + m) * 2 + bj) * 512] = pack8v(acc[ai][bj][m][0], acc[ai][bj][m][1]);
    } else {
      const int first = u.kind == 1;
      const int row0 = u.pm * BM + wr * 64 + fr, col0 = u.pn * BM + wc * 32 + 8 * fq;
#pragma unroll
      for (int ai = 0; ai < 2; ++ai) {
        MEMBAR();
        u32x4 pv[4][2], mv[4][2];
#pragma unroll
        for (int m = 0; m < 4; ++m)
#pragma unroll
          for (int bj = 0; bj < 2; ++bj) {
            pv[m][bj] = sp[((ai * 4 + m) * 2 + bj) * 512];
            if (!first) mv[m][bj] = *(const u32x4*)(M + (size_t)(row0 + ai * HALF + m * 16) * ZS + col0 + bj * HALF);
          }
#pragma unroll
        for (int m = 0; m < 4; ++m)
#pragma unroll
          for (int bj = 0; bj < 2; ++bj) {
            bf16_t* mp = M + (size_t)(row0 + ai * HALF + m * 16) * ZS + col0 + bj * HALF;
            const u32x4 pq = pv[m][bj];
            f32x4 r0, r1;
            const f32x4& g0 = acc[ai][bj][m][0]; const f32x4& g1 = acc[ai][bj][m][1];
            r0[0] = sigmoidf_(g0[0]) * bflo(pq.x); r0[1] = sigmoidf_(g0[1]) * bfhi(pq.x); r0[2] = sigmoidf_(g0[2]) * bflo(pq.y); r0[3] = sigmoidf_(g0[3]) * bfhi(pq.y);
            r1[0] = sigmoidf_(g1[0]) * bflo(pq.z); r1[1] = sigmoidf_(g1[1]) * bfhi(pq.z); r1[2] = sigmoidf_(g1[2]) * bflo(pq.w); r1[3] = sigmoidf_(g1[3]) * bfhi(pq.w);
            if (!first) { const u32x4 mq = mv[m][bj];
              r0[0] += bflo(mq.x); r0[1] += bfhi(mq.x); r0[2] += bflo(mq.y); r0[3] += bfhi(mq.y); r1[0] += bflo(mq.z); r1[1] += bfhi(mq.z); r1[2] += bflo(mq.w); r1[3] += bfhi(mq.w); }
            *(u32x4*)mp = pack8v(r0, r1);
          }
      }
    }
  }
};

struct GemmASched {
  const bf16_t* H; const bf16_t* W; int G, c;
  DI bool next(int i, Desc& d) const {
    const long L = (long)i * G + c; if (L >= 1496 + 272) return false;
    d.lda = 1024; d.ldb = 1024; d.nt = 16;
    if (L < 1496) {
      const int nwg = 1496, nN = 11, nM = 136;
      int wgid = (int)L; { const int q = nwg / NXCD, r = nwg % NXCD, xcd = wgid % NXCD, off = wgid / NXCD; wgid = (xcd < r ? xcd * (q + 1) : r * (q + 1) + (xcd - r) * q) + off; }
      const int nig = WGM * nN, gid = wgid / nig, fm = gid * WGM, gsz = (nM - fm) < WGM ? (nM - fm) : WGM;
      d.pm = fm + ((wgid % nig) % gsz); d.pn = (wgid % nig) / gsz; d.kind = 0;
      d.A = (const char*)(H + (size_t)d.pm * 256 * 1024); d.B = (const char*)(W + W_IN + (size_t)d.pn * 256 * 1024);
    } else {
      const int j = (int)L - 1496; d.pm = j & 1; d.pn = j >> 1; d.kind = 1;
      d.A = (const char*)(W + W_IN + (size_t)(2816 + d.pm * 256) * 1024); d.B = (const char*)(H + (size_t)d.pn * 256 * 1024);
    }
    return true;
  }
};
struct EpiGemmA {
  static constexpr bool PERM = true;
  bf16_t* Z; bf16_t* RVT;
  DI void operator()(const acc_t& acc, const Desc& u, int wr, int wc, int fr, int fq) const {
    const int row0 = u.pm * BM + wr * 64 + fr;
    if (u.kind == 0) {
      const int col0 = u.pn * BM + wc * 32 + 8 * fq;
#pragma unroll
      for (int ai = 0; ai < 2; ++ai)
#pragma unroll
        for (int m = 0; m < 4; ++m) { bf16_t* rowp = Z + (size_t)(row0 + ai * HALF + m * 16) * ZS + col0;
#pragma unroll
          for (int bj = 0; bj < 2; ++bj) *(u32x4*)(rowp + bj * HALF) = pack8v(acc[ai][bj][m][0], acc[ai][bj][m][1]); }
    } else {
      const int t0 = u.pn * BM, b = t0 / S, s0 = t0 - b * S + wc * 32 + 8 * fq;
#pragma unroll
      for (int ai = 0; ai < 2; ++ai)
#pragma unroll
        for (int m = 0; m < 4; ++m) { bf16_t* rowp = RVT + ((size_t)b * 512 + row0 + ai * HALF + m * 16) * S + s0;
#pragma unroll
          for (int bj = 0; bj < 2; ++bj) *(u32x4*)(rowp + bj * HALF) = pack8v(acc[ai][bj][m][0], acc[ai][bj][m][1]); }
    }
  }
};

struct QkvSched {
  const bf16_t* Z; const bf16_t* W; int G, c;
  DI bool next(int i, Desc& d) const {
    const long L = (long)i * G + c; if (L >= 476) return false;
    if (L < 204) { d.pm = (int)L / 3; d.pn = (int)L - d.pm * 3; d.kind = 0; d.lda = ZS; d.ldb = 384; d.nt = 6;
      d.A = (const char*)(Z + (size_t)d.pm * 256 * ZS + Z_QD); d.B = (const char*)(W + W_UQ + (size_t)d.pn * 256 * 384); }
    else if (L < 340) { const int j = (int)L - 204; d.pm = j >> 1; d.pn = j & 1; d.kind = 1; d.lda = ZS; d.ldb = 256; d.nt = 4;
      d.A = (const char*)(Z + (size_t)d.pm * 256 * ZS + Z_KVD); d.B = (const char*)(W + W_UK + (size_t)d.pn * 256 * 256); }
    else { const int j = (int)L - 340; d.pm = j & 1; d.pn = j >> 1; d.kind = 2; d.lda = 256; d.ldb = ZS; d.nt = 4;
      d.A = (const char*)(W + W_UV + (size_t)d.pm * 256 * 256); d.B = (const char*)(Z + (size_t)d.pn * 256 * ZS + Z_KVD); }
    return true;
  }
};
struct EpiQkv {
  static constexpr bool PERM = true;
  bf16_t* Q; bf16_t* Kb; bf16_t* VT;
  DI void operator()(const acc_t& acc, const Desc& u, int wr, int wc, int fr, int fq) const {
    const int row0 = u.pm * BM + wr * 64 + fr;
    if (u.kind == 0) {
      const int col0 = u.pn * BM + wc * 32 + 8 * fq;
#pragma unroll
      for (int ai = 0; ai < 2; ++ai)
#pragma unroll
        for (int m = 0; m < 4; ++m) { bf16_t* rowp = Q + (size_t)(row0 + ai * HALF + m * 16) * 768 + col0;
#pragma unroll
          for (int bj = 0; bj < 2; ++bj) *(u32x4*)(rowp + bj * HALF) = pack8v(acc[ai][bj][m][0], acc[ai][bj][m][1]); }
    } else if (u.kind == 1) {
#pragma unroll
      for (int ai = 0; ai < 2; ++ai)
#pragma unroll
        for (int m = 0; m < 4; ++m) { const int tl = row0 + ai * HALF + m * 16, bl = tl / S, s = tl - bl * S;
#pragma unroll
          for (int bj = 0; bj < 2; ++bj) { const int c = u.pn * BM + bj * HALF + wc * 32 + 8 * fq, head = c >> 6, j = c & 63;
            *(u32x4*)(Kb + ((size_t)(bl * 8 + head) * S + s) * 96 + j) = pack8v(acc[ai][bj][m][0], acc[ai][bj][m][1]); } }
    } else {
      const int t0 = u.pn * BM, b = t0 / S, s0 = t0 - b * S + wc * 32 + 8 * fq;
#pragma unroll
      for (int ai = 0; ai < 2; ++ai)
#pragma unroll
        for (int m = 0; m < 4; ++m) { bf16_t* rowp = VT + ((size_t)b * 512 + row0 + ai * HALF + m * 16) * S + s0;
#pragma unroll
          for (int bj = 0; bj < 2; ++bj) *(u32x4*)(rowp + bj * HALF) = pack8v(acc[ai][bj][m][0], acc[ai][bj][m][1]); }
    }
  }
};
struct EpiResid {
  static constexpr bool PERM = false;
  Params p; int layer, chunk, from_input;
  DI void operator()(const acc_t& acc, const Unit& u, int wr, int wc, int fr, int fq) const {
    const int row0 = u.pm * BM + wr * 64 + fr, col0 = u.pn * BM + wc * 32 + 4 * fq;
    const int b = u.pm / 17, g = (u.pm - b * 17) == 0 ? 8 : b;
    const float* gate = modp(p, layer, g, chunk);
    f32x4 gv[2][2];
#pragma unroll
    for (int bj = 0; bj < 2; ++bj)
#pragma unroll
      for (int n = 0; n < 2; ++n) gv[bj][n] = *(const f32x4*)(gate + col0 + bj * HALF + n * 16);
#pragma unroll
    for (int q = 0; q < 4; ++q) {
      const int ai = q >> 1, mh = q & 1;
      MEMBAR();
      f32x4 xv[2][2][2];
#pragma unroll
      for (int mm = 0; mm < 2; ++mm) { const int t = row0 + ai * HALF + (2 * mh + mm) * 16;
        const float* xi = from_input ? xrow_in(p, t) : xrow_ws(p, t);
#pragma unroll
        for (int bj = 0; bj < 2; ++bj)
#pragma unroll
          for (int n = 0; n < 2; ++n) xv[mm][bj][n] = *(const f32x4*)(xi + col0 + bj * HALF + n * 16); }
      MEMBAR();
#pragma unroll
      for (int mm = 0; mm < 2; ++mm) { const int t = row0 + ai * HALF + (2 * mh + mm) * 16;
        float* xo = xrow_ws(p, t);
#pragma unroll
        for (int bj = 0; bj < 2; ++bj)
#pragma unroll
          for (int n = 0; n < 2; ++n) *(f32x4*)(xo + col0 + bj * HALF + n * 16) = xv[mm][bj][n] + gv[bj][n] * acc[ai][bj][2 * mh + mm][n]; }
    }
  }
};
struct EpiFFN1 {
  static constexpr bool PERM = true;
  bf16_t* G;
  DI void operator()(const acc_t& acc, const Unit& u, int wr, int wc, int fr, int fq) const {
    const int row0 = u.pm * BM + wr * 64 + fr, col0 = u.pn * HALF + wc * 32 + 8 * fq;
#pragma unroll
    for (int ai = 0; ai < 2; ++ai)
#pragma unroll
      for (int m = 0; m < 4; ++m) {
        f32x4 r0, r1;
#pragma unroll
        for (int e = 0; e < 4; ++e) { r0[e] = siluf_(acc[ai][0][m][0][e]) * acc[ai][1][m][0][e]; r1[e] = siluf_(acc[ai][0][m][1][e]) * acc[ai][1][m][1][e]; }
        *(u32x4*)(G + (size_t)(row0 + ai * HALF + m * 16) * DFF + col0) = pack8v(r0, r1); }
  }
};
DI void conv_job(const float* src0, const float* src1, int ld, int K, int N, bf16_t* dst, int kind, const float* kscale, char* smem, int& rot) {
  float* tile = (float*)smem;
  const int ktn = K >> 6, ntn = N >> 6, kq = (ktn + 3) >> 2, nit = kq * ntn;
  const int G = gridDim.x;
  int start = blockIdx.x + rot; if (start >= G) start -= G;
  for (int it = start; it < nit; it += G) {
    const int tid = get_tid(), tx = tid & 15, ty = tid >> 4;
    const int nt = it / kq, kt0 = (it - nt * kq) * 4, nkt = (ktn - kt0) < 4 ? (ktn - kt0) : 4;
    const int n = nt * 64 + tx * 4;
    const float* src = src0; int col = n;
    if (kind == 1) {
      if (n < 512) col = n;
      else if (n < 768) col = 800 + (n - 512);
      else if (n < 1024) col = 1952 + (n - 768);
      else if (n < 1280) col = 512 + (n - 1024);
      else if (n < 1664) col = 1568 + (n - 1280);
      else if (n < 2176) col = 2208 + (n - 1664);
      else if (n < 2688) col = 2720 + (n - 2176);
      else if (n < 2720) col = 768 + (n - 2688);
      else if (n < 2816) col = -1;
      else col = 1056 + (n - 2816);
    } else if (kind == 2) { col = 3232 + n;
    } else if (kind == 4) { col = (n >> 6) * 128 + (n & 63);
    } else if (kind == 5) { col = (n >> 6) * 128 + 64 + (n & 63);
    } else if (kind == 6) { const int tl = n >> 8, c = n & 255; col = tl * 128 + (c & 127); src = (c >> 7) ? src1 : src0; }
    float4 v[4][2];
#pragma unroll
    for (int q = 0; q < 4; ++q)
#pragma unroll
      for (int ps = 0; ps < 2; ++ps) {
        v[q][ps] = make_float4(0.f, 0.f, 0.f, 0.f);
        if (q < nkt && col >= 0) { const int k = (kt0 + q) * 64 + ty + 32 * ps; v[q][ps] = *(const float4*)(src + (size_t)k * ld + col); }
      }
    __syncthreads();
#pragma unroll
    for (int q = 0; q < 4; ++q)
#pragma unroll
      for (int ps = 0; ps < 2; ++ps) {
        if (q < nkt) {
          const int kl = ty + 32 * ps; float4 w = v[q][ps];
          if (kscale) { const float sc = kscale[(kt0 + q) * 64 + kl]; w.x *= sc; w.y *= sc; w.z *= sc; w.w *= sc; }
          float* tp = tile + (q * 64 + kl) * 65 + tx * 4;
          tp[0] = w.x; tp[1] = w.y; tp[2] = w.z; tp[3] = w.w;
        }
      }
    __syncthreads();
    {
      const int kc = tid & 7, nl = tid >> 3;
#pragma unroll
      for (int q = 0; q < 4; ++q) {
        if (q < nkt) {
          const float* tp = tile + (q * 64 + kc * 8) * 65 + nl;
          u32x4 o; o.x = pk2(tp[0], tp[65]); o.y = pk2(tp[130], tp[195]); o.z = pk2(tp[260], tp[325]); o.w = pk2(tp[390], tp[455]);
          *(u32x4*)(dst + (size_t)(nt * 64 + nl) * K + (kt0 + q) * 64 + kc * 8) = o;
        }
      }
    }
  }
  rot = (rot + G - (nit % G)) % G;
}

DI void phase_convert(const Params& p, int l, int rot, char* smem) {
  {
    bf16_t* W = wl(p, l);
    conv_job(p.w_in + (size_t)l * D * NIN, nullptr, NIN, 1024, 3328, W + W_IN, 1, nullptr, smem, rot);
    conv_job(p.w_in + (size_t)l * D * NIN, nullptr, NIN, 1024, 3072, W + W_G, 2, nullptr, smem, rot);
    conv_job(p.w_uq + (size_t)l * 384 * 768, nullptr, 768, 384, 768, W + W_UQ, 0, p.g_q + l * 384, smem, rot);
    conv_job(p.w_ukv + (size_t)l * 256 * 1024, nullptr, 1024, 256, 512, W + W_UK, 4, p.g_kv + l * 256, smem, rot);
    conv_job(p.w_ukv + (size_t)l * 256 * 1024, nullptr, 1024, 256, 512, W + W_UV, 5, p.g_kv + l * 256, smem, rot);
    for (int nbk = 0; nbk < 8; ++nbk)
      for (int jj = 0; jj < 4; ++jj) {
        const float* s = ((jj & 1) ? p.lru_wx : p.lru_wa) + ((size_t)((l * 2 + (jj >> 1)) * 8 + nbk)) * 4096;
        conv_job(s, nullptr, 64, 64, 64, W + W_L + (size_t)(nbk * 256 + jj * 64) * 64, 0, nullptr, smem, rot);
      }
    conv_job(p.w_oa + (size_t)l * 512 * 1024, nullptr, 1024, 512, 1024, W + W_OA, 0, nullptr, smem, rot);
    conv_job(p.w_ob + (size_t)l * 512 * 1024, nullptr, 1024, 512, 1024, W + W_OB, 0, nullptr, smem, rot);
    conv_job(p.w_oc + (size_t)l * 512 * 1024, nullptr, 1024, 512, 1024, W + W_OC, 0, nullptr, smem, rot);
    conv_job(p.w_out + (size_t)l * 1024 * 1024, nullptr, 1024, 1024, 1024, W + W_OUT, 0, nullptr, smem, rot);
    conv_job(p.w_ff1 + (size_t)l * 1024 * DFF, p.w_ff3 + (size_t)l * 1024 * DFF, DFF, 1024, 5632, W + W_FF13, 6, nullptr, smem, rot);
    conv_job(p.w_ff2 + (size_t)l * DFF * 1024, nullptr, 1024, DFF, 1024, W + W_FF2, 0, nullptr, smem, rot);
  }
}
DI void phase_setup(const Params& p, char* smem) {
  int rot = 0;
  {
    float* act = (float*)smem;
    float* red = act + 9 * 1024;
    bool have = false;
    int mstart = blockIdx.x + rot; if (mstart >= (int)gridDim.x) mstart -= gridDim.x;
    for (int it = mstart; it < 2 * 96; it += gridDim.x) {
      const int tid = get_tid(), tx = tid & 63, ty = tid >> 6;
      __syncthreads();
      if (!have) {
        for (int i = tid; i < 9 * 1024; i += NT) { int g = i >> 10, k = i & 1023; float v = g < 8 ? p.c[g * 1024 + k] : p.c_ctx[k]; act[i] = siluf_(v); }
        have = true;
        __syncthreads();
      }
      const int l = it / 96, j = (it - l * 96) * 64 + tx;
      float a[9];
#pragma unroll
      for (int g = 0; g < 9; ++g) a[g] = 0.f;
      const float* wm = p.w_mod + (size_t)l * 1024 * 6144 + j;
#pragma unroll 8
      for (int k = ty * 128; k < ty * 128 + 128; ++k) {
        const float wv = wm[(size_t)k * 6144];
#pragma unroll
        for (int g = 0; g < 9; ++g) a[g] += act[g * 1024 + k] * wv;
      }
#pragma unroll
      for (int g = 0; g < 9; ++g) red[(ty * 9 + g) * 64 + tx] = a[g];
      __syncthreads();
      for (int i = tid; i < 9 * 64; i += NT) {
        int g = i >> 6, c = i & 63;
        float v = 0.f;
#pragma unroll
        for (int q = 0; q < 8; ++q) v += red[(q * 9 + g) * 64 + c];
        int jj = (it - l * 96) * 64 + c;
        ((float*)(p.ws + OFF_MOD))[(size_t)(l * 9 + g) * 6144 + jj] = v + p.b_mod[l * 6144 + jj];
      }
    }
  }
  {
    float* axc = (float*)(p.ws + OFF_AXC); float* axs = (float*)(p.ws + OFF_AXS);
    float* rtc = (float*)(p.ws + OFF_RTC); float* rts = (float*)(p.ws + OFF_RTS);
    const int gt = blockIdx.x * NT + get_tid(), gs = gridDim.x * NT;
    for (int i = gt; i < 4096 * 16; i += gs) {
      int n = i >> 4, j = i & 15; int row = n >> 6, col = n & 63;
      float inv = exp2f(-(float)(j & 7) * (13.287712379549449f / 8.f));
      float ang = (float)(j < 8 ? row : col) * inv;
      float sn, cs; sincosf(ang, &sn, &cs);
      axc[i] = cs; axs[i] = sn;
    }
    for (int i = gt; i < S * 32; i += gs) {
      int s = i >> 5, j = i & 31;
      float th = exp2f(-(float)j * (13.287712379549449f / 31.f));
      float ang = (float)s * th;
      float sn, cs; sincosf(ang, &sn, &cs);
      rtc[i] = cs; rts[i] = sn;
    }
  }
}

DI void phase_norm(const Params& p, int layer, int which, bool from_input, bool skipctx) {
  bf16_t* H = (bf16_t*)(p.ws + OFF_H);
  const float* gam = (which ? p.g_ffn : p.g_mix) + layer * 1024;
  const int tid_ = get_tid(); const int lane = tid_ & 63, w = tid_ >> 6;
  float4 gg[4], s4[4], c4[4];
#pragma unroll
  for (int i = 0; i < 4; ++i) { gg[i] = *(const float4*)(gam + (i * 64 + lane) * 4); s4[i] = make_float4(0.f, 0.f, 0.f, 0.f); c4[i] = s4[i]; }
  int gc = -1;
  for (int t0 = (blockIdx.x * 8 + w) * 2; t0 < T; t0 += gridDim.x * 16) {
    const int b = t0 / S, s = t0 - b * S, g = s < LC ? 8 : b;
    if (skipctx && s < LC) continue;
    if (g != gc) {
      const float* sh = modp(p, layer, g, which ? 3 : 0);
      const float* sc = modp(p, layer, g, which ? 4 : 1);
#pragma unroll
      for (int i = 0; i < 4; ++i) { s4[i] = *(const float4*)(sh + (i * 64 + lane) * 4); c4[i] = *(const float4*)(sc + (i * 64 + lane) * 4); }
      gc = g;
    }
    float4 v[2][4]; float ss[2] = {0.f, 0.f};
#pragma unroll
    for (int u = 0; u < 2; ++u) {
      const float* xr = from_input ? xrow_in(p, t0 + u) : xrow_ws(p, t0 + u);
#pragma unroll
      for (int i = 0; i < 4; ++i) { v[u][i] = *(const float4*)(xr + (i * 64 + lane) * 4); }
    }
#pragma unroll
    for (int u = 0; u < 2; ++u) {
#pragma unroll
      for (int i = 0; i < 4; ++i) ss[u] += v[u][i].x * v[u][i].x + v[u][i].y * v[u][i].y + v[u][i].z * v[u][i].z + v[u][i].w * v[u][i].w;
      ss[u] = wave_sum(ss[u]);
    }
#pragma unroll
    for (int i = 0; i < 4; ++i) {
      const int k = (i * 64 + lane) * 4;
#pragma unroll
      for (int u = 0; u < 2; ++u) {
        const float rstd = rsqrtf(ss[u] * (1.f / 1024.f) + EPS);
        float o0 = v[u][i].x * rstd * gg[i].x * (1.f + c4[i].x) + s4[i].x, o1 = v[u][i].y * rstd * gg[i].y * (1.f + c4[i].y) + s4[i].y;
        float o2 = v[u][i].z * rstd * gg[i].z * (1.f + c4[i].z) + s4[i].z, o3 = v[u][i].w * rstd * gg[i].w * (1.f + c4[i].w) + s4[i].w;
        uint2 o; o.x = pk2(o0, o1); o.y = pk2(o2, o3);
        *(uint2*)(H + (size_t)(t0 + u) * 1024 + k) = o;
      }
    }
  }
}
DI void phase_final_norm(const Params& p) {
  const int tid_ = get_tid(); const int lane = tid_ & 63, w = tid_ >> 6;
  float4 gg[4];
#pragma unroll
  for (int i = 0; i < 4; ++i) gg[i] = *(const float4*)(p.g_final + (i * 64 + lane) * 4);
  for (int t = blockIdx.x * 8 + w; t < NB * SEQ; t += gridDim.x * 8) {
    float* xr = p.out + (size_t)t * D;
    float4 v[4]; float ss = 0.f;
#pragma unroll
    for (int i = 0; i < 4; ++i) { v[i] = *(const float4*)(xr + (i * 64 + lane) * 4); ss += v[i].x * v[i].x + v[i].y * v[i].y + v[i].z * v[i].z + v[i].w * v[i].w; }
    ss = wave_sum(ss);
    const float rstd = rsqrtf(ss * (1.f / 1024.f) + EPS);
#pragma unroll
    for (int i = 0; i < 4; ++i) {
      const int k = (i * 64 + lane) * 4;
      float4 o; o.x = v[i].x * rstd * gg[i].x; o.y = v[i].y * rstd * gg[i].y; o.z = v[i].z * rstd * gg[i].z; o.w = v[i].w * rstd * gg[i].w;
      *(float4*)(xr + k) = o;
    }
  }
}
DI void phase_lownorm(const Params& p) {
  bf16_t* Z = (bf16_t*)(p.ws + OFF_Z);
  const int tid_ = get_tid(); const int lane = tid_ & 63, w = tid_ >> 6;
  for (int t0 = (blockIdx.x * 8 + w) * 2; t0 < T; t0 += gridDim.x * 16) {
    uint4 q[2], k[2];
#pragma unroll
    for (int u = 0; u < 2; ++u) {
      bf16_t* zr = Z + (size_t)(t0 + u) * ZS;
      q[u] = make_uint4(0, 0, 0, 0); k[u] = make_uint4(0, 0, 0, 0);
      if (lane < 48) q[u] = *(const uint4*)(zr + Z_QD + lane * 8);
      if (lane < 32) k[u] = *(const uint4*)(zr + Z_KVD + lane * 8);
    }
#pragma unroll
    for (int u = 0; u < 2; ++u) {
      bf16_t* zr = Z + (size_t)(t0 + u) * ZS;
      float sq = 0.f, sk = 0.f, a;
      a = bflo(q[u].x); sq += a * a; a = bfhi(q[u].x); sq += a * a; a = bflo(q[u].y); sq += a * a; a = bfhi(q[u].y); sq += a * a;
      a = bflo(q[u].z); sq += a * a; a = bfhi(q[u].z); sq += a * a; a = bflo(q[u].w); sq += a * a; a = bfhi(q[u].w); sq += a * a;
      a = bflo(k[u].x); sk += a * a; a = bfhi(k[u].x); sk += a * a; a = bflo(k[u].y); sk += a * a; a = bfhi(k[u].y); sk += a * a;
      a = bflo(k[u].z); sk += a * a; a = bfhi(k[u].z); sk += a * a; a = bflo(k[u].w); sk += a * a; a = bfhi(k[u].w); sk += a * a;
      sq = wave_sum(sq); sk = wave_sum(sk);
      const float rq = rsqrtf(sq * (1.f / 384.f) + EPS), rk = rsqrtf(sk * (1.f / 256.f) + EPS);
      if (lane < 48) { uint4 o; o.x = pk2(bflo(q[u].x) * rq, bfhi(q[u].x) * rq); o.y = pk2(bflo(q[u].y) * rq, bfhi(q[u].y) * rq); o.z = pk2(bflo(q[u].z) * rq, bfhi(q[u].z) * rq); o.w = pk2(bflo(q[u].w) * rq, bfhi(q[u].w) * rq); *(uint4*)(zr + Z_QD + lane * 8) = o; }
      if (lane < 32) { uint4 o; o.x = pk2(bflo(k[u].x) * rk, bfhi(k[u].x) * rk); o.y = pk2(bflo(k[u].y) * rk, bfhi(k[u].y) * rk); o.z = pk2(bflo(k[u].z) * rk, bfhi(k[u].z) * rk); o.w = pk2(bflo(k[u].w) * rk, bfhi(k[u].w) * rk); *(uint4*)(zr + Z_KVD + lane * 8) = o; }
    }
  }
}

DI void phase_gemm_a(const Params& p, int layer, char* smem) {
  GemmASched s{(const bf16_t*)(p.ws + OFF_H), wl(p, layer), (int)gridDim.x, (int)blockIdx.x};
  EpiGemmA e{(bf16_t*)(p.ws + OFF_Z), (bf16_t*)(p.ws + OFF_RVT)};
  gemm_stream(smem, s, e);
}
DI int vblock(int rot) { const int G = gridDim.x; int v = (int)blockIdx.x - rot; if (v < 0) v += G; return v; }
DI void phase_qkv(const Params& p, int layer, int hf, char* smem, int& rot) {
  const int G_ = gridDim.x;
  const bf16_t* W = wl(p, layer);
  const bf16_t* Z = (const bf16_t*)(p.ws + OFF_Z) + (size_t)hf * TH * ZS;
  bf16_t* Kb = (bf16_t*)(p.ws + OFF_K);
  const float* axc = (const float*)(p.ws + OFF_AXC); const float* axs = (const float*)(p.ws + OFF_AXS);
  {
    QkvSched s{Z, W, G_, vblock(rot)};
    EpiQkv e{(bf16_t*)(p.ws + OFF_Q), Kb, (bf16_t*)(p.ws + OFF_VT)};
    gemm_stream(smem, s, e);
    rot = (rot + 476) % G_;
  }
  {
    const int gt = blockIdx.x * NT + get_tid(), gs = gridDim.x * NT;
    for (int tl = gt; tl < TH; tl += gs) {
      const int bl = tl / S, s = tl - bl * S;
      const uint4* kr = (const uint4*)(Z + (size_t)tl * ZS + Z_KR);
      const uint4 a0 = kr[0], a1 = kr[1], b0 = kr[2], b1 = kr[3];
      const unsigned xa[8] = {a0.x, a0.y, a0.z, a0.w, a1.x, a1.y, a1.z, a1.w}, xb[8] = {b0.x, b0.y, b0.z, b0.w, b1.x, b1.y, b1.z, b1.w};
      unsigned o1[8], o2[8];
#pragma unroll
      for (int q = 0; q < 8; ++q) {
        float x1l = bflo(xa[q]), x1h = bfhi(xa[q]), x2l = bflo(xb[q]), x2h = bfhi(xb[q]);
        float c0 = 1.f, s0 = 0.f, c1 = 1.f, s1 = 0.f;
        if (s >= LC) { c0 = axc[(s - LC) * 16 + 2 * q]; s0 = axs[(s - LC) * 16 + 2 * q]; c1 = axc[(s - LC) * 16 + 2 * q + 1]; s1 = axs[(s - LC) * 16 + 2 * q + 1]; }
        o1[q] = pk2(x1l * c0 - x2l * s0, x1h * c1 - x2h * s1);
        o2[q] = pk2(x1l * s0 + x2l * c0, x1h * s1 + x2h * c1);
      }
#pragma unroll
      for (int hd = 0; hd < 8; ++hd) {
        uint4* kd = (uint4*)(Kb + ((size_t)(bl * 8 + hd) * S + s) * 96 + 64);
        kd[0] = make_uint4(o1[0], o1[1], o1[2], o1[3]); kd[1] = make_uint4(o1[4], o1[5], o1[6], o1[7]);
        kd[2] = make_uint4(o2[0], o2[1], o2[2], o2[3]); kd[3] = make_uint4(o2[4], o2[5], o2[6], o2[7]);
      }
    }
  }
}
DI void phase_merge(const Params& p, int layer, bool skipctx, char* smem) {
  MergeSched s{(const bf16_t*)(p.ws + OFF_H), (const bf16_t*)(p.ws + OFF_Z), wl(p, layer), skipctx ? 128 : 136, skipctx ? 1 : 0, (int)gridDim.x, (int)blockIdx.x};
  EpiMergeS e{(u32x4*)(p.ws + OFF_Q) + (size_t)blockIdx.x * 16 * 512, (bf16_t*)(p.ws + OFF_Z) + Z_M};
  gemm_stream(smem, s, e);
}
DI void phase_resid_gemm(const Params& p, int layer, const bf16_t* A, int lda, const bf16_t* BT, int K, int chunk, bool from_input, bool skipctx, char* smem) {
  Order o; o.init(skipctx ? 128 : 136, 4, skipctx);
  EpiResid e{p, layer, chunk, from_input};
  gemm_phase(smem, A, lda, BT, K, K, o, e);
}
DI void phase_ffn1(const Params& p, int layer, bool skipctx, char* smem) {
  Order o; o.init(skipctx ? 128 : 136, 22, skipctx);
  EpiFFN1 e{(bf16_t*)(p.ws + OFF_Z)};
  gemm_phase(smem, (const bf16_t*)(p.ws + OFF_H), 1024, wl(p, layer) + W_FF13, 1024, 1024, o, e);
}
DI void phase_attn(const Params& p, int hf, bool skipctx, char* smem, int& rot) {
  const bf16_t* Qb = (const bf16_t*)(p.ws + OFF_Q);
  const bf16_t* Kb = (const bf16_t*)(p.ws + OFF_K);
  const bf16_t* VTb = (const bf16_t*)(p.ws + OFF_VT);
  bf16_t* Z = (bf16_t*)(p.ws + OFF_Z) + (size_t)hf * TH * ZS;
  constexpr int KROW = 208, VROW = 264, KB_ = 128 * KROW, STG = KB_ + 64 * VROW;
  const int nitem = HB * 8 * 16 + (skipctx ? 0 : HB * 8);
  const int vb_ = vblock(rot); rot = (rot + nitem) % (int)gridDim.x;
  for (int it = vb_; it < nitem; it += gridDim.x) {
    const int tid = get_tid(), lane = tid & 63, w = tid >> 6, r = lane & 31, h = lane >> 5;
    int bh, s0, nkt;
    if (it < HB * 8 * 16) {
      int li = it;
      if (gridDim.x == 256) { const int c_ = it & 255, rr_ = it >> 8, idx_ = (c_ >> 3) + 32 * rr_; li = ((c_ & 7) * 4 + (idx_ >> 4)) * 16 + (idx_ & 15); }
      bh = li >> 4; s0 = LC + (li & 15) * 256; nkt = S / 128;
    } else { bh = it - HB * 8 * 16; s0 = 0; nkt = LC / 128; }
    const int head = bh & 7, bl = bh >> 3;
    const size_t tq = (size_t)bl * S + s0 + w * 32 + r;
    bf16x8 qf[6];
    {
      const float* axc = (const float*)(p.ws + OFF_AXC); const float* axs = (const float*)(p.ws + OFF_AXS);
      uint4 qu[6];
#pragma unroll
      for (int ks = 0; ks < 6; ++ks) qu[ks] = *(const uint4*)(Qb + tq * 768 + head * 96 + ks * 16 + h * 8);
#pragma unroll
      for (int ks = 0; ks < 4; ++ks) {
        const uint4 u = qu[ks];
        qf[ks] = pack8(bflo(u.x) * QSCALE, bfhi(u.x) * QSCALE, bflo(u.y) * QSCALE, bfhi(u.y) * QSCALE, bflo(u.z) * QSCALE, bfhi(u.z) * QSCALE, bflo(u.w) * QSCALE, bfhi(u.w) * QSCALE);
      }
      const unsigned a1[4] = {qu[4].x, qu[4].y, qu[4].z, qu[4].w}, a2[4] = {qu[5].x, qu[5].y, qu[5].z, qu[5].w};
      float o1[8], o2[8];
      const int sq_ = s0 + w * 32 + r;
#pragma unroll
      for (int e = 0; e < 8; ++e) {
        const float x1 = ((e & 1) ? bfhi(a1[e >> 1]) : bflo(a1[e >> 1])) * QSCALE;
        const float x2 = ((e & 1) ? bfhi(a2[e >> 1]) : bflo(a2[e >> 1])) * QSCALE;
        float cs = 1.f, sn = 0.f;
        if (sq_ >= LC) { cs = axc[(sq_ - LC) * 16 + 8 * h + e]; sn = axs[(sq_ - LC) * 16 + 8 * h + e]; }
        o1[e] = x1 * cs - x2 * sn; o2[e] = x1 * sn + x2 * cs;
      }
      qf[4] = pack8(o1[0], o1[1], o1[2], o1[3], o1[4], o1[5], o1[6], o1[7]);
      qf[5] = pack8(o2[0], o2[1], o2[2], o2[3], o2[4], o2[5], o2[6], o2[7]);
    }
    const bf16_t* Kg = Kb + (size_t)(bl * 8 + head) * S * 96;
    const bf16_t* Vg = VTb + (size_t)(bl * 8 + head) * 64 * S;
    f32x16 o[2]; o[0] = zero16(); o[1] = zero16();
    float m_run = -1e30f, l_run = 0.f;
    uint4 ak0, ak1, ak2, av0, av1, bk0, bk1, bk2, bv0, bv1;
    const int kr0 = tid / 12, kc0 = tid - kr0 * 12, kr1 = (tid + 512) / 12, kc1 = (tid + 512) - kr1 * 12, kr2 = (tid + 1024) / 12, kc2 = (tid + 1024) - kr2 * 12;
    const int vr0 = tid >> 4, vr1 = (tid + 512) >> 4, vc = tid & 15;
#define ATT_LOAD(K0, K1, K2, V0, V1, t_) do { \
      K0 = *(const uint4*)(Kg + (size_t)((t_) * 128 + kr0) * 96 + kc0 * 8); K1 = *(const uint4*)(Kg + (size_t)((t_) * 128 + kr1) * 96 + kc1 * 8); K2 = *(const uint4*)(Kg + (size_t)((t_) * 128 + kr2) * 96 + kc2 * 8); \
      V0 = *(const uint4*)(Vg + (size_t)vr0 * S + (t_) * 128 + vc * 8); V1 = *(const uint4*)(Vg + (size_t)vr1 * S + (t_) * 128 + vc * 8); } while (0)
#define ATT_WRITE(K0, K1, K2, V0, V1, buf) do { char* sk_ = smem + (buf) * STG; char* sv_ = sk_ + KB_; \
      *(uint4*)(sk_ + kr0 * KROW + kc0 * 16) = K0; *(uint4*)(sk_ + kr1 * KROW + kc1 * 16) = K1; *(uint4*)(sk_ + kr2 * KROW + kc2 * 16) = K2; \
      *(uint2*)(sv_ + vr0 * VROW + vc * 16) = make_uint2(V0.x, V0.y); *(uint2*)(sv_ + vr0 * VROW + vc * 16 + 8) = make_uint2(V0.z, V0.w); \
      *(uint2*)(sv_ + vr1 * VROW + vc * 16) = make_uint2(V1.x, V1.y); *(uint2*)(sv_ + vr1 * VROW + vc * 16 + 8) = make_uint2(V1.z, V1.w); } while (0)
    auto compute = [&](int buf, int half) {
      const char* sk = smem + buf * STG + half * 64 * KROW; const char* sv = smem + buf * STG + KB_ + half * 128;
      f32x16 st[2]; st[0] = zero16(); st[1] = zero16();
      {
        bf16x8 kf[2][6];
#pragma unroll
        for (int kb = 0; kb < 2; ++kb)
#pragma unroll
          for (int ks = 0; ks < 6; ++ks) kf[kb][ks] = *(const bf16x8*)(sk + (kb * 32 + r) * KROW + (ks * 16 + h * 8) * 2);
        __builtin_amdgcn_sched_barrier(0);
#pragma unroll
        for (int ks = 0; ks < 6; ++ks)
#pragma unroll
          for (int kb = 0; kb < 2; ++kb) st[kb] = MFMA(kf[kb][ks], qf[ks], st[kb]);
        __builtin_amdgcn_sched_barrier(0);
      }
      bf16x8 vf[2][2][2];
#pragma unroll
      for (int kb = 0; kb < 2; ++kb)
#pragma unroll
        for (int s2 = 0; s2 < 2; ++s2)
#pragma unroll
          for (int dvb = 0; dvb < 2; ++dvb) {
            const char* vp = sv + (dvb * 32 + r) * VROW + (kb * 32 + 16 * s2 + 4 * h) * 2;
            const s16x4 lo = *(const s16x4*)vp, hi = *(const s16x4*)(vp + 16);
            vf[kb][s2][dvb] = __builtin_shufflevector(lo, hi, 0, 1, 2, 3, 4, 5, 6, 7);
          }
      float mx = st[0][0];
#pragma unroll
      for (int i = 0; i < 16; ++i) { mx = fmaxf(mx, st[0][i]); mx = fmaxf(mx, st[1][i]); }
      if (__any(mx > m_run + 8.f)) {
        mx = fmaxf(mx, __shfl_xor(mx, 32));
        const float m_new = fmaxf(m_run, mx);
        const float alpha = fexp2(m_run - m_new);
        m_run = m_new;
        l_run *= alpha;
#pragma unroll
        for (int i = 0; i < 16; ++i) { o[0][i] *= alpha; o[1][i] *= alpha; }
      }
      float ps = 0.f;
#pragma unroll
      for (int kb = 0; kb < 2; ++kb)
#pragma unroll
        for (int i = 0; i < 16; ++i) { const float e = fexp2(st[kb][i] - m_run); st[kb][i] = e; ps += e; }
      l_run += ps;
#pragma unroll
      for (int kb = 0; kb < 2; ++kb)
#pragma unroll
        for (int s2 = 0; s2 < 2; ++s2) {
          const bf16x8 pb = pack8(st[kb][8 * s2 + 0], st[kb][8 * s2 + 1], st[kb][8 * s2 + 2], st[kb][8 * s2 + 3], st[kb][8 * s2 + 4], st[kb][8 * s2 + 5], st[kb][8 * s2 + 6], st[kb][8 * s2 + 7]);
#pragma unroll
          for (int dvb = 0; dvb < 2; ++dvb) o[dvb] = MFMA(vf[kb][s2][dvb], pb, o[dvb]);
        }
    };
    __syncthreads();
    ATT_LOAD(ak0, ak1, ak2, av0, av1, 0);
    ATT_LOAD(bk0, bk1, bk2, bv0, bv1, 1);
    ATT_WRITE(ak0, ak1, ak2, av0, av1, 0);
    __syncthreads();
    for (int kt = 0; kt < nkt; kt += 2) {
      if (kt + 2 < nkt) ATT_LOAD(ak0, ak1, ak2, av0, av1, kt + 2);
      compute(0, 0); compute(0, 1);
      ATT_WRITE(bk0, bk1, bk2, bv0, bv1, 1);
      __syncthreads();
      if (kt + 3 < nkt) ATT_LOAD(bk0, bk1, bk2, bv0, bv1, kt + 3);
      compute(1, 0); compute(1, 1);
      if (kt + 2 < nkt) ATT_WRITE(ak0, ak1, ak2, av0, av1, 0);
      __syncthreads();
    }
#undef ATT_LOAD
#undef ATT_WRITE
    const float lt = l_run + __shfl_xor(l_run, 32);
    const float inv = 1.f / lt;
    bf16_t* ot = (bf16_t*)smem;
#pragma unroll
    for (int dvb = 0; dvb < 2; ++dvb)
#pragma unroll
      for (int i = 0; i < 16; ++i) ot[(w * 32 + r) * 72 + dvb * 32 + crow(i, h)] = f2bf(o[dvb][i] * inv);
    __syncthreads();
#pragma unroll
    for (int i = 0; i < 4; ++i) {
      const int c = tid + 512 * i, row = c >> 3, kc = c & 7;
      const uint4 v = *(const uint4*)((const char*)ot + row * 144 + kc * 16);
      *(uint4*)(Z + ((size_t)bl * S + s0 + row) * ZS + Z_YB + head * 64 + kc * 8) = v;
    }
  }
}

DI void phase_lru(const Params& p, int layer, int b0, int nb, int mode, bool skipctx, char* smem) {
  bf16_t* Z = (bf16_t*)(p.ws + OFF_Z);
  const bf16_t* WL = wl(p, layer) + W_L;
  float2* AGG = (float2*)(p.ws + OFF_AGG);
  const float* H0 = (const float*)(p.ws + OFF_H0);
  bf16_t* xs0 = (bf16_t*)smem;
  bf16_t* uA = (bf16_t*)(smem + 17408);
  float* uF = (float*)(smem + 26624);
  float* sA = (float*)(smem + 43008);
  float* sB = (float*)(smem + 76288);
  float* h0s = (float*)(smem + 109568);
  constexpr int SD = 64 * 65;
  const float* cw = p.conv_w + layer * 4 * 512; const float* cb = p.conv_b + layer * 512;
  int G = gridDim.x; asm volatile("" : "+s"(G));
  const int nbn = nb * 8, bpg = G / nbn;
  const int bn = blockIdx.x / bpg, sub = blockIdx.x - bn * bpg;
  if (bn >= nbn) return;
  const int nblk = bn & 7, b = b0 + (bn >> 3);
  const int jlo = (mode == 1 && skipctx) ? 4 : 0;
  const int tid0 = get_tid(), lane0 = tid0 & 63, w0_ = tid0 >> 6, r0 = lane0 & 31, h0_ = lane0 >> 5;
  const int chh0 = (w0_ >> 1) & 1, dw0 = w0_ >> 2;
  bf16x8 bq[4][2];
#pragma unroll
  for (int ks = 0; ks < 4; ++ks)
#pragma unroll
    for (int q = 0; q < 2; ++q) bq[ks][q] = *(const bf16x8*)(WL + (size_t)(nblk * 256 + (2 * dw0 + q) * 64 + chh0 * 32 + r0) * 64 + ks * 16 + 8 * h0_);
  const int chgl = nblk * 64 + chh0 * 32 + r0;
  const float sp = log1p_pos(__expf(-p.lru_lam[(layer * 2 + dw0) * 512 + chgl]));
  const float ba = p.lru_ba[(layer * 2 + dw0) * 512 + chgl], bx = p.lru_bx[(layer * 2 + dw0) * 512 + chgl];
  const int chg = nblk * 64 + (tid0 & 63);
  const float w0 = cw[chg], w1 = cw[512 + chg], w2 = cw[1024 + chg], w3 = cw[1536 + chg], bb = cb[chg];
  uint4 pre0 = make_uint4(0, 0, 0, 0), pre1 = make_uint4(0, 0, 0, 0);
  float preh = 0.f;
  int tid = tid0;
  auto issue = [&](int j) {
    if (mode == 1 && tid < 128) preh = H0[((size_t)(b * 2 + (tid >> 6)) * 68 + j) * 512 + nblk * 64 + (tid & 63)];
    const int s0 = j * 64, slo = j < 4 ? 0 : LC, shi = j < 4 ? LC : S;
    { const int row = tid >> 3, kc = tid & 7, s = s0 - 2 + row;
      pre0 = make_uint4(0, 0, 0, 0);
      if (s >= slo && s < shi) pre0 = *(const uint4*)(Z + ((size_t)b * S + s) * ZS + Z_LRUX + nblk * 64 + kc * 8); }
    { const int c = tid + 512, row = c >> 3, kc = c & 7, s = s0 - 2 + row;
      pre1 = make_uint4(0, 0, 0, 0);
      if (c < 67 * 8 && s >= slo && s < shi) pre1 = *(const uint4*)(Z + ((size_t)b * S + s) * ZS + Z_LRUX + nblk * 64 + kc * 8); }
  };
  auto stash = [&](int buf) {
    char* xb_ = (char*)xs0 + buf * 8704;
    *(uint4*)(xb_ + (tid >> 3) * 128 + (tid & 7) * 16) = pre0;
    if (tid + 512 < 67 * 8) *(uint4*)(xb_ + ((tid + 512) >> 3) * 128 + (tid & 7) * 16) = pre1;
    if (mode == 1 && tid < 128) h0s[tid] = preh;
  };
  __syncthreads();
  issue(jlo + sub);
  stash(0);
  int cur = 0;
  for (int j = jlo + sub; j < 68; j += bpg, cur ^= 1) {
    const int s0 = j * 64;
    const bf16_t* xs = xs0 + cur * (8704 / 2);
    tid = get_tid();
    const int lane = tid & 63, w = tid >> 6, r = lane & 31, h = lane >> 5, th = w & 1, chh = (w >> 1) & 1, dw = w >> 2, chl = chh * 32 + r, ch = tid & 63;
    const int sd = w >> 2, sc16 = lane & 15, sseg = lane >> 4, sch = (w & 3) * 16 + sc16;
    __syncthreads();
#pragma unroll
    for (int i = 0; i < 8; ++i) {
      const int tok = (tid >> 6) + 8 * i;
      const float u = bb + w0 * bf2f(xs[tok * 64 + ch]) + w1 * bf2f(xs[(tok + 1) * 64 + ch]) + w2 * bf2f(xs[(tok + 2) * 64 + ch]) + w3 * bf2f(xs[(tok + 3) * 64 + ch]);
      uF[tok * 64 + ch] = u; uA[tok * 72 + ch] = f2bf(u);
    }
    const float h0v = (mode == 1) ? h0s[sd * 64 + sch] : 0.f;
    if (j + bpg < 68) issue(j + bpg);
    __syncthreads();
    {
      f32x16 acc[2]; acc[0] = zero16(); acc[1] = zero16();
#pragma unroll
      for (int ks = 0; ks < 4; ++ks) {
        const bf16x8 a = *(const bf16x8*)((const char*)uA + (th * 32 + r) * 144 + (ks * 16 + 8 * h) * 2);
#pragma unroll
        for (int q = 0; q < 2; ++q) acc[q] = MFMA(a, bq[ks][q], acc[q]);
      }
#pragma unroll
      for (int i = 0; i < 16; ++i) {
        const int tok = th * 32 + crow(i, h);
        const float rr = sigmoidf_(acc[0][i] + ba), ii = sigmoidf_(acc[1][i] + bx);
        const float a_ = __builtin_amdgcn_exp2f(-11.541560327111707f * rr * sp);
        sA[dw * SD + tok * 65 + chl] = a_;
        sB[dw * SD + tok * 65 + chl] = __builtin_amdgcn_sqrtf(__builtin_fmaf(-a_, a_, 1.f)) * ii * uF[tok * 64 + chl];
      }
    }
    unsigned short gate[8];
    if (mode == 1) {
      const bf16_t* gp = Z + ((size_t)b * S + s0 + (tid >> 6)) * ZS + Z_LGATE + nblk * 64 + ch;
#pragma unroll
      for (int i = 0; i < 8; ++i) gate[i] = gp[(size_t)(8 * i) * ZS];
    }
    __syncthreads();
    {
      float av[16], bv[16];
#pragma unroll
      for (int q = 0; q < 16; ++q) {
        const int pi = sseg * 16 + q, tok = sd ? 63 - pi : pi;
        av[q] = sA[sd * SD + tok * 65 + sch]; bv[q] = sB[sd * SD + tok * 65 + sch];
      }
      float P = 1.f, E = 0.f;
#pragma unroll
      for (int q = 0; q < 16; ++q) { E = av[q] * E + bv[q]; P *= av[q]; }
      float hh = h0v, PP = 1.f, EE = 0.f;
#pragma unroll
      for (int sg = 0; sg < 4; ++sg) {
        const float Pg = __shfl(P, sc16 + 16 * sg), Eg = __shfl(E, sc16 + 16 * sg);
        if (sg < sseg) hh = Pg * hh + Eg;
        EE = Pg * EE + Eg; PP *= Pg;
      }
      if (mode == 0) {
        if (sseg == 0) AGG[((size_t)(b * 2 + sd) * 68 + j) * 512 + nblk * 64 + sch] = make_float2(PP, EE);
      } else {
#pragma unroll
        for (int q = 0; q < 16; ++q) {
          const int pi = sseg * 16 + q, tok = sd ? 63 - pi : pi;
          hh = av[q] * hh + bv[q];
          sB[sd * SD + tok * 65 + sch] = hh;
        }
      }
    }
    if (mode == 1) {
      __syncthreads();
#pragma unroll
      for (int i = 0; i < 8; ++i) {
        const int tok = (tid >> 6) + 8 * i;
        const float g = bf2f(gate[i]);
        Z[((size_t)b * S + s0 + tok) * ZS + Z_LGATE + nblk * 64 + ch] = f2bf(geluf_(g) * (sB[tok * 65 + ch] + sB[SD + tok * 65 + ch]));
      }
    }
    stash(cur ^ 1);
  }
}

template <int DIR>
DI void lru_prefix_one(const float2* ag, float* h0) {
  float hh = 0.f;
#pragma unroll 1
  for (int g = 0; g < 4; ++g) {
    float2 v[17];
#pragma unroll
    for (int i = 0; i < 17; ++i) { const int q = g * 17 + i; const int t = DIR ? (q < 4 ? 3 - q : 71 - q) : q; v[i] = ag[(size_t)t * 512]; }
#pragma unroll
    for (int i = 0; i < 17; ++i) { const int q = g * 17 + i; const int t = DIR ? (q < 4 ? 3 - q : 71 - q) : q; h0[(size_t)t * 512] = hh; hh = v[i].x * hh + v[i].y; }
  }
}
DI void phase_lru_prefix(const Params& p) {
  const float2* AGG = (const float2*)(p.ws + OFF_AGG);
  float* H0 = (float*)(p.ws + OFF_H0);
  for (int it = blockIdx.x; it < NB * 2; it += gridDim.x) {
    const int tid = get_tid(), d = it & 1;
    const float2* ag = AGG + (size_t)it * 68 * 512 + tid;
    float* h0 = H0 + (size_t)it * 68 * 512 + tid;
    if (d) lru_prefix_one<1>(ag, h0); else lru_prefix_one<0>(ag, h0);
  }
}

DI float ret_lg2(int head, int d) { return log2f(1.f - exp2f(-(d ? 5.5f : 5.0f) - (float)head)); }

DI void phase_ret_states(const Params& p, int hf, char* smem, int& rot) {
  const bf16_t* Z = (const bf16_t*)(p.ws + OFF_Z) + (size_t)hf * TH * ZS;
  const bf16_t* RVT = (const bf16_t*)(p.ws + OFF_RVT) + (size_t)hf * HB * 512 * S;
  float* CS = (float*)(p.ws + OFF_CS);
  const float* rtc = (const float*)(p.ws + OFF_RTC); const float* rts = (const float*)(p.ws + OFF_RTS);
  bf16_t* KT0 = (bf16_t*)smem;
  bf16_t* KT1 = (bf16_t*)(smem + 17408);
  char* VT = smem + 34816;
  const int nitem = HB * 4 * 34;
  const int vb_ = vblock(rot); rot = (rot + nitem) % (int)gridDim.x;
  for (int it = vb_; it < nitem; it += gridDim.x) {
    const int tid = get_tid(), lane = tid & 63, w = tid >> 6, r = lane & 31, h = lane >> 5;
    const int c = it % 34, bh = it / 34, head = bh & 3, bl = bh >> 2;
    const float lgf = ret_lg2(head, 0), lgb = ret_lg2(head, 1);
    __syncthreads();
    {
      const int tok = tid >> 2, cp = tid & 3, s = c * 128 + tok;
      const bf16_t* kp = Z + ((size_t)bl * S + s) * ZS + Z_RETK + head * 64 + cp * 8;
      const uint4 u1 = *(const uint4*)kp, u2 = *(const uint4*)(kp + 32);
      const unsigned a1[4] = {u1.x, u1.y, u1.z, u1.w}, a2[4] = {u2.x, u2.y, u2.z, u2.w};
      const float wf = fexp2((float)(127 - tok) * lgf) * 0.125f, wb = fexp2((float)tok * lgb) * 0.125f;
#pragma unroll
      for (int e = 0; e < 8; ++e) {
        const int jd = cp * 8 + e;
        const float x1 = (e & 1) ? bfhi(a1[e >> 1]) : bflo(a1[e >> 1]);
        const float x2 = (e & 1) ? bfhi(a2[e >> 1]) : bflo(a2[e >> 1]);
        const float cs = rtc[s * 32 + jd], sn = rts[s * 32 + jd];
        const float k1 = x1 * cs - x2 * sn, k2 = x1 * sn + x2 * cs;
        KT0[jd * 136 + tok] = f2bf(k1 * wf); KT0[(jd + 32) * 136 + tok] = f2bf(k2 * wf);
        KT1[jd * 136 + tok] = f2bf(k1 * wb); KT1[(jd + 32) * 136 + tok] = f2bf(k2 * wb);
      }
    }
    {
      const bf16_t* rv = RVT + ((size_t)(bl * 4 + head) * 128 + (tid >> 4)) * S + c * 128 + (tid & 15) * 8;
      const uint4 q0 = *(const uint4*)rv, q1 = *(const uint4*)(rv + (size_t)32 * S), q2 = *(const uint4*)(rv + (size_t)64 * S), q3 = *(const uint4*)(rv + (size_t)96 * S);
      __builtin_amdgcn_sched_barrier(0);
      char* vd = VT + (tid >> 4) * 272 + (tid & 15) * 16;
      *(uint4*)vd = q0; *(uint4*)(vd + 32 * 272) = q1; *(uint4*)(vd + 64 * 272) = q2; *(uint4*)(vd + 96 * 272) = q3;
    }
    __syncthreads();
    const int dvb = w & 3, d = w >> 2;
    const char* KTd = (const char*)(d ? KT1 : KT0);
    f32x16 acc[2]; acc[0] = zero16(); acc[1] = zero16();
#pragma unroll
    for (int ks = 0; ks < 8; ++ks) {
      const bf16x8 a = *(const bf16x8*)(VT + (dvb * 32 + r) * 272 + (ks * 16 + 8 * h) * 2);
#pragma unroll
      for (int nb2 = 0; nb2 < 2; ++nb2) {
        const bf16x8 b0 = *(const bf16x8*)(KTd + (nb2 * 32 + r) * 272 + (ks * 16 + 8 * h) * 2);
        acc[nb2] = MFMA(a, b0, acc[nb2]);
      }
    }
#pragma unroll
    for (int nb2 = 0; nb2 < 2; ++nb2)
#pragma unroll
      for (int i = 0; i < 16; ++i)
        CS[((size_t)((bl * 4 + head) * 34 + c) * 2 + d) * 8192 + (dvb * 32 + crow(i, h)) * 64 + nb2 * 32 + r] = acc[nb2][i];
  }
}
template <int DIR>
DI void ret_prefix_one(const float* base, bf16_t* ob, float g128) {
  float v[34];
#pragma unroll
  for (int i = 0; i < 34; ++i) { const int c = DIR ? (i < 2 ? 1 - i : 35 - i) : i; v[i] = base[(size_t)c * 2 * 8192]; }
  float run = 0.f;
#pragma unroll
  for (int i = 0; i < 34; ++i) { const int c = DIR ? (i < 2 ? 1 - i : 35 - i) : i; ob[(size_t)c * 2 * 8192] = f2bf(run); run = g128 * run + v[i]; }
}
DI void phase_ret_prefix(const Params& p) {
  const float* CS = (const float*)(p.ws + OFF_CS);
  bf16_t* CSB = (bf16_t*)(p.ws + OFF_CSB);
  const int nitem = HB * 4 * 2 * 16;
  for (int it = blockIdx.x; it < nitem; it += gridDim.x) {
    const int eb = it & 15, d = (it >> 4) & 1, bh = it >> 5, head = bh & 3;
    const float g128 = exp2f(128.f * ret_lg2(head, d));
    const size_t off = ((size_t)(bh * 34) * 2 + d) * 8192 + eb * 512 + get_tid();
    if (d) ret_prefix_one<1>(CS + off, CSB + off, g128); else ret_prefix_one<0>(CS + off, CSB + off, g128);
  }
}
DI void phase_ret_out(const Params& p, int hf, bool skipctx, char* smem0, int& rot) {
  bf16_t* Z = (bf16_t*)(p.ws + OFF_Z) + (size_t)hf * TH * ZS;
  const bf16_t* RVT = (const bf16_t*)(p.ws + OFF_RVT) + (size_t)hf * HB * 512 * S;
  const bf16_t* CS = (const bf16_t*)(p.ws + OFF_CSB);
  const float* rtc = (const float*)(p.ws + OFF_RTC); const float* rts = (const float*)(p.ws + OFF_RTS);
  const int cpb = skipctx ? 32 : 34;
  const int npair = HB * 4 * cpb / 2;
  const int vb_ = vblock(rot); rot = (rot + npair) % (int)gridDim.x;
  for (int itp = vb_; itp < npair; itp += gridDim.x) {
    const int tid5 = get_tid(), grp = tid5 >> 8, tid = tid5 & 255, lane = tid & 63, w = tid >> 6, r = lane & 31, h = lane >> 5;
    char* smem = smem0 + grp * 53248;
    char* KR = smem;
    char* VT = smem + 18432;
    bf16_t* ot = (bf16_t*)(smem + 18432);
    const int it = itp * 2 + grp;
    int c, bh;
    if (skipctx) { c = (it & 31) + 2; bh = it >> 5; } else { c = it % 34; bh = it / 34; }
    const int head = bh & 3, bl = bh >> 2;
    const float lgf = ret_lg2(head, 0), lgb = ret_lg2(head, 1);
    __syncthreads();
#pragma unroll 1
    for (int u = 0; u < 2; ++u) {
      const int q = tid + 256 * u, tok = q >> 2, cp = q & 3, s = c * 128 + tok;
      const bf16_t* kp = Z + ((size_t)bl * S + s) * ZS + Z_RETK + head * 64 + cp * 8;
      const uint4 u1 = *(const uint4*)kp, u2 = *(const uint4*)(kp + 32);
      const unsigned a1[4] = {u1.x, u1.y, u1.z, u1.w}, a2[4] = {u2.x, u2.y, u2.z, u2.w};
      float k1[8], k2[8];
#pragma unroll
      for (int e = 0; e < 8; ++e) {
        const int jd = cp * 8 + e;
        const float x1 = (e & 1) ? bfhi(a1[e >> 1]) : bflo(a1[e >> 1]);
        const float x2 = (e & 1) ? bfhi(a2[e >> 1]) : bflo(a2[e >> 1]);
        const float cs = rtc[s * 32 + jd], sn = rts[s * 32 + jd];
        k1[e] = (x1 * cs - x2 * sn) * 0.125f; k2[e] = (x1 * sn + x2 * cs) * 0.125f;
      }
      *(bf16x8*)(KR + tok * 144 + cp * 16) = pack8(k1[0], k1[1], k1[2], k1[3], k1[4], k1[5], k1[6], k1[7]);
      *(bf16x8*)(KR + tok * 144 + 64 + cp * 16) = pack8(k2[0], k2[1], k2[2], k2[3], k2[4], k2[5], k2[6], k2[7]);
    }
    {
      const bf16_t* rv = RVT + ((size_t)(bl * 4 + head) * 128 + (tid >> 4)) * S + c * 128 + (tid & 15) * 8;
      const uint4 q0 = *(const uint4*)rv, q1 = *(const uint4*)(rv + (size_t)16 * S), q2 = *(const uint4*)(rv + (size_t)32 * S), q3 = *(const uint4*)(rv + (size_t)48 * S);
      const uint4 q4 = *(const uint4*)(rv + (size_t)64 * S), q5 = *(const uint4*)(rv + (size_t)80 * S), q6 = *(const uint4*)(rv + (size_t)96 * S), q7 = *(const uint4*)(rv + (size_t)112 * S);
      __builtin_amdgcn_sched_barrier(0);
      char* vd = VT + (tid >> 4) * 272 + (tid & 15) * 16;
      *(uint4*)vd = q0; *(uint4*)(vd + 16 * 272) = q1; *(uint4*)(vd + 32 * 272) = q2; *(uint4*)(vd + 48 * 272) = q3;
      *(uint4*)(vd + 64 * 272) = q4; *(uint4*)(vd + 80 * 272) = q5; *(uint4*)(vd + 96 * 272) = q6; *(uint4*)(vd + 112 * 272) = q7;
    }
    const int iq = w * 32 + r, sq = c * 128 + iq;
    bf16x8 qf[4];
    {
      const bf16_t* qp = Z + ((size_t)bl * S + sq) * ZS + Z_RETQ + head * 64;
#pragma unroll
      for (int ks = 0; ks < 2; ++ks) {
        MEMBAR();
        const uint4 u1 = *(const uint4*)(qp + ks * 16 + 8 * h), u2 = *(const uint4*)(qp + 32 + ks * 16 + 8 * h);
        const unsigned a1[4] = {u1.x, u1.y, u1.z, u1.w}, a2[4] = {u2.x, u2.y, u2.z, u2.w};
        float q1[8], q2[8];
#pragma unroll
        for (int e = 0; e < 8; ++e) {
          const int jd = ks * 16 + 8 * h + e;
          const float x1 = (e & 1) ? bfhi(a1[e >> 1]) : bflo(a1[e >> 1]);
          const float x2 = (e & 1) ? bfhi(a2[e >> 1]) : bflo(a2[e >> 1]);
          const float cs = rtc[sq * 32 + jd], sn = rts[sq * 32 + jd];
          q1[e] = x1 * cs - x2 * sn; q2[e] = x1 * sn + x2 * cs;
        }
        qf[ks] = pack8(q1[0], q1[1], q1[2], q1[3], q1[4], q1[5], q1[6], q1[7]);
        qf[ks + 2] = pack8(q2[0], q2[1], q2[2], q2[3], q2[4], q2[5], q2[6], q2[7]);
      }
    }
    __syncthreads();
    f32x16 o[4];
#pragma unroll
    for (int dvb = 0; dvb < 4; ++dvb) o[dvb] = zero16();
#pragma unroll
    for (int kb = 0; kb < 4; ++kb) {
      MEMBAR();
      f32x16 st = zero16();
#pragma unroll
      for (int ks = 0; ks < 4; ++ks) {
        const bf16x8 a = *(const bf16x8*)(KR + (kb * 32 + r) * 144 + (ks * 16 + 8 * h) * 2);
        st = MFMA(a, qf[ks], st);
      }
#pragma unroll
      for (int i = 0; i < 16; ++i) {
        const int dl = iq - (kb * 32 + crow(i, h));
        const float dlf = (float)dl;
        const float e = fexp2(dl > 0 ? dlf * lgf : -dlf * lgb);
        st[i] *= (dl == 0 ? 2.f : e);
      }
#pragma unroll
      for (int s2 = 0; s2 < 2; ++s2) {
        const bf16x8 pb = pack8(st[8 * s2 + 0], st[8 * s2 + 1], st[8 * s2 + 2], st[8 * s2 + 3], st[8 * s2 + 4], st[8 * s2 + 5], st[8 * s2 + 6], st[8 * s2 + 7]);
#pragma unroll
        for (int dvb = 0; dvb < 4; ++dvb) {
          const char* vp = VT + (dvb * 32 + r) * 272 + (kb * 32 + 16 * s2 + 4 * h) * 2;
          const s16x4 lo = *(const s16x4*)vp, hi = *(const s16x4*)(vp + 16);
          const bf16x8 va = __builtin_shufflevector(lo, hi, 0, 1, 2, 3, 4, 5, 6, 7);
          o[dvb] = MFMA(va, pb, o[dvb]);
        }
      }
    }
#pragma unroll 1
    for (int d = 0; d < 2; ++d) {
      const float qdec = d ? fexp2((float)(128 - iq) * lgb) : fexp2((float)(iq + 1) * lgf);
      const bf16_t* Rg = CS + ((size_t)((bl * 4 + head) * 34 + c) * 2 + d) * 8192;
      bf16x8 rf[4][4];
#pragma unroll
      for (int dvb = 0; dvb < 4; ++dvb)
#pragma unroll
        for (int ks = 0; ks < 4; ++ks) rf[dvb][ks] = *(const bf16x8*)(Rg + (dvb * 32 + r) * 64 + ks * 16 + 8 * h);
#pragma unroll
      for (int dvb = 0; dvb < 4; ++dvb) {
        f32x16 t = zero16();
#pragma unroll
        for (int ks = 0; ks < 4; ++ks) t = MFMA(rf[dvb][ks], qf[ks], t);
#pragma unroll
        for (int i = 0; i < 16; ++i) o[dvb][i] += qdec * t[i];
      }
    }
    float sm = 0.f;
#pragma unroll
    for (int dvb = 0; dvb < 4; ++dvb)
#pragma unroll
      for (int i = 0; i < 16; ++i) sm += o[dvb][i];
    sm += __shfl_xor(sm, 32);
    const float mu = sm * (1.f / 128.f);
    float vs = 0.f;
#pragma unroll
    for (int dvb = 0; dvb < 4; ++dvb)
#pragma unroll
      for (int i = 0; i < 16; ++i) { const float dd = o[dvb][i] - mu; vs += dd * dd; }
    vs += __shfl_xor(vs, 32);
    const float rs = rsqrtf(vs * (1.f / 128.f) + EPS);
    __syncthreads();
#pragma unroll
    for (int dvb = 0; dvb < 4; ++dvb)
#pragma unroll
      for (int i = 0; i < 16; ++i) ot[iq * 136 + dvb * 32 + crow(i, h)] = f2bf((o[dvb][i] - mu) * rs);
    __syncthreads();
#pragma unroll 1
    for (int u = 0; u < 8; ++u) {
      const int ch = tid + 256 * u, row = ch >> 4, kc = ch & 15;
      bf16_t* gp = Z + ((size_t)bl * S + c * 128 + row) * ZS + Z_RGATE + head * 128 + kc * 8;
      const uint4 g4 = *(const uint4*)gp;
      const uint4 v4 = *(const uint4*)((const char*)ot + row * 272 + kc * 16);
      uint4 o4;
      o4.x = pk2(siluf_(bflo(g4.x)) * bflo(v4.x), siluf_(bfhi(g4.x)) * bfhi(v4.x));
      o4.y = pk2(siluf_(bflo(g4.y)) * bflo(v4.y), siluf_(bfhi(g4.y)) * bfhi(v4.y));
      o4.z = pk2(siluf_(bflo(g4.z)) * bflo(v4.z), siluf_(bfhi(g4.z)) * bfhi(v4.z));
      o4.w = pk2(siluf_(bflo(g4.w)) * bflo(v4.w), siluf_(bfhi(g4.w)) * bfhi(v4.w));
      *(uint4*)gp = o4;
    }
  }
}


__global__ void __launch_bounds__(NT, 2) fwd_megakernel(Params p) {
  extern __shared__ __attribute__((aligned(16))) char smem[];
  cg::grid_group grid = cg::this_grid();
  volatile LAS3 unsigned* xst = (volatile LAS3 unsigned*)(LAS3 unsigned*)(smem + SMEM_BYTES - 16);
  if (threadIdx.x == 0) { xst[0] = 0u; xst[1] = 0u; xst[2] = 0u; xst[3] = 0u; }
  __syncthreads();
  if (blockIdx.x == 0) { unsigned* bw = (unsigned*)(p.ws + OFF_BAR); for (int i = threadIdx.x; i < (int)(BAR_BYTES / 4); i += NT) bw[i] = 0u; }
  phase_setup(p, smem);
  grid.sync();
  const XcdBarrier xb = xcd_barrier_post((unsigned*)(p.ws + OFF_BAR), xst);
#define GSYNC() xcd_barrier(xb)
  for (int layer = 0; layer < 2; ++layer) {
    const bool first = layer == 0, last = layer == 1;
    phase_norm(p, layer, 0, first, false);
    if (first) phase_convert(p, 0, 0, smem);
    GSYNC();
    phase_gemm_a(p, layer, smem);
    GSYNC();
    phase_lownorm(p);
    phase_lru(p, layer, 0, NB, 0, false, smem);
    GSYNC();
    int rot = 16;
    phase_lru_prefix(p);
    phase_qkv(p, layer, 0, smem, rot);
    phase_ret_states(p, 0, smem, rot);
    GSYNC();
    phase_ret_prefix(p);
    rot = 0;
    phase_attn(p, 0, last, smem, rot);
    phase_lru(p, layer, 0, HB, 1, last, smem);
    GSYNC();
    rot = 0;
    phase_ret_out(p, 0, last, smem, rot);
    phase_qkv(p, layer, 1, smem, rot);
    phase_ret_states(p, 1, smem, rot);
    GSYNC();
    phase_ret_prefix(p);
    rot = 0;
    phase_attn(p, 1, last, smem, rot);
    phase_lru(p, layer, HB, HB, 1, last, smem);
    GSYNC();
    rot = 0;
    phase_ret_out(p, 1, last, smem, rot);
    GSYNC();
    phase_merge(p, layer, last, smem);
    if (first) phase_convert(p, 1, (int)gridDim.x - 32, smem);
    GSYNC();
    phase_resid_gemm(p, layer, (const bf16_t*)(p.ws + OFF_Z) + Z_M, ZS, wl(p, layer) + W_OUT, 1024, 2, first, last, smem);
    GSYNC();
    phase_norm(p, layer, 1, false, last);
    GSYNC();
    phase_ffn1(p, layer, last, smem);
    GSYNC();
    phase_resid_gemm(p, layer, (const bf16_t*)(p.ws + OFF_Z), DFF, wl(p, layer) + W_FF2, DFF, 5, false, last, smem);
    GSYNC();
  }
  phase_final_norm(p);
}

extern "C" void kernel_launch(void* const* d_in, const int* in_sizes, int n_in, void* d_out, int out_size, void* d_ws, size_t ws_size, hipStream_t stream) {
  static int grid_blocks = 0;
  if (!grid_blocks) {
    int dev = 0, cus = 0, per_cu = 0;
    (void)hipGetDevice(&dev);
    (void)hipDeviceGetAttribute(&cus, hipDeviceAttributeMultiprocessorCount, dev);
    if (hipFuncSetAttribute((const void*)fwd_megakernel, hipFuncAttributeMaxDynamicSharedMemorySize, SMEM_BYTES) != hipSuccess) fprintf(stderr, "hipFuncSetAttribute failed\n");
    (void)hipOccupancyMaxActiveBlocksPerMultiprocessor(&per_cu, fwd_megakernel, NT, SMEM_BYTES);
    if (per_cu < 1) per_cu = 1;
    grid_blocks = cus * per_cu;
  }
  if (ws_size < WS_TOTAL) { fprintf(stderr, "workspace too small: %zu < %zu\n", ws_size, (size_t)WS_TOTAL); return; }
  Params p{};
  const float** pp = (const float**)&p;
  for (int i = 0; i < 28; ++i) pp[i] = (const float*)d_in[i];
  p.out = (float*)d_out;
  p.ws = (char*)d_ws;
  void* args[] = {&p};
  hipError_t e = hipLaunchCooperativeKernel((void*)fwd_megakernel, dim3(grid_blocks), dim3(NT), args, SMEM_BYTES, stream);
  if (e != hipSuccess) fprintf(stderr, "cooperative launch failed: %s (grid %d)\n", hipGetErrorString(e), grid_blocks);
}
```
